# Optimizing an MI355X kernel written in HIP

```python
import jax, jax.numpy as jnp
from jax import lax
import numpy as np

D_MODEL = 1024
BATCH = 8
SEQ = 8192
DEPTH = 4

D_MIX = D_MODEL
HEAD_DIM = 64
A_HEADS = 6
A_WIDTH = A_HEADS * HEAD_DIM
A_ROT_DIM = HEAD_DIM // 4
DILATED_CONFIGS = ((128, 1), (512, 4), (2048, 16))
WIN_BLOCK = 128
B_HEADS = 6
B_NOPE = 64
B_ROPE = 32
B_V = 64
B_WIDTH = B_HEADS * B_V
Q_LORA = 384
KV_LORA = 128
Q_BLOCK = 128
C_GROUPS = 4
C_GROUP_DIM = 64
C_WIDTH = C_GROUPS * C_GROUP_DIM
D_IN = 3 * A_WIDTH + Q_LORA + KV_LORA + B_ROPE + C_WIDTH
ROPE_THETA = 500000.0
D_FF = 2816
N_EXPERTS = 8
TOP_K = 2
D_FF_EXPERT = 3584
MOE_BLOCK = 512
N_DENSE = (DEPTH + 1) // 2
N_MOE = DEPTH // 2
RMS_EPS = 1e-6
NEG_INF = -1e30

kernel_name = "hybrid_dilated_mla_fnet_moe_encoder"


def _rmsnorm(x, g):
    xf = x.astype(jnp.float32)
    y = xf * lax.rsqrt(jnp.mean(xf * xf, axis=-1, keepdims=True) + RMS_EPS)
    return (y * g.astype(jnp.float32)).astype(x.dtype)


def _rope(x, rot_dim):
    seq = x.shape[1]
    half = rot_dim // 2
    inv_freq = ROPE_THETA ** (-jnp.arange(half, dtype=jnp.float32) / half)
    ang = jnp.arange(seq, dtype=jnp.float32)[:, None] * inv_freq[None, :]
    cos = jnp.cos(ang)[None, :, None, :]
    sin = jnp.sin(ang)[None, :, None, :]
    xr = x[..., :rot_dim].astype(jnp.float32)
    x1, x2 = xr[..., :half], xr[..., half:]
    rot = jnp.concatenate([x1 * cos - x2 * sin, x2 * cos + x1 * sin], axis=-1).astype(x.dtype)
    return jnp.concatenate([rot, x[..., rot_dim:]], axis=-1)


def _strided_window_attention(q, k, v, dilation, radius):
    bsz, seq, heads, dh = q.shape
    length = seq // dilation
    n_blk = -(-length // WIN_BLOCK)
    lp = n_blk * WIN_BLOCK
    span = WIN_BLOCK + 2 * radius

    def residues(t):
        return t.reshape(bsz, length, dilation, heads, dh).transpose(0, 2, 1, 3, 4)

    qr = jnp.pad(residues(q), ((0, 0), (0, 0), (0, lp - length), (0, 0), (0, 0)))
    kpad = ((0, 0), (0, 0), (radius, lp - length + radius), (0, 0), (0, 0))
    kr = jnp.pad(residues(k), kpad)
    vr = jnp.pad(residues(v), kpad)
    idx = jnp.arange(n_blk)[:, None] * WIN_BLOCK + jnp.arange(span)[None, :]
    kb = kr[:, :, idx]
    vb = vr[:, :, idx]
    qb = qr.reshape(bsz, dilation, n_blk, WIN_BLOCK, heads, dh)
    s = jnp.einsum('bdnqhc,bdnkhc->bdnhqk', qb, kb).astype(jnp.float32) * (dh ** -0.5)
    qpos = jnp.arange(n_blk)[:, None] * WIN_BLOCK + jnp.arange(WIN_BLOCK)[None, :]
    kpos = idx - radius
    rel = kpos[:, None, :] - qpos[:, :, None]
    valid = (jnp.abs(rel) <= radius) & (kpos >= 0)[:, None, :] & (kpos < length)[:, None, :]
    s = jnp.where(valid[None, None, :, None], s, NEG_INF)
    m = jnp.max(s, axis=-1, keepdims=True)
    p = jnp.exp(s - m)
    den = jnp.sum(p, axis=-1, keepdims=True)
    o = jnp.einsum('bdnhqk,bdnkhc->bdnqhc', (p / den).astype(v.dtype), vb)
    lse = (m + jnp.log(den))[..., 0]
    o = o.reshape(bsz, dilation, lp, heads, dh)[:, :, :length]
    lse = lse.transpose(0, 1, 2, 4, 3).reshape(bsz, dilation, lp, heads)[:, :, :length]
    o = o.transpose(0, 2, 1, 3, 4).reshape(bsz, seq, heads, dh)
    lse = lse.transpose(0, 2, 1, 3).reshape(bsz, seq, heads)
    return o, lse


def _dilated_attention(q, k, v):
    outs, lses = [], []
    for window, dilation in DILATED_CONFIGS:
        o, lse = _strided_window_attention(q, k, v, dilation, (window // 2) // dilation)
        outs.append(o)
        lses.append(lse)
    w = jax.nn.softmax(jnp.stack(lses, axis=0), axis=0)
    o = jnp.sum(jnp.stack(outs, axis=0).astype(jnp.float32) * w[..., None], axis=0)
    return o.astype(q.dtype)


def _block_attention(q, k, v):
    bsz, seq, heads, dq = q.shape
    dv = v.shape[-1]
    nq = seq // Q_BLOCK
    qb = q.reshape(bsz, nq, Q_BLOCK, heads, dq).transpose(1, 0, 2, 3, 4)
    scale = dq ** -0.5

    def one_block(qblk):
        s = jnp.einsum('bqhc,bkhc->bhqk', qblk, k).astype(jnp.float32) * scale
        p = jax.nn.softmax(s, axis=-1)
        return jnp.einsum('bhqk,bkhc->bqhc', p.astype(v.dtype), v)

    o = lax.map(one_block, qb)
    return o.transpose(1, 0, 2, 3, 4).reshape(bsz, seq, heads, dv)


def _fourier_mix(f):
    bsz, seq, _ = f.shape
    fg = f.reshape(bsz, seq, C_GROUPS, C_GROUP_DIM).astype(jnp.float32)
    y = jnp.fft.fft2(fg, axes=(1, 3), norm='ortho').real
    return y.reshape(bsz, seq, C_WIDTH).astype(f.dtype)


def _swiglu(h, wg, wu, wd):
    return (jax.nn.silu(h @ wg) * (h @ wu)) @ wd


def _moe_swiglu(h, w_router, w_gate, w_up, w_down):
    n_tok, dm = h.shape
    logits = h.astype(jnp.float32) @ w_router.astype(jnp.float32)
    top_val, top_idx = lax.top_k(logits, TOP_K)
    gates = jax.nn.softmax(top_val, axis=-1)
    n_assign = n_tok * TOP_K
    flat_e = top_idx.reshape(-1)
    flat_tok = jnp.repeat(jnp.arange(n_tok, dtype=jnp.int32), TOP_K)
    order = jnp.argsort(flat_e)
    e_sorted = flat_e[order]
    tok_sorted = flat_tok[order]
    gate_sorted = gates.reshape(-1)[order]
    counts = jnp.bincount(flat_e, length=N_EXPERTS)
    padded = ((counts + MOE_BLOCK - 1) // MOE_BLOCK) * MOE_BLOCK
    start = jnp.cumsum(counts) - counts
    cum_padded = jnp.cumsum(padded)
    start_padded = cum_padded - padded
    rank = jnp.arange(n_assign, dtype=jnp.int32) - start[e_sorted]
    dest = start_padded[e_sorted] + rank
    n_blocks = -(-n_assign // MOE_BLOCK) + N_EXPERTS
    n_rows = n_blocks * MOE_BLOCK
    tok_pad = jnp.full((n_rows,), n_tok, dtype=jnp.int32).at[dest].set(tok_sorted)
    h_ext = jnp.concatenate([h, jnp.zeros((1, dm), h.dtype)], axis=0)
    xb = h_ext[tok_pad].reshape(n_blocks, MOE_BLOCK, dm)
    block_start = jnp.arange(n_blocks, dtype=jnp.int32) * MOE_BLOCK
    block_expert = jnp.minimum(
        jnp.sum(block_start[:, None] >= cum_padded[None, :], axis=1), N_EXPERTS - 1)

    def one_block(args):
        xe, e = args
        return _swiglu(xe, w_gate[e], w_up[e], w_down[e])

    yb = lax.map(one_block, (xb, block_expert)).reshape(n_rows, dm)
    y_assign = yb[dest] * gate_sorted[:, None].astype(h.dtype)
    return jax.ops.segment_sum(y_assign, tok_sorted, num_segments=n_tok)


def setup_inputs(seed: int = 0) -> dict:
    key = jax.random.key(seed)
    ks = jax.random.split(key, 18)
    f32 = jnp.float32

    def nrm(k, shape, fan_in):
        return jax.random.normal(k, shape, f32) * (fan_in ** -0.5)

    def gain(k, shape):
        return 1.0 + 0.02 * jax.random.normal(k, shape, f32)

    return {
        'x': jax.random.normal(ks[0], (BATCH, SEQ, D_MODEL), f32),
        'attn_norm': gain(ks[1], (DEPTH, D_MODEL)),
        'w_in': nrm(ks[2], (DEPTH, D_MODEL, D_IN), D_MODEL),
        'q_norm': gain(ks[3], (DEPTH, Q_LORA)),
        'w_uq': nrm(ks[4], (DEPTH, Q_LORA, B_HEADS * (B_NOPE + B_ROPE)), Q_LORA),
        'kv_norm': gain(ks[5], (DEPTH, KV_LORA)),
        'w_ukv': nrm(ks[6], (DEPTH, KV_LORA, B_HEADS * (B_NOPE + B_V)), KV_LORA),
        'mix_gain': gain(ks[7], (DEPTH, D_MIX)),
        'w_out': nrm(ks[8], (DEPTH, D_MIX, D_MODEL), D_MIX),
        'ffn_norm': gain(ks[9], (DEPTH, D_MODEL)),
        'w_ffn_gate': nrm(ks[10], (N_DENSE, D_MODEL, D_FF), D_MODEL),
        'w_ffn_up': nrm(ks[11], (N_DENSE, D_MODEL, D_FF), D_MODEL),
        'w_ffn_down': nrm(ks[12], (N_DENSE, D_FF, D_MODEL), D_FF),
        'w_router': nrm(ks[13], (N_MOE, D_MODEL, N_EXPERTS), D_MODEL),
        'w_exp_gate': nrm(ks[14], (N_MOE, N_EXPERTS, D_MODEL, D_FF_EXPERT), D_MODEL),
        'w_exp_up': nrm(ks[15], (N_MOE, N_EXPERTS, D_MODEL, D_FF_EXPERT), D_MODEL),
        'w_exp_down': nrm(ks[16], (N_MOE, N_EXPERTS, D_FF_EXPERT, D_MODEL), D_FF_EXPERT),
        'final_norm': gain(ks[17], (D_MODEL,)),
    }


def reference(x, attn_norm, w_in, q_norm, w_uq, kv_norm, w_ukv, mix_gain, w_out, ffn_norm,
              w_ffn_gate, w_ffn_up, w_ffn_down, w_router, w_exp_gate, w_exp_up, w_exp_down,
              final_norm):
    bsz, seq, dm = x.shape
    cuts = [A_WIDTH, 2 * A_WIDTH, 3 * A_WIDTH, 3 * A_WIDTH + Q_LORA,
            3 * A_WIDTH + Q_LORA + KV_LORA, 3 * A_WIDTH + Q_LORA + KV_LORA + B_ROPE]
    for l in range(DEPTH):
        h = _rmsnorm(x, attn_norm[l])
        z = jnp.einsum('bsd,de->bse', h, w_in[l])
        qa, ka, va, cq, ckv, kpe, fc = jnp.split(z, cuts, axis=-1)

        qa = _rope(qa.reshape(bsz, seq, A_HEADS, HEAD_DIM), A_ROT_DIM)
        ka = _rope(ka.reshape(bsz, seq, A_HEADS, HEAD_DIM), A_ROT_DIM)
        va = va.reshape(bsz, seq, A_HEADS, HEAD_DIM)
        o_a = _dilated_attention(qa, ka, va).reshape(bsz, seq, A_WIDTH)

        qb = jnp.einsum('bsr,re->bse', _rmsnorm(cq, q_norm[l]), w_uq[l])
        qb = qb.reshape(bsz, seq, B_HEADS, B_NOPE + B_ROPE)
        qb = jnp.concatenate([qb[..., :B_NOPE], _rope(qb[..., B_NOPE:], B_ROPE)], axis=-1)
        kv = jnp.einsum('bsr,re->bse', _rmsnorm(ckv, kv_norm[l]), w_ukv[l])
        kv = kv.reshape(bsz, seq, B_HEADS, B_NOPE + B_V)
        k_pe = _rope(kpe.reshape(bsz, seq, 1, B_ROPE), B_ROPE)
        kb = jnp.concatenate(
            [kv[..., :B_NOPE], jnp.broadcast_to(k_pe, (bsz, seq, B_HEADS, B_ROPE))], axis=-1)
        vb = kv[..., B_NOPE:]
        o_b = _block_attention(qb, kb, vb).reshape(bsz, seq, B_WIDTH)

        o_c = _fourier_mix(fc)

        g = mix_gain[l]
        mix = jnp.concatenate([
            _rmsnorm(o_a, g[:A_WIDTH]),
            _rmsnorm(o_b, g[A_WIDTH:A_WIDTH + B_WIDTH]),
            _rmsnorm(o_c, g[A_WIDTH + B_WIDTH:]),
        ], axis=-1)
        x = x + jnp.einsum('bse,ed->bsd', mix, w_out[l])

        h = _rmsnorm(x, ffn_norm[l])
        if l % 2 == 0:
            i = l // 2
            y = _swiglu(h, w_ffn_gate[i], w_ffn_up[i], w_ffn_down[i])
        else:
            i = l // 2
            y = _moe_swiglu(h.reshape(bsz * seq, dm), w_router[i], w_exp_gate[i],
                            w_exp_up[i], w_exp_down[i]).reshape(bsz, seq, dm)
        x = x + y
    return _rmsnorm(x, final_norm)
```

```cpp
#include <hip/hip_runtime.h>
#include <cstdio>
#include <cstdint>

#ifndef MK_PER_PHASE
#define MK_PER_PHASE 0
#endif

#ifndef PROBE_DUP
#define PROBE_DUP -1
#endif
#define REPS(k) for (int rep_ = 0; rep_ < ((PROBE_DUP) == (k) ? 2 : 1); ++rep_)

#define GAS __attribute__((address_space(1)))
#define LAS __attribute__((address_space(3)))
typedef unsigned short bf16_t;
typedef short bf16x8 __attribute__((ext_vector_type(8)));
typedef short s16x4 __attribute__((ext_vector_type(4)));
typedef float f32x4 __attribute__((ext_vector_type(4)));
typedef float f32x2 __attribute__((ext_vector_type(2)));
typedef float f32x16 __attribute__((ext_vector_type(16)));
typedef unsigned u32x4 __attribute__((ext_vector_type(4)));
typedef unsigned u32x2 __attribute__((ext_vector_type(2)));
typedef int i32x2 __attribute__((ext_vector_type(2)));
typedef int i32x4 __attribute__((ext_vector_type(4)));

constexpr int T = 65536, DM = 1024, SEQ = 8192, NBATCH = 8, DEPTH = 4;
constexpr int D_IN = 1952, NIN = 2304;
constexpr int D_FF = 2816, D_FFE = 3584, NEXP = 8;
constexpr float RMS_EPS = 1e-6f;
constexpr float QSCALE_A = 0.18033688011112042f;
constexpr float QSCALE_B = 0.14724444602590306f;
constexpr float FFT_SCALE = 0.0013810679320049755f;
constexpr int RT_STRIDE = T + 8 * 256;
constexpr int MAX_TILES = RT_STRIDE / 256;

constexpr size_t MiB = 1u << 20;
constexpr size_t WS_CTL = 0, CTL_ZERO_BYTES = 1 * MiB;
constexpr size_t WS_ROPEA = 1 * MiB;
constexpr size_t WS_ROPEB = 2 * MiB;
constexpr size_t WS_W1F = 3 * MiB;
constexpr size_t WS_W2F = 3 * MiB + 128 * 1024;
constexpr size_t WS_TW = 3 * MiB + 256 * 1024;
constexpr size_t WS_SSQX = 4 * MiB;
constexpr size_t WS_SSQC = 5 * MiB;
constexpr size_t WS_TOKE = 6 * MiB;
constexpr size_t WS_TOKG = 6 * MiB + 512 * 1024;
constexpr size_t WS_CNTWG = 7 * MiB;
constexpr size_t WS_ROWTOK = 8 * MiB;
constexpr size_t WS_ROWGATE = 9 * MiB;
constexpr size_t WS_TILEE = 10 * MiB;
constexpr size_t WS_ROWSC = 11 * MiB;
constexpr size_t WS_ROWSC2 = 11 * MiB + 512 * 1024;
constexpr size_t WS_ROWRS = 12 * MiB;
constexpr size_t WS_WL = 16 * MiB, WL_STRIDE = 8 * MiB;
constexpr size_t WL_WUP = 4608 * 1024, WL_WUKV = 4608 * 1024 + 1 * MiB, WL_WOUT = 6 * MiB;
constexpr size_t WS_WFF = 48 * MiB, WFF_STRIDE = 17 * MiB;
constexpr size_t WFF_WD = 11 * MiB;
constexpr size_t WS_WGUE = 82 * MiB;
constexpr size_t WS_WDE = 194 * MiB;
constexpr size_t WS_XB = 250 * MiB;
constexpr size_t WS_AP = 970 * MiB;
constexpr size_t WS_QA = 378 * MiB, WS_KA = 426 * MiB, WS_VA = 474 * MiB;
constexpr size_t WS_CQK = 522 * MiB;
constexpr size_t WS_Z = 586 * MiB;
constexpr size_t WS_QB = 650 * MiB, WS_KB = 722 * MiB;
constexpr size_t WS_VB = 794 * MiB;
constexpr size_t WS_MIX = 842 * MiB;
constexpr size_t WS_HID = 378 * MiB;
constexpr size_t WS_XB8 = 970 * MiB;
constexpr size_t WS_END = 1034 * MiB;
static_assert(WS_HID + (size_t)RT_STRIDE * D_FFE * 2 <= WS_MIX, "hidden overlay");

constexpr int CW_TMO = 0, CW_DBG = 16, CW_BAR = 4096;

constexpr int RING_BYTES = 131072;
constexpr int EPI_OFF = RING_BYTES;
constexpr int MISC_OFF = EPI_OFF + 4096;
constexpr int TAB_OFF = MISC_OFF + 1024;
constexpr int TAB_SLOT = 5120, TAB_REL = TAB_OFF - EPI_OFF;
constexpr int LDS_BYTES = TAB_OFF + 3 * TAB_SLOT;

#define RLX_AGENT __ATOMIC_RELAXED, __HIP_MEMORY_SCOPE_AGENT
#define LDS_WAIT() asm volatile("s_waitcnt lgkmcnt(0)" ::: "memory")
#define VM_WAIT() asm volatile("s_waitcnt vmcnt(0)" ::: "memory")
#define SBAR() __builtin_amdgcn_sched_barrier(0)

__device__ __forceinline__ unsigned cvt_pk_bf16(float lo, float hi) { unsigned r; asm volatile("v_cvt_pk_bf16_f32 %0, %1, %2" : "=v"(r) : "v"(lo), "v"(hi)); return r; }
__device__ __forceinline__ unsigned f2bf(float f) { unsigned u = __builtin_bit_cast(unsigned, f); return (u + 0x7fffu + ((u >> 16) & 1u)) >> 16; }
__device__ __forceinline__ unsigned pk2(float lo, float hi) { return f2bf(lo) | (f2bf(hi) << 16); }
__device__ __forceinline__ float bflo(unsigned w) { return __uint_as_float(w << 16); }
__device__ __forceinline__ float bfhi(unsigned w) { return __uint_as_float(w & 0xffff0000u); }
__device__ __forceinline__ float wave_sum(float v) {
#pragma unroll
    for (int o = 1; o < 64; o <<= 1) v += __shfl_xor(v, o);
    return v;
}
__device__ __forceinline__ float clamp448(float v) { return __builtin_amdgcn_fmed3f(v, -448.f, 448.f); }
__device__ __forceinline__ unsigned pk4_fp8(float a, float b, float c, float d) {
    int w = __builtin_amdgcn_cvt_pk_fp8_f32(clamp448(a), clamp448(b), 0, false); w = __builtin_amdgcn_cvt_pk_fp8_f32(clamp448(c), clamp448(d), w, true); return (unsigned)w; }
__device__ __forceinline__ float bf_lo(unsigned w) { return __uint_as_float(w << 16); }
__device__ __forceinline__ float bf_hi(unsigned w) { return __uint_as_float(w & 0xffff0000u); }
__device__ __forceinline__ unsigned pk4_i8(float a, float b, float c, float d) {
    const float M = 12582912.f;
    const unsigned ia = __float_as_uint(__builtin_amdgcn_fmed3f(a, -127.f, 127.f) + M), ib = __float_as_uint(__builtin_amdgcn_fmed3f(b, -127.f, 127.f) + M);
    const unsigned ic = __float_as_uint(__builtin_amdgcn_fmed3f(c, -127.f, 127.f) + M), id = __float_as_uint(__builtin_amdgcn_fmed3f(d, -127.f, 127.f) + M);
    return __builtin_amdgcn_perm(ib, ia, 0x0c0c0400u) | __builtin_amdgcn_perm(id, ic, 0x04000c0cu); }
constexpr float I8_WQ = 127.f * 32.f / 4.0f, I8_WINV = 4.0f / (127.f * 32.f);
constexpr float I8_XR = 4.0f / 127.f;
constexpr float W8_SCALE = 64.f, W8_INV = 1.0f / 64.f;
constexpr unsigned FP8_MOE = 3u;
constexpr unsigned I8_INPROJ = 15u;
constexpr unsigned I8_MOE = 3u;
constexpr unsigned I8_DENSE = 3u;
constexpr unsigned FP8_DENSE = 3u;
constexpr unsigned FP8_DDOWN = 3u;
template <int CTRL, int ROWMASK> __device__ __forceinline__ float dpp_step(float x) {
    return x + __builtin_bit_cast(float, __builtin_amdgcn_update_dpp(0, __builtin_bit_cast(int, x), CTRL, ROWMASK, 0xf, false)); }
__device__ __forceinline__ float wave_sum_dpp(float x) {
    x = dpp_step<0xB1, 0xf>(x); x = dpp_step<0x4E, 0xf>(x); x = dpp_step<0x124, 0xf>(x); x = dpp_step<0x128, 0xf>(x);
    x = dpp_step<0x142, 0xa>(x); x = dpp_step<0x143, 0xc>(x);
    return x; }
__device__ __forceinline__ u32x4 pack8(const float (&v)[8]) { u32x4 w; w.x = cvt_pk_bf16(v[0], v[1]); w.y = cvt_pk_bf16(v[2], v[3]); w.z = cvt_pk_bf16(v[4], v[5]); w.w = cvt_pk_bf16(v[6], v[7]); return w; }

#define XB_TMO      128
#define XB_XCNT(j)  (256  + 64 * (j))
#define XB_XSUB(j)  (1280 + 64 * (j))
#define XB_XGEN(j)  (2304 + 64 * (j))
#define XB_TOP      3328
#define XB_TOPGEN   3392
#define XCD_BAR_WORDS 3456
#define XB_SPIN_CAP (1u << 20)

__device__ __forceinline__ unsigned xb_ld(unsigned* p)              { return __hip_atomic_load(p, __ATOMIC_RELAXED, __HIP_MEMORY_SCOPE_AGENT); }
__device__ __forceinline__ unsigned xb_add(unsigned* p, unsigned v) { return __hip_atomic_fetch_add(p, v, __ATOMIC_RELAXED, __HIP_MEMORY_SCOPE_AGENT); }
__device__ __forceinline__ unsigned xb_xcc_id() { return (unsigned)__builtin_amdgcn_s_getreg((3 << 11) | 20) & 0xFu; }
#define XB_SPIN(cond, bar) do { unsigned _sp = 0; while (cond) { __builtin_amdgcn_s_sleep(1); \
    if ((++_sp & 255u) == 0u) { if (xb_ld(&(bar)[XB_TMO])) break; if (_sp > XB_SPIN_CAP) { atomicAdd(&(bar)[XB_TMO], 1u); break; } } } } while (0)

struct XcdBarrier { unsigned* bar; unsigned x; volatile LAS unsigned* st; int tid; };

__device__ __forceinline__ XcdBarrier xcd_barrier_post(unsigned* bar, volatile LAS unsigned* st) {
    XcdBarrier b; b.bar = bar; b.x = xb_xcc_id(); b.st = st;
    if (threadIdx.x == 0) (void)xb_add(&bar[XB_XCNT(b.x)], 1u);
    return b;
}
__device__ __forceinline__ void xcd_barrier_complete(unsigned* bar, unsigned x, unsigned& nloc, unsigned& nx) {
    const unsigned G = gridDim.x * gridDim.y * gridDim.z;
    unsigned sum, cnt, mine, sp = 0u;
    for (;;) {
        sum = 0u; cnt = 0u; mine = 0u;
#pragma unroll
        for (unsigned j = 0; j < 16; ++j) { const unsigned c = xb_ld(&bar[XB_XCNT(j)]); sum += c; cnt += (c > 0u) ? 1u : 0u; mine = (j == x) ? c : mine; }
        if (sum == G) break;
        __builtin_amdgcn_s_sleep(1);
        if ((++sp & 255u) == 0u) { if (xb_ld(&bar[XB_TMO])) break; if (sp > XB_SPIN_CAP) { atomicAdd(&bar[XB_TMO], 1u); break; } }
    }
    nloc = mine > 0u ? mine : 1u; nx = cnt > 0u ? cnt : 1u;
}
__device__ __forceinline__ void xcd_barrier(const XcdBarrier& b) {
    asm volatile("s_waitcnt vmcnt(0)" ::: "memory");
    __syncthreads();
    if (b.tid == 0) {
        unsigned* bar = b.bar;
        __builtin_amdgcn_s_waitcnt(0);
        unsigned nloc = b.st[0], nx = b.st[1];
        if (nloc == 0u) { xcd_barrier_complete(bar, b.x, nloc, nx); b.st[0] = nloc; b.st[1] = nx; }
        const unsigned old = xb_add(&bar[XB_XSUB(b.x)], 1u);
        const unsigned gen = old / nloc;
        if (old + 1u == (gen + 1u) * nloc) {
            __builtin_amdgcn_fence(__ATOMIC_RELEASE, "agent");
            asm volatile("s_waitcnt vmcnt(0)" ::: "memory");
            const unsigned og = xb_add(&bar[XB_TOP], 1u);
            const unsigned tg = og / nx;
            if (og + 1u == (tg + 1u) * nx) xb_add(&bar[XB_TOPGEN], 1u);
            else XB_SPIN(xb_ld(&bar[XB_TOPGEN]) == tg, bar);
            __builtin_amdgcn_fence(__ATOMIC_ACQUIRE, "agent");
            xb_add(&bar[XB_XGEN(b.x)], 1u);
            asm volatile("s_waitcnt vmcnt(0)" ::: "memory");
        } else {
            XB_SPIN(xb_ld(&bar[XB_XGEN(b.x)]) == gen, bar);
            __builtin_amdgcn_fence(__ATOMIC_ACQUIRE, "agent");
            asm volatile("s_waitcnt vmcnt(0)" ::: "memory");
        }
    }
    __syncthreads();
}
namespace pg8 {
constexpr int BM = 256, BK = 64, HALF = 128, HTB = HALF * BK * 2, STAGE_BYTES = 8 * HTB, NXCD = 8, WGM = 8;
__host__ __device__ __forceinline__ int lds_byte(int r, int c) { const int st = (r >> 4) * 2 + (c >> 5), rr = r & 15, cc = c & 31, ob = rr * 64 + cc * 2; return st * 1024 + (ob ^ (((ob >> 9) & 1) << 5)); }
__host__ __device__ __forceinline__ void stage_rc(int b, int& R, int& C) { const int st = b / 1024, sb = b % 1024, swz = sb ^ (((sb >> 9) & 1) << 5); R = (st >> 1) * 16 + swz / 64; C = (st & 1) * 32 + (swz % 64) / 2; }
__host__ __device__ __forceinline__ int perm32(int rho) { const int n = rho >> 4, i = rho & 15; return 8 * (i >> 2) + 4 * n + (i & 3); }

struct Unit { int pm, pn; };
typedef int i32x4 __attribute__((ext_vector_type(4)));
typedef int i32x8 __attribute__((ext_vector_type(8)));
__device__ __forceinline__ i32x8 cat16(bf16x8 lo, bf16x8 hi) { const i32x4 a = __builtin_bit_cast(i32x4, lo), b = __builtin_bit_cast(i32x4, hi); return __builtin_shufflevector(a, b, 0, 1, 2, 3, 4, 5, 6, 7); }
struct Gemm { const void* A; const void* Bt; int lda, ldb, K, esz; };

struct OrderBase {
    int nM, nN, nwg, G, c;
    __device__ __forceinline__ void init(int nM_, int nN_, int G_, int c_) { nM = nM_; nN = nN_; nwg = nM * nN; G = G_; c = c_; }
    __device__ __forceinline__ bool next(int i, Unit& u) const {
        const long L = (long)i * G + c; if (L >= nwg) return false;
        int wgid = (int)L; { const int q = nwg / NXCD, r = nwg % NXCD, xcd = wgid % NXCD, off = wgid / NXCD; wgid = (xcd < r ? xcd * (q + 1) : r * (q + 1) + (xcd - r) * q) + off; }
        const int nig = WGM * nN, gid = wgid / nig, fm = gid * WGM, gsz = (nM - fm) < WGM ? (nM - fm) : WGM;
        u.pm = fm + ((wgid % nig) % gsz); u.pn = (wgid % nig) / gsz; return true;
    }
};
struct PlainOrder : OrderBase {
    __device__ __forceinline__ const char* b_base(const Gemm& g, const Unit& u) const { return (const char*)g.Bt + (size_t)u.pn * BM * g.ldb * g.esz; }
    __device__ __forceinline__ void a_offs(const Gemm& g, const Unit& u, int R0, int C0, unsigned (&ao)[2][2]) const {
#pragma unroll
        for (int h = 0; h < 2; ++h)
#pragma unroll
            for (int i = 0; i < 2; ++i) ao[h][i] = (unsigned)((u.pm * BM + h * HALF + i * 64 + R0) * g.lda) * (unsigned)g.esz + (unsigned)C0 * 2u;
    }
};
template <bool GATHER> struct MoeOrder : OrderBase {
    const int* tile_e; const int* row_tok; size_t estride;
    int ntl0 = 1 << 30;
    __device__ __forceinline__ bool next(int i, Unit& u) const { if (!OrderBase::next(i, u)) return false; if (u.pm >= ntl0) u.pm += MAX_TILES - ntl0; return true; }
    __device__ __forceinline__ const char* b_base(const Gemm& g, const Unit& u) const {
        const int e = __builtin_amdgcn_readfirstlane(tile_e[u.pm + (u.pm >= MAX_TILES ? 8 : 0)]);
        return (const char*)g.Bt + ((size_t)e * estride + (size_t)u.pn * BM * g.ldb) * g.esz; }
    __device__ __forceinline__ void a_offs(const Gemm& g, const Unit& u, int R0, int C0, unsigned (&ao)[2][2]) const {
#pragma unroll
        for (int h = 0; h < 2; ++h)
#pragma unroll
            for (int i = 0; i < 2; ++i) {
                int r = u.pm * BM + h * HALF + i * 64 + R0;
                if (GATHER) { const int t = row_tok[r]; r = t < 0 ? 0 : t; }
                ao[h][i] = (unsigned)(r * g.lda) * (unsigned)g.esz + (unsigned)C0 * 2u; }
    }
};

template <int MODE, class Epi, class Sched>
__device__ __forceinline__ void gemm_phase(LAS unsigned char* lds, LAS unsigned char* lds_epi, const Gemm g, const Sched& S, const Epi& E, int tid) {
    asm volatile("" : "+v"(tid));
    const int wid = __builtin_amdgcn_readfirstlane(tid >> 6), lane = tid & 63, wr = wid >> 2, wc = wid & 3, fr = lane & 15, fq = lane >> 4;
    constexpr int ESZ = MODE == 2 ? 2 : 1;
    int nt = g.K * ESZ / 128;
    asm volatile("" : "+s"(nt));
    int R0, C0; stage_rc(tid * 16, R0, C0);
    unsigned voffB[2];
#pragma unroll
    for (int i = 0; i < 2; ++i) { const int R = R0 + i * 64; const int Rb = (R & ~31) + perm32(R & 31); voffB[i] = (unsigned)(Rb * g.ldb) * (unsigned)ESZ + (unsigned)C0 * 2u; }
    const size_t kstep = (size_t)(BK * 2);
    const size_t hstepB = (size_t)HALF * g.ldb * ESZ;
    const unsigned ldsw = (unsigned)wid * 1024u;
    const int aoff = lds_byte(wr * 64 + fr, fq * 8), boff = lds_byte(wc * 32 + fr, fq * 8);
    LAS unsigned char* abase = lds + aoff; LAS unsigned char* bbase = lds + 4 * HTB + boff; asm volatile("" : "+v"(abase), "+v"(bbase));
#define PG8_SA(b, h) (((b) * 2 + (h)) * HTB)
#define PG8_SB(b, h) ((4 + (b) * 2 + (h)) * HTB)
#define PG8_STAGE(bufoff, gbase, voff) do { _Pragma("unroll") for (int _i = 0; _i < 2; ++_i) \
        __builtin_amdgcn_global_load_lds((const unsigned*)((const char*)(gbase) + (voff)[_i]), (LAS unsigned*)(lds + (bufoff) + ldsw + _i * 8192), 16, 0, 0); } while (0)
#define PG8_LD16(base, off) (*(const LAS bf16x8*)((base) + (off)))
#define PG8_LDA(dst, b, h) do { if constexpr (MODE != 1) { _Pragma("unroll") for (int m = 0; m < 4; ++m) _Pragma("unroll") for (int k = 0; k < 2; ++k) dst[m][k] = PG8_LD16(abase, PG8_SA(b, h) + m * 2048 + k * 1024); } \
      else { _Pragma("unroll") for (int m = 0; m < 4; ++m) dst##8[m] = cat16(PG8_LD16(abase, PG8_SA(b, h) + m * 2048), PG8_LD16(abase, PG8_SA(b, h) + m * 2048 + 1024)); } } while (0)
#define PG8_LDB(dst, b, h) do { if constexpr (MODE != 1) { _Pragma("unroll") for (int n = 0; n < 2; ++n) _Pragma("unroll") for (int k = 0; k < 2; ++k) dst[n][k] = PG8_LD16(bbase, PG8_SA(b, h) + n * 2048 + k * 1024); } \
      else { _Pragma("unroll") for (int n = 0; n < 2; ++n) dst##8[n] = cat16(PG8_LD16(bbase, PG8_SA(b, h) + n * 2048), PG8_LD16(bbase, PG8_SA(b, h) + n * 2048 + 1024)); } } while (0)
#define PG8_MMA(ai, bj, At, Bt) do { __builtin_amdgcn_s_setprio(1); if constexpr (MODE == 2) { _Pragma("unroll") for (int m = 0; m < 4; ++m) _Pragma("unroll") for (int n = 0; n < 2; ++n) _Pragma("unroll") for (int k = 0; k < 2; ++k) \
        acc[ai][bj][m][n] = __builtin_amdgcn_mfma_f32_16x16x32_bf16(Bt[n][k], At[m][k], acc[ai][bj][m][n], 0, 0, 0); } \
      else if constexpr (MODE == 3) { _Pragma("unroll") for (int m = 0; m < 4; ++m) _Pragma("unroll") for (int n = 0; n < 2; ++n) _Pragma("unroll") for (int k = 0; k < 2; ++k) \
        acc[ai][bj][m][n] = __builtin_bit_cast(f32x4, __builtin_amdgcn_mfma_i32_16x16x64_i8(__builtin_bit_cast(i32x4, Bt[n][k]), __builtin_bit_cast(i32x4, At[m][k]), __builtin_bit_cast(i32x4, acc[ai][bj][m][n]), 0, 0, 0)); } \
      else { _Pragma("unroll") for (int m = 0; m < 4; ++m) _Pragma("unroll") for (int n = 0; n < 2; ++n) \
        asm volatile("s_nop 1\n\tv_mfma_scale_f32_16x16x128_f8f6f4 %0, %1, %2, %0, %3, %3 op_sel_hi:[0,0,0]" : "+v"(acc[ai][bj][m][n]) : "v"(Bt##8[n]), "v"(At##8[m]), "v"(0x7f7f7f7f)); } \
      __builtin_amdgcn_s_setprio(0); } while (0)
#define PG8_WAIT_V(n) asm volatile("s_waitcnt vmcnt(" #n ")" ::: "memory")
#define PG8_WAIT_L(n) asm volatile("s_waitcnt lgkmcnt(" #n ")" ::: "memory")
#define PG8_BAR __builtin_amdgcn_s_barrier()
#define PG8_SCHED __builtin_amdgcn_sched_barrier(0)
    Unit cur, nxt; int ui = 0;
    if (!S.next(0, cur)) return;
    f32x4 acc[2][2][4][2];
#pragma unroll
    for (int a = 0; a < 2; ++a)
#pragma unroll
        for (int b = 0; b < 2; ++b)
#pragma unroll
            for (int m = 0; m < 4; ++m)
#pragma unroll
                for (int n = 0; n < 2; ++n) acc[a][b][m][n] = (f32x4){0.f, 0.f, 0.f, 0.f};
    bf16x8 At[4][2], B0[2][2], B1[2][2]; i32x8 At8[4], B08[2], B18[2];
    unsigned ao[2][2], nao[2][2];
    S.a_offs(g, cur, R0, C0, ao);
    const char* const A0 = (const char*)g.A;
    const char* cB = S.b_base(g, cur);
    int eslot = 0; E.prefetch(cur, lds_epi, 0, wid, fq * 16 + fr);
    PG8_STAGE(PG8_SB(0, 0), cB, voffB); PG8_STAGE(PG8_SB(0, 1), cB + hstepB, voffB); PG8_STAGE(PG8_SA(0, 0), A0, ao[0]); PG8_STAGE(PG8_SA(0, 1), A0, ao[1]);
    if (wr == 1) PG8_BAR;
    PG8_WAIT_V(2); PG8_BAR;
    PG8_STAGE(PG8_SB(1, 0), cB + kstep, voffB); PG8_STAGE(PG8_SA(1, 0), A0 + kstep, ao[0]); PG8_STAGE(PG8_SB(1, 1), cB + hstepB + kstep, voffB);
    PG8_WAIT_V(6); PG8_BAR;
    for (;;) {
        const bool has_next = S.next(ui + 1, nxt);
        const char* nB = cB;
        if (has_next) { S.a_offs(g, nxt, R0, C0, nao); nB = S.b_base(g, nxt); E.prefetch(nxt, lds_epi, eslot == 2 ? 0 : eslot + 1, wid, fq * 16 + fr); }
        else {
#pragma unroll
            for (int h = 0; h < 2; ++h)
#pragma unroll
                for (int i = 0; i < 2; ++i) nao[h][i] = ao[h][i]; }
        for (int t = 0; t < nt; t += 2) {
            const bool last = (t == nt - 2);
            const char* a1 = A0 + (size_t)(t + 1) * kstep;
            const char* a2 = last ? A0 : A0 + (size_t)(t + 2) * kstep; const char* b2 = last ? nB : cB + (size_t)(t + 2) * kstep;
            const char* a3 = a2 + kstep; const char* b3 = b2 + kstep;
            unsigned a2o[2][2];
#pragma unroll
            for (int h = 0; h < 2; ++h)
#pragma unroll
                for (int i = 0; i < 2; ++i) a2o[h][i] = last ? nao[h][i] : ao[h][i];
            PG8_LDB(B0, 0, 0); PG8_LDB(B1, 0, 1); PG8_SCHED; PG8_LDA(At, 0, 0); PG8_STAGE(PG8_SA(1, 1), a1, ao[1]);
            PG8_WAIT_V(8); PG8_WAIT_L(0); PG8_BAR; PG8_MMA(0, 0, At, B0); PG8_MMA(0, 1, At, B1); PG8_BAR; PG8_SCHED;
            PG8_LDA(At, 0, 1); PG8_STAGE(PG8_SB(0, 0), b2, voffB); PG8_STAGE(PG8_SB(0, 1), b2 + hstepB, voffB); PG8_STAGE(PG8_SA(0, 0), a2, a2o[0]);
            PG8_WAIT_V(8); PG8_WAIT_L(0); PG8_BAR; PG8_MMA(1, 0, At, B0); PG8_MMA(1, 1, At, B1); PG8_BAR; PG8_SCHED;
            PG8_LDB(B0, 1, 0); PG8_LDB(B1, 1, 1); PG8_SCHED; PG8_LDA(At, 1, 0); PG8_STAGE(PG8_SA(0, 1), a2, a2o[1]);
            PG8_WAIT_V(8); PG8_WAIT_L(0); PG8_BAR; PG8_MMA(0, 0, At, B0); PG8_MMA(0, 1, At, B1); PG8_BAR; PG8_SCHED;
            PG8_LDA(At, 1, 1); PG8_STAGE(PG8_SB(1, 0), b3, voffB); PG8_STAGE(PG8_SB(1, 1), b3 + hstepB, voffB); PG8_STAGE(PG8_SA(1, 0), a3, a2o[0]);
            PG8_WAIT_V(8); PG8_WAIT_L(0); PG8_BAR; PG8_MMA(1, 0, At, B0); PG8_MMA(1, 1, At, B1); PG8_BAR; PG8_SCHED;
        }
        if constexpr (MODE == 3) {
#pragma unroll
            for (int a = 0; a < 2; ++a)
#pragma unroll
                for (int b = 0; b < 2; ++b)
#pragma unroll
                    for (int m = 0; m < 4; ++m)
#pragma unroll
                        for (int n = 0; n < 2; ++n) acc[a][b][m][n] = __builtin_convertvector(__builtin_bit_cast(i32x4, acc[a][b][m][n]), f32x4);
        }
        if constexpr (MODE == 1) asm volatile("s_nop 15\n\ts_nop 15" ::: "memory");
        if (wr == 0) PG8_BAR;
        E.eslot = eslot; E(acc, cur, wr, wc, fr, fq, lds_epi, tid); eslot = eslot == 2 ? 0 : eslot + 1;
        if (!has_next) break;
#pragma unroll
        for (int a = 0; a < 2; ++a)
#pragma unroll
            for (int b = 0; b < 2; ++b)
#pragma unroll
                for (int m = 0; m < 4; ++m)
#pragma unroll
                    for (int n = 0; n < 2; ++n) acc[a][b][m][n] = (f32x4){0.f, 0.f, 0.f, 0.f};
        cur = nxt; cB = nB; ++ui;
#pragma unroll
        for (int h = 0; h < 2; ++h)
#pragma unroll
            for (int i = 0; i < 2; ++i) ao[h][i] = nao[h][i];
        if (wr == 1) PG8_BAR;
    }
    PG8_WAIT_V(0);
    PG8_BAR;
#undef PG8_SA
#undef PG8_SB
#undef PG8_STAGE
#undef PG8_LD16
#undef PG8_LDA
#undef PG8_LDB
#undef PG8_MMA
#undef PG8_WAIT_V
#undef PG8_WAIT_L
#undef PG8_BAR
#undef PG8_SCHED
}

__device__ __forceinline__ void row_reduce_store(const float (&part)[2][4], LAS unsigned char* lds_epi, int pm, int wr, int wc, int fr, int fq, int tid, float* dst, int slot, const int* rowmap) {
    LAS float* P = (LAS float*)lds_epi;
#pragma unroll
    for (int ai = 0; ai < 2; ++ai)
#pragma unroll
        for (int m = 0; m < 4; ++m) { float s = part[ai][m]; s += __shfl_xor(s, 16); s += __shfl_xor(s, 32);
            if (fq == 0) P[(ai * HALF + wr * 64 + m * 16 + fr) * 4 + wc] = s; }
    asm volatile("s_waitcnt lgkmcnt(0)" ::: "memory"); __builtin_amdgcn_s_barrier(); asm volatile("" ::: "memory");
    if (tid < 256) { const f32x4 p = *(const LAS f32x4*)(P + tid * 4); int r = pm * BM + tid; if (rowmap) r = rowmap[r];
        if (r >= 0) dst[(size_t)r * 4 + slot] = (p.x + p.y) + (p.z + p.w); }
}
__device__ __forceinline__ void st16(bf16_t* p, const float (&v)[8]) { *(u32x4*)p = pack8(v); }
__device__ __forceinline__ void rot_pairs(float (&v)[8], const f32x4 c01, const f32x4 c23) {
    const float c[4] = {c01.x, c01.z, c23.x, c23.z}, s[4] = {c01.y, c01.w, c23.y, c23.w};
#pragma unroll
    for (int i = 0; i < 4; ++i) { const float a = v[2 * i], b = v[2 * i + 1]; v[2 * i] = a * c[i] - b * s[i]; v[2 * i + 1] = b * c[i] + a * s[i]; }
}
__device__ __forceinline__ LAS unsigned char* epi_tab(LAS unsigned char* lds_epi, int slot) { return lds_epi + TAB_REL + slot * TAB_SLOT; }
__device__ __forceinline__ void epi_tab_fetch(const f32x4* sq, const float* sc, int pm, LAS unsigned char* tab, int wid, int lane) {
    asm volatile("" : "+v"(lane));
    pm = __builtin_amdgcn_readfirstlane(pm);
    if (wid < 4) __builtin_amdgcn_global_load_lds((const unsigned*)((const char*)sq + (size_t)(pm * BM + wid * 64) * 16 + (size_t)(unsigned)(lane * 16)), (LAS unsigned*)(tab + wid * 1024), 16, 0, 0);
    else if (sc) __builtin_amdgcn_global_load_lds((const unsigned*)((const char*)sc + (size_t)(pm * BM + (wid - 4) * 64) * 4 + (size_t)(unsigned)(lane * 4)), (LAS unsigned*)(tab + 4096 + (wid - 4) * 256), 4, 0, 0);
}

struct EpiInProj {
    const f32x4* ssqx; bf16_t *QA, *KA, *VA, *CQK, *KB, *Z; float* ssqc; const f32x2* ropeA; const f32x2* ropeB; const float* rowsc;
    mutable int eslot = 0;
    __device__ __forceinline__ void prefetch(const Unit& u, LAS unsigned char* lds_epi, int slot, int wid, int lane) const { epi_tab_fetch(ssqx, rowsc, u.pm, epi_tab(lds_epi, slot), wid, lane); }
    __device__ __forceinline__ void operator()(const f32x4 (&acc)[2][2][4][2], const Unit& u, int wr, int wc, int fr, int fq, LAS unsigned char* lds_epi, int tid) const {
        int cw = wc * 32 + fq * 8; asm volatile("" : "+v"(cw));
        const int row0 = u.pm * BM + wr * 64 + fr;
        float rs[2][4], part[2][4];
        { f32x4 sq[2][4]; const LAS unsigned char* tab = epi_tab(lds_epi, eslot);
#pragma unroll
          for (int ai = 0; ai < 2; ++ai)
#pragma unroll
              for (int m = 0; m < 4; ++m) sq[ai][m] = ((const LAS f32x4*)tab)[ai * HALF + wr * 64 + m * 16 + fr];
#pragma unroll
          for (int ai = 0; ai < 2; ++ai)
#pragma unroll
              for (int m = 0; m < 4; ++m) { const f32x4 s = sq[ai][m]; rs[ai][m] = rsqrtf(((s.x + s.y) + (s.z + s.w)) * (1.0f / DM) + RMS_EPS); part[ai][m] = 0.f; }
          if (rowsc) { float sc[2][4];
#pragma unroll
              for (int ai = 0; ai < 2; ++ai)
#pragma unroll
                  for (int m = 0; m < 4; ++m) sc[ai][m] = ((const LAS float*)(tab + 4096))[ai * HALF + wr * 64 + m * 16 + fr];
#pragma unroll
              for (int ai = 0; ai < 2; ++ai)
#pragma unroll
                  for (int m = 0; m < 4; ++m) rs[ai][m] *= sc[ai][m] * I8_WINV; } }
#pragma unroll
        for (int bj = 0; bj < 2; ++bj) {
            const int ht = u.pn * 2 + bj;
            const float segf = rowsc ? (ht < 3 ? QSCALE_A : ht >= 14 ? 8.0f : 1.0f) : 1.0f;
            bf16_t* dst = nullptr; int pitch = 0; int kind = 0;
            if (ht < 3) { dst = QA + ht * 128 + cw; pitch = 384; kind = 1; }
            else if (ht < 6) { dst = KA + (ht - 3) * 128 + cw; pitch = 384; kind = 1; }
            else if (ht < 9) { dst = VA + (ht - 6) * 128 + cw; pitch = 384; }
            else if (ht < 12) { dst = CQK + (ht - 9) * 128 + cw; pitch = 512; kind = 3; }
            else if (ht == 12) { dst = CQK + 384 + cw; pitch = 512; kind = 3; }
            else if (ht == 13) { kind = 2; }
            else { dst = Z + (ht - 14) * 128 + cw; pitch = 512; }
            const bool rotA = (wc & 1) == 0 && fq < 2;
            const f32x2* tb = kind == 1 ? ropeA + (fq & 1) * 4 : ropeB + fq * 4; const int tp = kind == 1 ? 8 : 16;
#pragma unroll
            for (int ai = 0; ai < 2; ++ai) {
                f32x4 cs[4][2];
                if (kind == 1 || kind == 2) {
#pragma unroll
                    for (int m = 0; m < 4; ++m) { const f32x2* q = tb + (size_t)((row0 + ai * HALF + m * 16) & (SEQ - 1)) * tp; cs[m][0] = *(const f32x4*)q; cs[m][1] = *(const f32x4*)(q + 2); }
                }
#pragma unroll
                for (int m = 0; m < 4; ++m) {
                    const int row = row0 + ai * HALF + m * 16; const float r = rs[ai][m] * segf;
                    float v[8];
#pragma unroll
                    for (int n = 0; n < 2; ++n)
#pragma unroll
                        for (int j = 0; j < 4; ++j) v[4 * n + j] = acc[ai][bj][m][n][j] * r;
                    if (kind == 1) { if (rotA) rot_pairs(v, cs[m][0], cs[m][1]); st16(dst + (size_t)row * pitch, v); }
                    else if (kind == 2) { if (wc == 0) { rot_pairs(v, cs[m][0], cs[m][1]); const u32x4 w = pack8(v);
#pragma unroll
                            for (int h = 0; h < 6; ++h) *(u32x4*)(KB + (size_t)row * 576 + h * 96 + 64 + fq * 8) = w; } }
                    else { if (kind == 3) { float s = 0.f;
#pragma unroll
                            for (int j = 0; j < 8; ++j) s += v[j] * v[j];
                            part[ai][m] += s; }
                        st16(dst + (size_t)row * pitch, v); }
                }
                asm volatile("" ::: "memory");
            }
        }
        if (u.pn >= 4 && u.pn <= 6) row_reduce_store(part, lds_epi, u.pm, wr, wc, fr, fq, tid, ssqc, u.pn - 4, nullptr);
    }
};

struct EpiUp {
    const f32x4* ssqc; bf16_t *QB, *KB, *VB; const f32x2* ropeB; bool isq;
    mutable int eslot = 0;
    __device__ __forceinline__ void prefetch(const Unit& u, LAS unsigned char* lds_epi, int slot, int wid, int lane) const { epi_tab_fetch(ssqc, nullptr, u.pm, epi_tab(lds_epi, slot), wid, lane); }
    __device__ __forceinline__ void operator()(const f32x4 (&acc)[2][2][4][2], const Unit& u, int wr, int wc, int fr, int fq, LAS unsigned char* lds_epi, int tid) const {
        int cw = wc * 32 + fq * 8; asm volatile("" : "+v"(cw));
        const int row0 = u.pm * BM + wr * 64 + fr;
        float rs[2][4];
        { f32x4 sq[2][4];
#pragma unroll
          for (int ai = 0; ai < 2; ++ai)
#pragma unroll
              for (int m = 0; m < 4; ++m) sq[ai][m] = ((const LAS f32x4*)epi_tab(lds_epi, eslot))[ai * HALF + wr * 64 + m * 16 + fr];
#pragma unroll
          for (int ai = 0; ai < 2; ++ai)
#pragma unroll
              for (int m = 0; m < 4; ++m) { const f32x4 s = sq[ai][m]; rs[ai][m] = isq ? rsqrtf((s.x + s.y) * (1.0f / 384.0f) + RMS_EPS) : rsqrtf(s.z * (1.0f / 128.0f) + RMS_EPS); } }
#pragma unroll
        for (int bj = 0; bj < 2; ++bj) {
            const int n0 = u.pn * BM + bj * HALF + cw;
            bf16_t* dst; int pitch; int ropeoff = -1; bool valid = true;
            if (isq) { const int head = n0 / 96, ip = n0 - head * 96; valid = n0 < 576; dst = QB + n0; pitch = 576; if (ip >= 64) ropeoff = (ip - 64) >> 1; }
            else if (n0 < 384) { const int head = n0 >> 6; dst = KB + head * 96 + (n0 & 63); pitch = 576; }
            else { dst = VB + (n0 - 384); pitch = 384; }
            const f32x2* tb = ropeB + (ropeoff < 0 ? 0 : ropeoff);
#pragma unroll
            for (int ai = 0; ai < 2; ++ai) {
                f32x4 cs[4][2];
                if (isq) {
#pragma unroll
                    for (int m = 0; m < 4; ++m) { const f32x2* q = tb + (size_t)((row0 + ai * HALF + m * 16) & (SEQ - 1)) * 16; cs[m][0] = *(const f32x4*)q; cs[m][1] = *(const f32x4*)(q + 2); } }
#pragma unroll
                for (int m = 0; m < 4; ++m) {
                    const int row = row0 + ai * HALF + m * 16; const float r = rs[ai][m];
                    float v[8];
#pragma unroll
                    for (int n = 0; n < 2; ++n)
#pragma unroll
                        for (int j = 0; j < 4; ++j) v[4 * n + j] = acc[ai][bj][m][n][j] * r;
                    if (ropeoff >= 0) rot_pairs(v, cs[m][0], cs[m][1]);
                    if (valid) st16(dst + (size_t)row * pitch, v);
                }
                asm volatile("" ::: "memory");
            }
        }
    }
};

struct EpiResid {
    bf16_t* XM; float* ssqx; unsigned char* XB8; const float* rowsc; float ascale;
    mutable int eslot = 0;
    __device__ __forceinline__ void prefetch(const Unit&, LAS unsigned char*, int, int, int) const {}
    __device__ __forceinline__ void operator()(const f32x4 (&acc)[2][2][4][2], const Unit& u, int wr, int wc, int fr, int fq, LAS unsigned char* lds_epi, int tid) const {
        int cw = wc * 32 + fq * 8; asm volatile("" : "+v"(cw));
        const int row0 = u.pm * BM + wr * 64 + fr, col0 = u.pn * BM + cw;
        float part[2][4];
#pragma unroll
        for (int ai = 0; ai < 2; ++ai)
          {
            u32x4 xr[4][2]; float qs[4] = {1.f, 1.f, 1.f, 1.f};
            if (rowsc) {
#pragma unroll
                for (int mm = 0; mm < 4; ++mm) qs[mm] = rowsc[row0 + ai * HALF + mm * 16]; }
#pragma unroll
            for (int mm = 0; mm < 4; ++mm) { const size_t off = (size_t)(row0 + ai * HALF + mm * 16) * DM + col0;
#pragma unroll
                for (int bj = 0; bj < 2; ++bj) xr[mm][bj] = *(const u32x4*)(XM + off + bj * HALF); }
#pragma unroll
            for (int mm = 0; mm < 4; ++mm) { const int m = mm; const size_t off = (size_t)(row0 + ai * HALF + m * 16) * DM + col0; float s = 0.f; const float iq = __builtin_amdgcn_rcpf(qs[mm]);
#pragma unroll
                for (int bj = 0; bj < 2; ++bj) { const u32x4 xw = xr[mm][bj];
                    const f32x4 x0 = {bf_lo(xw.x), bf_hi(xw.x), bf_lo(xw.y), bf_hi(xw.y)}, x1 = {bf_lo(xw.z), bf_hi(xw.z), bf_lo(xw.w), bf_hi(xw.w)};
                    const f32x4 y0 = x0 + acc[ai][bj][m][0] * ascale, y1 = x1 + acc[ai][bj][m][1] * ascale;
                    u32x4 w; w.x = cvt_pk_bf16(y0.x, y0.y); w.y = cvt_pk_bf16(y0.z, y0.w); w.z = cvt_pk_bf16(y1.x, y1.y); w.w = cvt_pk_bf16(y1.z, y1.w);
                    *(u32x4*)(XM + off + bj * HALF) = w;
                    if (XB8) { u32x2 w8;
                        if (rowsc) { w8.x = pk4_i8(y0.x * iq, y0.y * iq, y0.z * iq, y0.w * iq); w8.y = pk4_i8(y1.x * iq, y1.y * iq, y1.z * iq, y1.w * iq); }
                        else { w8.x = pk4_fp8(y0.x, y0.y, y0.z, y0.w); w8.y = pk4_fp8(y1.x, y1.y, y1.z, y1.w); }
                        *(u32x2*)(XB8 + off + bj * HALF) = w8; }
                    s += (y0.x * y0.x + y0.y * y0.y) + (y0.z * y0.z + y0.w * y0.w) + (y1.x * y1.x + y1.y * y1.y) + (y1.z * y1.z + y1.w * y1.w);
                }
                part[ai][m] = s; }
            asm volatile("" ::: "memory");
          }
        row_reduce_store(part, lds_epi, u.pm, wr, wc, fr, fq, tid, ssqx, u.pn, nullptr);
    }
};

__device__ __forceinline__ float silu_mul(float g, float u) { return g * u * __builtin_amdgcn_rcpf(1.0f + __builtin_amdgcn_exp2f(-1.4426950408889634f * g)); }
struct EpiSwiGLU {
    const f32x4* ssqx; bf16_t* HID; int ldh; const int* rowmap; float ascale; int out8; const float* rowrs; const float* rowsc; mutable int eslot = 0;
    __device__ __forceinline__ void prefetch(const Unit& u, LAS unsigned char* lds_epi, int slot, int wid, int lane) const {
        LAS unsigned char* tab = epi_tab(lds_epi, slot);
        if (rowrs) { if (wid < 4) { asm volatile("" : "+v"(lane)); const int pm = __builtin_amdgcn_readfirstlane(u.pm);
                __builtin_amdgcn_global_load_lds((const unsigned*)((const char*)rowrs + (size_t)(pm * BM + wid * 64) * 4 + (size_t)(unsigned)(lane * 4)), (LAS unsigned*)(tab + wid * 256), 4, 0, 0); } }
        else if (!rowmap) epi_tab_fetch(ssqx, rowsc, u.pm, tab, wid, lane); }
    __device__ __forceinline__ void operator()(const f32x4 (&acc)[2][2][4][2], const Unit& u, int wr, int wc, int fr, int fq, LAS unsigned char* lds_epi, int tid) const {
        int cw = wc * 32 + fq * 8; asm volatile("" : "+v"(cw));
        const int row0 = u.pm * BM + wr * 64 + fr, col0 = u.pn * HALF + cw;
        float rs[2][4];
        if (rowrs) {
            const LAS float* T = (const LAS float*)epi_tab(lds_epi, eslot);
#pragma unroll
            for (int ai = 0; ai < 2; ++ai)
#pragma unroll
                for (int m = 0; m < 4; ++m) rs[ai][m] = T[ai * HALF + wr * 64 + m * 16 + fr] * ascale;
        } else {
            int tok[2][4];
#pragma unroll
            for (int ai = 0; ai < 2; ++ai)
#pragma unroll
                for (int m = 0; m < 4; ++m) { const int row = row0 + ai * HALF + m * 16; tok[ai][m] = rowmap ? rowmap[row] : row; }
            f32x4 sq[2][4]; float sc[2][4];
            if (!rowmap) {
                const LAS unsigned char* tab = epi_tab(lds_epi, eslot);
#pragma unroll
                for (int ai = 0; ai < 2; ++ai)
#pragma unroll
                    for (int m = 0; m < 4; ++m) { const int rr = ai * HALF + wr * 64 + m * 16 + fr; sq[ai][m] = ((const LAS f32x4*)tab)[rr]; sc[ai][m] = rowsc ? ((const LAS float*)(tab + 4096))[rr] : 1.0f; }
            } else {
#pragma unroll
            for (int ai = 0; ai < 2; ++ai)
#pragma unroll
                for (int m = 0; m < 4; ++m) { sq[ai][m] = ssqx[tok[ai][m] < 0 ? 0 : tok[ai][m]]; sc[ai][m] = rowsc ? rowsc[tok[ai][m] < 0 ? 0 : tok[ai][m]] : 1.0f; }
            }
#pragma unroll
            for (int ai = 0; ai < 2; ++ai)
#pragma unroll
                for (int m = 0; m < 4; ++m) { const f32x4 s = sq[ai][m]; const float r = rsqrtf(((s.x + s.y) + (s.z + s.w)) * (1.0f / DM) + RMS_EPS) * (ascale * sc[ai][m]); rs[ai][m] = tok[ai][m] < 0 ? 0.f : r; }
        }
#pragma unroll
        for (int ai = 0; ai < 2; ++ai)
#pragma unroll
            for (int m = 0; m < 4; ++m) {
                const int row = row0 + ai * HALF + m * 16; const float r = rs[ai][m]; const float c1 = -1.4426950408889634f * r, ir2 = __builtin_amdgcn_rcpf(r * r);
                float v[8];
#pragma unroll
                for (int n = 0; n < 2; ++n)
#pragma unroll
                    for (int j = 0; j < 4; ++j) { const float ag = acc[ai][0][m][n][j], au = acc[ai][1][m][n][j];
                        const float e = __builtin_amdgcn_exp2f(ag * c1); v[4 * n + j] = (ag * au) * __builtin_amdgcn_rcpf(__builtin_fmaf(e, ir2, ir2)); }
                if (out8) { u32x2 w8; w8.x = pk4_fp8(v[0], v[1], v[2], v[3]); w8.y = pk4_fp8(v[4], v[5], v[6], v[7]); *(u32x2*)((unsigned char*)HID + (size_t)row * ldh + col0) = w8; }
                else st16(HID + (size_t)row * ldh + col0, v);
            }
    }
};

struct EpiMoeDown {
    bf16_t* XM; float* ssqx; const int* rowmap; const float* rowgate; unsigned char* XB8; const float* rowsc; int last; float ascale;
    mutable int eslot = 0;
    __device__ __forceinline__ void prefetch(const Unit& u, LAS unsigned char* lds_epi, int slot, int wid, int lane) const {
        asm volatile("" : "+v"(lane)); const int pm = __builtin_amdgcn_readfirstlane(u.pm); LAS unsigned char* tab = epi_tab(lds_epi, slot);
        if (wid < 4) __builtin_amdgcn_global_load_lds((const unsigned*)((const char*)rowmap + (size_t)(pm * BM + wid * 64) * 4 + (size_t)(unsigned)(lane * 4)), (LAS unsigned*)(tab + wid * 256), 4, 0, 0);
        else __builtin_amdgcn_global_load_lds((const unsigned*)((const char*)rowgate + (size_t)(pm * BM + (wid - 4) * 64) * 4 + (size_t)(unsigned)(lane * 4)), (LAS unsigned*)(tab + 4096 + (wid - 4) * 256), 4, 0, 0); }
    __device__ __forceinline__ void operator()(const f32x4 (&acc)[2][2][4][2], const Unit& u, int wr, int wc, int fr, int fq, LAS unsigned char* lds_epi, int tid) const {
        int cw = wc * 32 + fq * 8; asm volatile("" : "+v"(cw));
        const int row0 = u.pm * BM + wr * 64 + fr, col0 = u.pn * BM + cw;
        float part[2][4]; int tok[2][4];
#pragma unroll
        for (int ai = 0; ai < 2; ++ai)
#pragma unroll
            for (int m = 0; m < 4; ++m) tok[ai][m] = ((const LAS int*)epi_tab(lds_epi, eslot))[ai * HALF + wr * 64 + m * 16 + fr];
#pragma unroll
        for (int ai = 0; ai < 2; ++ai)
          {
            u32x4 xr[4][2]; float gt[4], qs[4] = {1.f, 1.f, 1.f, 1.f};
#pragma unroll
            for (int mm = 0; mm < 4; ++mm) gt[mm] = ((const LAS float*)(epi_tab(lds_epi, eslot) + 4096))[ai * HALF + wr * 64 + mm * 16 + fr] * ascale;
            if (XB8) {
#pragma unroll
                for (int mm = 0; mm < 4; ++mm) { const int tk = tok[ai][mm]; qs[mm] = rowsc[tk < 0 ? 0 : tk]; } }
#pragma unroll
            for (int mm = 0; mm < 4; ++mm) { const int m = mm; const size_t off = (size_t)(tok[ai][m] < 0 ? 0 : tok[ai][m]) * DM + col0;
#pragma unroll
                for (int bj = 0; bj < 2; ++bj) xr[mm][bj] = *(const u32x4*)(XM + off + bj * HALF); }
#pragma unroll
            for (int mm = 0; mm < 4; ++mm) { const int m = mm; const int tk = tok[ai][m]; const float g1 = gt[mm]; float s = 0.f; const float iq = __builtin_amdgcn_rcpf(qs[mm]);
                if (tk >= 0) { const size_t off = (size_t)tk * DM + col0;
#pragma unroll
                    for (int bj = 0; bj < 2; ++bj) { const u32x4 xw = xr[mm][bj];
                        const f32x4 x0 = {bf_lo(xw.x), bf_hi(xw.x), bf_lo(xw.y), bf_hi(xw.y)}, x1 = {bf_lo(xw.z), bf_hi(xw.z), bf_lo(xw.w), bf_hi(xw.w)};
                        const f32x4 y0 = x0 + acc[ai][bj][m][0] * g1, y1 = x1 + acc[ai][bj][m][1] * g1;
                        u32x4 w; w.x = cvt_pk_bf16(y0.x, y0.y); w.y = cvt_pk_bf16(y0.z, y0.w); w.z = cvt_pk_bf16(y1.x, y1.y); w.w = cvt_pk_bf16(y1.z, y1.w);
                        *(u32x4*)(XM + off + bj * HALF) = w;
                        if (last) {
                            if (XB8) { u32x2 w8; w8.x = pk4_i8(y0.x * iq, y0.y * iq, y0.z * iq, y0.w * iq); w8.y = pk4_i8(y1.x * iq, y1.y * iq, y1.z * iq, y1.w * iq); *(u32x2*)(XB8 + off + bj * HALF) = w8; }
                            s += (y0.x * y0.x + y0.y * y0.y) + (y0.z * y0.z + y0.w * y0.w) + (y1.x * y1.x + y1.y * y1.y) + (y1.z * y1.z + y1.w * y1.w); }
                    } }
                part[ai][m] = s; }
            asm volatile("" ::: "memory");
          }
        if (last) row_reduce_store(part, lds_epi, u.pm, wr, wc, fr, fq, tid, ssqx, u.pn, rowmap);
    }
};
struct EpiNull { float* sink; mutable int eslot = 0;
    __device__ __forceinline__ void prefetch(const Unit&, LAS unsigned char*, int, int, int) const {}
    __device__ __forceinline__ void operator()(const f32x4 (&acc)[2][2][4][2], const Unit& u, int wr, int wc, int fr, int fq, LAS unsigned char* lds_epi, int tid) const {
        f32x4 s = {0.f, 0.f, 0.f, 0.f};
#pragma unroll
        for (int ai = 0; ai < 2; ++ai)
#pragma unroll
            for (int bj = 0; bj < 2; ++bj)
#pragma unroll
                for (int m = 0; m < 4; ++m) { s += acc[ai][bj][m][0]; s += acc[ai][bj][m][1]; }
        if ((s.x + s.y) + (s.z + s.w) == 12345.678f) sink[tid] = s.x;
    }
};
}
namespace att {
__device__ __forceinline__ int crow(int r, int hi) { return (r & 3) + 8 * (r >> 2) + 4 * hi; }
__device__ __forceinline__ bf16x8 ld8(const bf16_t* p) { return *reinterpret_cast<const bf16x8*>(p); }
constexpr float THR = 8.f;
__device__ __forceinline__ void partialSM(f32x16& p0, f32x16& p1, float& m_reg, float& alpha) {
    float pmax = p0[0];
#pragma unroll
    for (int r = 1; r < 16; ++r) pmax = fmaxf(pmax, p0[r]);
#pragma unroll
    for (int r = 0; r < 16; ++r) pmax = fmaxf(pmax, p1[r]);
    { auto rr = __builtin_amdgcn_permlane32_swap(__float_as_uint(pmax), __float_as_uint(pmax), false, false);
      pmax = fmaxf(__uint_as_float(rr[0]), __uint_as_float(rr[1])); }
    float mn;
    if (__builtin_expect(__all(pmax - m_reg <= THR), 1)) { mn = m_reg; alpha = 1.f; }
    else { mn = fmaxf(m_reg, pmax); alpha = __builtin_amdgcn_exp2f(m_reg - mn); m_reg = mn; }
#pragma unroll
    for (int r = 0; r < 16; ++r) p0[r] = p0[r] - mn;
#pragma unroll
    for (int r = 0; r < 16; ++r) p1[r] = p1[r] - mn;
#pragma unroll
    for (int r = 0; r < 16; ++r) p0[r] = __builtin_amdgcn_exp2f(p0[r]);
}
template <bool FIRST>
__device__ __forceinline__ void partialSM_neg(f32x16& p0, f32x16& p1, float& m_reg, f32x16& negm, float& alpha) {
    float pmax = p0[0];
#pragma unroll
    for (int r = 1; r < 16; ++r) pmax = fmaxf(pmax, p0[r]);
#pragma unroll
    for (int r = 0; r < 16; ++r) pmax = fmaxf(pmax, p1[r]);
    { auto rr = __builtin_amdgcn_permlane32_swap(__float_as_uint(pmax), __float_as_uint(pmax), false, false);
      pmax = fmaxf(__uint_as_float(rr[0]), __uint_as_float(rr[1])); }
    if (!FIRST && __builtin_expect(__all(pmax <= THR), 1)) { alpha = 1.f; }
    else { const float dl = FIRST ? pmax : fmaxf(pmax, 0.f); m_reg += dl;
#pragma unroll
        for (int r = 0; r < 16; ++r) { p0[r] -= dl; p1[r] -= dl; }
        const float nm = -m_reg;
#pragma unroll
        for (int r = 0; r < 16; ++r) negm[r] = nm;
        alpha = FIRST ? 1.f : __builtin_amdgcn_exp2f(-dl); }
#pragma unroll
    for (int r = 0; r < 16; ++r) p0[r] = __builtin_amdgcn_exp2f(p0[r]);
}
__device__ __forceinline__ void finishSM(f32x16& p0, f32x16& p1, float alpha, float& l_reg, bf16x8& pa0, bf16x8& pa1, bf16x8& pa2, bf16x8& pa3) {
#pragma unroll
    for (int r = 0; r < 16; ++r) p1[r] = __builtin_amdgcn_exp2f(p1[r]);
    float ps = 0;
#pragma unroll
    for (int r = 0; r < 16; ++r) ps += p0[r];
#pragma unroll
    for (int r = 0; r < 16; ++r) ps += p1[r];
    { auto rr = __builtin_amdgcn_permlane32_swap(__float_as_uint(ps), __float_as_uint(ps), false, false);
      ps = __uint_as_float(rr[0]) + __uint_as_float(rr[1]); }
    l_reg = l_reg * alpha + ps;
#define PK4(P, BASE, OUT) do { unsigned a0 = cvt_pk_bf16(P[BASE + 0], P[BASE + 1]), a1 = cvt_pk_bf16(P[BASE + 2], P[BASE + 3]);   \
    unsigned b0 = cvt_pk_bf16(P[BASE + 4], P[BASE + 5]), b1 = cvt_pk_bf16(P[BASE + 6], P[BASE + 7]);                              \
    auto r0 = __builtin_amdgcn_permlane32_swap(a0, b0, false, false); auto r1 = __builtin_amdgcn_permlane32_swap(a1, b1, false, false); \
    u32x4 w = {r0[0], r1[0], r0[1], r1[1]}; OUT = *reinterpret_cast<bf16x8*>(&w); } while (0)
    PK4(p0, 0, pa0); PK4(p0, 8, pa1); PK4(p1, 0, pa2); PK4(p1, 8, pa3);
#undef PK4
}
__device__ __forceinline__ void finishSM_ns(f32x16& p0, f32x16& p1, float alpha, float& l_reg, bf16x8& pa0, bf16x8& pa1, bf16x8& pa2, bf16x8& pa3) {
#pragma unroll
    for (int r = 0; r < 16; ++r) p1[r] = __builtin_amdgcn_exp2f(p1[r]);
    float ps = 0;
#pragma unroll
    for (int r = 0; r < 16; ++r) ps += p0[r];
#pragma unroll
    for (int r = 0; r < 16; ++r) ps += p1[r];
    { auto rr = __builtin_amdgcn_permlane32_swap(__float_as_uint(ps), __float_as_uint(ps), false, false);
      ps = __uint_as_float(rr[0]) + __uint_as_float(rr[1]); }
    l_reg = l_reg * alpha + ps;
#define PK4N(P, BASE, OUT) do { u32x4 w = {cvt_pk_bf16(P[BASE + 0], P[BASE + 1]), cvt_pk_bf16(P[BASE + 2], P[BASE + 3]), cvt_pk_bf16(P[BASE + 4], P[BASE + 5]), cvt_pk_bf16(P[BASE + 6], P[BASE + 7])}; \
    OUT = *reinterpret_cast<bf16x8*>(&w); } while (0)
    PK4N(p0, 0, pa0); PK4N(p0, 8, pa1); PK4N(p1, 0, pa2); PK4N(p1, 8, pa3);
#undef PK4N
}
template <int NCG> __device__ __forceinline__ int v_st_ns(int k, int c) { return ((k >> 3) * NCG + (c >> 5)) * 512 + ((k & 7) * 32 + (c & 31)) * 2; }
template <int NCG> __device__ __forceinline__ int v_st(int k, int c) { const int kk = (k & ~0xC) | ((k & 4) << 1) | ((k & 8) >> 1); return ((kk >> 3) * NCG + (c >> 5)) * 512 + ((kk & 7) * 32 + (c & 31)) * 2; }
__device__ __forceinline__ int v_rd_base(int lane) { return ((lane & 3) << 3) | (((lane >> 2) & 3) << 6) | (((lane >> 4) & 1) << 5) | (((lane >> 5) & 1) << 8); }
template <int OFF> __device__ __forceinline__ s16x4 tr_read(int vb) { s16x4 r; asm volatile("ds_read_b64_tr_b16 %0, %1 offset:%2" : "=&v"(r) : "v"(vb), "i"(OFF) : "memory"); return r; }
template <int NCG, int D0> __device__ __forceinline__ void pv_one(f32x16& od, int vb, bf16x8 pa0, bf16x8 pa1, bf16x8 pa2, bf16x8 pa3) {
    constexpr int HS = NCG * 512, KS = 2 * HS, O = D0 * 512;
    const s16x4 l0 = tr_read<O>(vb), h0 = tr_read<O + HS>(vb), l1 = tr_read<O + KS>(vb), h1 = tr_read<O + KS + HS>(vb);
    const s16x4 l2 = tr_read<O + 2 * KS>(vb), h2 = tr_read<O + 2 * KS + HS>(vb), l3 = tr_read<O + 3 * KS>(vb), h3 = tr_read<O + 3 * KS + HS>(vb);
    asm volatile("s_waitcnt lgkmcnt(0)" ::: "memory"); SBAR();
#define PK(L, H) (bf16x8){L[0], L[1], L[2], L[3], H[0], H[1], H[2], H[3]}
    od = __builtin_amdgcn_mfma_f32_32x32x16_bf16(pa0, PK(l0, h0), od, 0, 0, 0);
    od = __builtin_amdgcn_mfma_f32_32x32x16_bf16(pa1, PK(l1, h1), od, 0, 0, 0);
    od = __builtin_amdgcn_mfma_f32_32x32x16_bf16(pa2, PK(l2, h2), od, 0, 0, 0);
    od = __builtin_amdgcn_mfma_f32_32x32x16_bf16(pa3, PK(l3, h3), od, 0, 0, 0);
#undef PK
}
__device__ __forceinline__ u32x4 ld16_sys(const void* p) { u32x4 v; asm volatile("global_load_dwordx4 %0, %1, off sc0 sc1\n\ts_waitcnt vmcnt(0)" : "=v"(v) : "v"(p) : "memory"); return v; }

template <class RowPtr>
__device__ __forceinline__ void head_tail(const f32x16 (&o)[2], float l_reg, float* wsf, bf16_t* stg, int lane, int r32, int hi, float (&ss)[4], const RowPtr& rowptr) {
    if (hi == 0) wsf[r32] = l_reg; asm volatile("s_waitcnt lgkmcnt(0)" ::: "memory");
    float rli[16];
#pragma unroll
    for (int r = 0; r < 16; ++r) rli[r] = __builtin_amdgcn_rcpf(wsf[crow(r, hi)]);
#pragma unroll
    for (int r = 0; r < 16; ++r) { const int orow = crow(r, hi);
#pragma unroll
        for (int d0 = 0; d0 < 2; ++d0) stg[orow * 64 + d0 * 32 + r32] = (bf16_t)f2bf(o[d0][r] * rli[r]); }
    asm volatile("s_waitcnt lgkmcnt(0)" ::: "memory");
#pragma unroll
    for (int i = 0; i < 4; ++i) { const int row = i * 8 + (lane >> 3), ch = lane & 7; const u32x4 v = *(const u32x4*)(stg + row * 64 + ch * 8);
        *(u32x4*)(rowptr(i) + ch * 8) = v;
        float s = 0.f;
#pragma unroll
        for (int j = 0; j < 4; ++j) { const float a = bflo(v[j]), b = bfhi(v[j]); s += a * a + b * b; }
        ss[i] += s; }
    asm volatile("s_waitcnt lgkmcnt(0)" ::: "memory");
}
__device__ __forceinline__ u32x4 ld16_dev(const void* p) {
    const unsigned long long a = __hip_atomic_load((const unsigned long long*)p, __ATOMIC_RELAXED, __HIP_MEMORY_SCOPE_AGENT), b = __hip_atomic_load((const unsigned long long*)p + 1, __ATOMIC_RELAXED, __HIP_MEMORY_SCOPE_AGENT);
    u32x4 v; v.x = (unsigned)a; v.y = (unsigned)(a >> 32); v.z = (unsigned)b; v.w = (unsigned)(b >> 32); return v; }
template <class RowPtr>
__device__ __forceinline__ void group_norm_rows(float (&ss)[4], int lane, const RowPtr& rowptr  ) {
    float rstd[4];
#pragma unroll
    for (int i = 0; i < 4; ++i) { float s = ss[i]; s += __shfl_xor(s, 1); s += __shfl_xor(s, 2); s += __shfl_xor(s, 4); rstd[i] = rsqrtf(s * (1.0f / 384.0f) + RMS_EPS); }
    asm volatile("s_waitcnt vmcnt(0)" ::: "memory");
#pragma unroll
    for (int hb = 0; hb < 6; hb += 2) {
        u32x4 v[2][4];
#pragma unroll
        for (int h = 0; h < 2; ++h)
#pragma unroll
            for (int i = 0; i < 4; ++i) v[h][i] = ld16_dev(rowptr(i, hb + h) + (lane & 7) * 8);
#pragma unroll
        for (int h = 0; h < 2; ++h)
#pragma unroll
            for (int i = 0; i < 4; ++i) { bf16_t* p = rowptr(i, hb + h) + (lane & 7) * 8; u32x4 w;
#pragma unroll
                for (int j = 0; j < 4; ++j) w[j] = cvt_pk_bf16(bflo(v[h][i][j]) * rstd[i], bfhi(v[h][i][j]) * rstd[i]);
                *(u32x4*)p = w; }
    }
}

constexpr int KP = 208;
constexpr int SHM_K = 64 * KP, SHM_V = 8192;
constexpr int SLOT = 2 * SHM_K + 2 * SHM_V, L_WS = 3 * SLOT, MLA_LDS = L_WS + 8 * 384;
__device__ __forceinline__ void qkt96(f32x16& p0, f32x16& p1, const char* Ks, const bf16x8* qr, const f32x16& negm, int r32, int hi) {
#pragma unroll
    for (int d0 = 0; d0 < 6; ++d0) { const int cb = (d0 * 16 + hi * 8) * 2;
        const bf16x8 b0 = *reinterpret_cast<const bf16x8*>(Ks + r32 * KP + cb);
        const bf16x8 b1 = *reinterpret_cast<const bf16x8*>(Ks + (32 + r32) * KP + cb);
        if (d0 == 0) { p0 = __builtin_amdgcn_mfma_f32_32x32x16_bf16(b0, qr[0], negm, 0, 0, 0); p1 = __builtin_amdgcn_mfma_f32_32x32x16_bf16(b1, qr[0], negm, 0, 0, 0); }
        else { p0 = __builtin_amdgcn_mfma_f32_32x32x16_bf16(b0, qr[d0], p0, 0, 0, 0); p1 = __builtin_amdgcn_mfma_f32_32x32x16_bf16(b1, qr[d0], p1, 0, 0, 0); } }
}
__device__ __forceinline__ void mla_unit(int b, int qt, const bf16_t* __restrict__ QB, const bf16_t* __restrict__ KB, const bf16_t* __restrict__ VB, bf16_t* MIX, char* lds, int tid) {
    asm volatile("" : "+v"(tid));
    const int wid = __builtin_amdgcn_readfirstlane(tid >> 6), lane = tid & 63, r32 = lane & 31, hi = lane >> 5;
    float* wsf = (float*)(lds + L_WS) + wid * 96; float* al_l = wsf + 32; float* ssrow = wsf + 64;
    bf16_t* stg = (bf16_t*)lds + wid * 2048;
    const long rowbase = (long)b * SEQ; const int q0 = qt * 256 + wid * 32;
    int kgo[3], klo[3], vgo[2], vlo[2];
#pragma unroll
    for (int i = 0; i < 3; ++i) { const int p = tid + 512 * i, row = p / 12, c = p - row * 12; kgo[i] = row * 576 + c * 8; klo[i] = (row >> 6) * SHM_K + (row & 63) * KP + c * 16; }
#pragma unroll
    for (int i = 0; i < 2; ++i) { const int p = tid + 512 * i, row = p >> 3, c = p & 7; vgo[i] = row * 384 + c * 8; vlo[i] = 2 * SHM_K + (row >> 6) * SHM_V + v_st_ns<2>(row & 63, c * 8); }
    const int vrd = (int)(uintptr_t)lds + v_rd_base(lane);
    if (lane < 32) ssrow[lane] = 0.f;
    constexpr int NP = SEQ / 128;
    if (wid >= 4) __builtin_amdgcn_s_setprio(1);
    bf16x8 ks[3], vs[2];
    for (int h = 0; h < 6; ++h) {
        const bf16_t* Qw = QB + (rowbase + q0 + r32) * 576 + h * 96 + hi * 8;
        const bf16_t* Kh = KB + rowbase * 576 + h * 96; const bf16_t* Vh = VB + rowbase * 384 + h * 64;
        bf16x8 qr[6];
#pragma unroll
        for (int d0 = 0; d0 < 6; ++d0) qr[d0] = ld8(Qw + d0 * 16);
        float m_reg = 0.f, l_reg = 0; f32x16 o[2] = {}; f32x16 negm = {};

#define SLOAD(P) do { _Pragma("unroll") for (int i = 0; i < 3; ++i) ks[i] = ld8(Kh + (long)(P) * (128 * 576) + kgo[i]); _Pragma("unroll") for (int i = 0; i < 2; ++i) vs[i] = ld8(Vh + (long)(P) * (128 * 384) + vgo[i]); } while (0)
#define SWRITE(sl) do { char* sb_ = lds + (sl) * SLOT; _Pragma("unroll") for (int i = 0; i < 3; ++i) *(bf16x8*)(sb_ + klo[i]) = ks[i]; _Pragma("unroll") for (int i = 0; i < 2; ++i) *(bf16x8*)(sb_ + vlo[i]) = vs[i]; } while (0)
#define KT(sl, sub) (lds + (sl) * SLOT + (sub) * SHM_K)
#define VT(sl, sub) (vrd + (sl) * SLOT + 2 * SHM_K + (sub) * SHM_V)
#define RESC(a) do { if (__any((a) < 1.f)) { if (hi == 0) al_l[r32] = (a); asm volatile("s_waitcnt lgkmcnt(0)" ::: "memory"); \
        _Pragma("unroll") for (int d = 0; d < 2; ++d) _Pragma("unroll") for (int r = 0; r < 16; ++r) o[d][r] *= al_l[crow(r, hi)]; } } while (0)
#define PV2(vb) do { pv_one<2, 0>(o[0], (vb), pa0, pa1, pa2, pa3); pv_one<2, 1>(o[1], (vb), pa0, pa1, pa2, pa3); } while (0)
        f32x16 pA0, pA1, pB0, pB1; float alA, alB; bf16x8 pa0, pa1, pa2, pa3;
        int s0 = 0, s1 = 1, s2 = 2;
        if (h == 0) SLOAD(0);
        SWRITE(0); SLOAD(1); __syncthreads();
        qkt96(pA0, pA1, KT(0, 0), qr, negm, r32, hi); partialSM_neg<true>(pA0, pA1, m_reg, negm, alA);
        SWRITE(1); SLOAD(2); __syncthreads();
        for (int J = 0; J < NP - 1; ++J) {
            if (J + 2 < NP) SWRITE(s2); if (J + 3 < NP) SLOAD(J + 3);
            SBAR(); qkt96(pB0, pB1, KT(s0, 1), qr, negm, r32, hi);
            finishSM_ns(pA0, pA1, alA, l_reg, pa0, pa1, pa2, pa3); SBAR();
            PV2(VT(s0, 0)); partialSM_neg<false>(pB0, pB1, m_reg, negm, alB);
            RESC(alB);
            SBAR(); qkt96(pA0, pA1, KT(s1, 0), qr, negm, r32, hi);
            finishSM_ns(pB0, pB1, alB, l_reg, pa0, pa1, pa2, pa3); SBAR();
            PV2(VT(s0, 1)); partialSM_neg<false>(pA0, pA1, m_reg, negm, alA);
            RESC(alA); __syncthreads();
            { const int t_ = s0; s0 = s1; s1 = s2; s2 = t_; }
        }
        if (h + 1 < 6) {
#pragma unroll
            for (int i = 0; i < 3; ++i) ks[i] = ld8(Kh + 96 + kgo[i]);
#pragma unroll
            for (int i = 0; i < 2; ++i) vs[i] = ld8(Vh + 64 + vgo[i]); }
        SBAR(); qkt96(pB0, pB1, KT(s0, 1), qr, negm, r32, hi);
        finishSM_ns(pA0, pA1, alA, l_reg, pa0, pa1, pa2, pa3); SBAR();
        PV2(VT(s0, 0)); partialSM_neg<false>(pB0, pB1, m_reg, negm, alB);
        RESC(alB);
        finishSM_ns(pB0, pB1, alB, l_reg, pa0, pa1, pa2, pa3); SBAR();
        PV2(VT(s0, 1));
#undef KT
#undef VT
#undef RESC
#undef PV2
#undef SLOAD
#undef SWRITE
        __syncthreads();
        bf16_t* obase = MIX + (rowbase + q0) * 1024 + 384 + h * 64;
        { float ssh[4] = {0.f, 0.f, 0.f, 0.f};
          head_tail(o, l_reg, wsf, stg, lane, r32, hi, ssh, [&](int i) { return obase + (long)(i * 8 + (lane >> 3)) * 1024; });
#pragma unroll
          for (int i = 0; i < 4; ++i) { float t = ssh[i]; t += __shfl_xor(t, 1); t += __shfl_xor(t, 2); t += __shfl_xor(t, 4); if ((lane & 7) == 0) ssrow[i * 8 + (lane >> 3)] += t; } }
        __syncthreads();
    }
    __builtin_amdgcn_s_setprio(0);
    { int ln = lane; asm volatile("" : "+v"(ln));
      int q0l = q0; asm volatile("" : "+v"(q0l));
      bf16_t* obase = MIX + (rowbase + q0l) * 1024 + 384; float ss[4];
      asm volatile("s_waitcnt lgkmcnt(0)" ::: "memory");
#pragma unroll
      for (int i = 0; i < 4; ++i) ss[i] = ssrow[i * 8 + (ln >> 3)] * 0.125f;
      group_norm_rows(ss, ln, [&](int i, int h) { return obase + (long)(i * 8 + (ln >> 3)) * 1024 + h * 64; }); }
}

constexpr int DL_X = 0, DL_ML = 65536, DL_V = 67584, DL_WS = 133120, DIL_LDS = 135168;
template <int SH>
__device__ __forceinline__ void dil_loadk(bf16x8 (&kf)[2][4], int kb, const bf16_t* __restrict__ Kb, int r32, int hi) {
    kb = __builtin_amdgcn_readfirstlane(kb);
    const char* kbase = (const char*)Kb + ((long)kb << SH) * 768; const unsigned koff = (unsigned)((r32 << SH) * 768 + hi * 16);
#pragma unroll
    for (int hf = 0; hf < 2; ++hf)
#pragma unroll
        for (int d0 = 0; d0 < 4; ++d0) kf[hf][d0] = *(const bf16x8*)(kbase + (size_t)(hf * ((32 << SH) * 768) + d0 * 32) + (size_t)koff);
}
template <int SH>
__device__ __forceinline__ void dil_tile(int kb, int qidx, bf16x8 (&kf)[2][4], bool nv, bool inside, const bf16_t* __restrict__ Kb, const bf16_t* __restrict__ Vb, const bf16x8 (&qr)[4], float& m_reg, float& l_reg, f32x16 (&o)[2],
                                         char* V_lds, int vb0, float* al_l, int lane, int r32, int hi) {
    constexpr int L = SEQ >> SH;
    { const int kbu = __builtin_amdgcn_readfirstlane(kb);
      const char* vbase = (const char*)Vb + ((long)kbu << SH) * 768; const unsigned voff = (unsigned)((((lane & 31) >> 2) << SH) * 768 + ((lane >> 5) * 32 + (lane & 3) * 8) * 2);
      LAS unsigned char* vdst = (LAS unsigned char*)(unsigned)(uintptr_t)V_lds;
#pragma unroll
      for (int j = 0; j < 8; ++j) __builtin_amdgcn_global_load_lds((const unsigned*)(vbase + (size_t)(j * ((8 << SH) * 768)) + (size_t)voff), (LAS unsigned*)(vdst + j * 1024), 16, 0, 0); }
    f32x16 p0 = {}, p1 = {};
#pragma unroll
    for (int d0 = 0; d0 < 4; ++d0) { p0 = __builtin_amdgcn_mfma_f32_32x32x16_bf16(kf[0][d0], qr[d0], p0, 0, 0, 0); p1 = __builtin_amdgcn_mfma_f32_32x32x16_bf16(kf[1][d0], qr[d0], p1, 0, 0, 0); }
    if (nv) dil_loadk<SH>(kf, kb + 64, Kb, r32, hi);
    const int rel = kb - qidx + 64 + 4 * hi;
    if (inside && kb >= 0 && kb + 63 < L) {
    } else if (kb < 0 || kb + 63 >= L) {
#pragma unroll
        for (int r = 0; r < 16; ++r) { const int cr = (r & 3) + 8 * (r >> 2); const int k0 = kb + 4 * hi + cr, k1 = k0 + 32;
            const bool v0 = (unsigned)(rel + cr) <= 128u && (unsigned)k0 < (unsigned)L, v1 = (unsigned)(rel + cr + 32) <= 128u && (unsigned)k1 < (unsigned)L;
            p0[r] = v0 ? p0[r] : -INFINITY; p1[r] = v1 ? p1[r] : -INFINITY; }
    } else {
#pragma unroll
        for (int r = 0; r < 16; ++r) { const int cr = (r & 3) + 8 * (r >> 2);
            p0[r] = (unsigned)(rel + cr) <= 128u ? p0[r] : -INFINITY; p1[r] = (unsigned)(rel + cr + 32) <= 128u ? p1[r] : -INFINITY; }
    }
    float alpha; bf16x8 pa0, pa1, pa2, pa3;
    partialSM(p0, p1, m_reg, alpha);
    finishSM_ns(p0, p1, alpha, l_reg, pa0, pa1, pa2, pa3);
    if (__any(alpha < 1.f)) { if (hi == 0) al_l[r32] = alpha; asm volatile("s_waitcnt lgkmcnt(0)" ::: "memory");
#pragma unroll
        for (int d = 0; d < 2; ++d)
#pragma unroll
            for (int r = 0; r < 16; ++r) o[d][r] *= al_l[crow(r, hi)]; }
    if (nv) asm volatile("s_waitcnt vmcnt(8) lgkmcnt(0)" ::: "memory"); else asm volatile("s_waitcnt vmcnt(0) lgkmcnt(0)" ::: "memory");
    pv_one<2, 0>(o[0], vb0, pa0, pa1, pa2, pa3); pv_one<2, 1>(o[1], vb0, pa0, pa1, pa2, pa3);
}
__device__ __forceinline__ void dil_unit(int b, int iblk, int h8, const bf16_t* __restrict__ QA, const bf16_t* __restrict__ KA, const bf16_t* __restrict__ VA, bf16_t* MIX, char* lds, int tid_) {
    asm volatile("" : "+v"(tid_));
    const int lane = tid_ & 63, r32 = lane & 31, hi = lane >> 5, w = __builtin_amdgcn_readfirstlane(tid_ >> 6);
    float* X = (float*)(lds + DL_X); float* ML = (float*)(lds + DL_ML);
    char* V_lds = lds + DL_V + w * 8192; bf16_t* stg = (bf16_t*)V_lds; float* wsf = (float*)(lds + DL_WS) + w * 64; float* al_l = wsf + 32;
    const long rowbase = (long)b * SEQ;
    const int vb0 = (int)(uintptr_t)V_lds + v_rd_base(lane);
    const int rho = 8 * h8 + w;
    float ss[4] = {0.f, 0.f, 0.f, 0.f};
    const int lane_o = lane;
    for (int h = 0; h < 6; ++h) {
        float m_reg = -1e30f, l_reg = 0; f32x16 o[2] = {};
        bf16x8 qr[4];
        const bf16_t* Kh = KA + rowbase * 384 + h * 64; const bf16_t* Vh = VA + rowbase * 384 + h * 64;
        int ln1 = lane_o; asm volatile("" : "+v"(ln1));
        {   const int lane = ln1, r32 = ln1 & 31, hi = ln1 >> 5;
            const int a = r32 >> 3, c = r32 & 7, pos = 16 * (32 * iblk + 4 * w + a) + 8 * h8 + c;
            const bf16_t* Qw = QA + (rowbase + pos) * 384 + h * 64 + hi * 8;
#pragma unroll
            for (int d0 = 0; d0 < 4; ++d0) qr[d0] = ld8(Qw + d0 * 16);
            const int kb0 = 16 * (32 * iblk + 4 * w) + 8 * h8 - 64;
            { bf16x8 kf[2][4]; int t = kb0 + 63 >= 0 ? 0 : (-kb0) >> 6;
              if (t < 3 && kb0 + 64 * t < SEQ) dil_loadk<0>(kf, kb0 + 64 * t, Kh, r32, hi);
#pragma unroll 1
              for (; t < 3 && kb0 + 64 * t < SEQ; ++t) { const int kb = kb0 + 64 * t; const bool nv = t + 1 < 3 && kb + 64 < SEQ;
                  dil_tile<0>(kb, pos, kf, nv, t == 1, Kh, Vh, qr, m_reg, l_reg, o, V_lds, vb0, al_l, lane, r32, hi); } }
#pragma unroll
            for (int r = 0; r < 16; ++r) { const int q = crow(r, hi); float* xp = X + ((q & 7) * 32 + 4 * w + (q >> 3)) * 64 + r32; xp[0] = o[0][r]; xp[32] = o[1][r]; }
            if (hi == 0) { ML[c * 32 + 4 * w + a] = m_reg; ML[256 + c * 32 + 4 * w + a] = l_reg; }
        }
        asm volatile("s_waitcnt lgkmcnt(0)" ::: "memory"); __syncthreads();
        int ln2 = lane_o; asm volatile("" : "+v"(ln2));
        {   const int lane = ln2, r32 = ln2 & 31, hi = ln2 >> 5;
            const int pos = 16 * (32 * iblk + r32) + rho;
            const bf16_t* Qw = QA + (rowbase + pos) * 384 + h * 64 + hi * 8;
#pragma unroll
            for (int d0 = 0; d0 < 4; ++d0) qr[d0] = ld8(Qw + d0 * 16);
#pragma unroll
            for (int r = 0; r < 16; ++r) { const float* xp = X + (w * 32 + crow(r, hi)) * 64 + r32; o[0][r] = xp[0]; o[1][r] = xp[32]; }
            m_reg = ML[w * 32 + r32]; l_reg = ML[256 + w * 32 + r32];
            asm volatile("s_waitcnt lgkmcnt(0)" ::: "memory"); __syncthreads();
            { bf16x8 kf[2][4]; const int kb16 = 32 * iblk - 64, kb4 = 128 * iblk - 64;
              int t = kb16 + 63 >= 0 ? 0 : (-kb16) >> 6;
              if (t < 3 && kb16 + 64 * t < (SEQ >> 4)) dil_loadk<4>(kf, kb16 + 64 * t, Kh + rho * 384, r32, hi);
#pragma unroll 1
              for (; t < 3 && kb16 + 64 * t < (SEQ >> 4); ++t) { const int kb = kb16 + 64 * t; const bool nv = t + 1 < 3 && kb + 64 < (SEQ >> 4);
                  dil_tile<4>(kb, 32 * iblk + r32, kf, nv, t == 1, Kh + rho * 384, Vh + rho * 384, qr, m_reg, l_reg, o, V_lds, vb0, al_l, lane, r32, hi); }
              t = kb4 + 63 >= 0 ? 0 : (-kb4) >> 6;
              if (t < 4 && kb4 + 64 * t < (SEQ >> 2)) dil_loadk<2>(kf, kb4 + 64 * t, Kh + (rho & 3) * 384, r32, hi);
#pragma unroll 1
              for (; t < 4 && kb4 + 64 * t < (SEQ >> 2); ++t) { const int kb = kb4 + 64 * t; const bool nv = t + 1 < 4 && kb + 64 < (SEQ >> 2);
                  dil_tile<2>(kb, 4 * (32 * iblk + r32) + (rho >> 2), kf, nv, false, Kh + (rho & 3) * 384, Vh + (rho & 3) * 384, qr, m_reg, l_reg, o, V_lds, vb0, al_l, lane, r32, hi); } }
        }
        bf16_t* obase = MIX + (rowbase + rho) * 1024 + h * 64;
        head_tail(o, l_reg, wsf, stg, lane, r32, hi, ss, [&](int i) { return obase + (long)(16 * (32 * iblk + i * 8 + (lane >> 3))) * 1024; });
    }
    { int ln = lane; asm volatile("" : "+v"(ln));
      bf16_t* obase = MIX + (rowbase + rho) * 1024;
      group_norm_rows(ss, ln, [&](int i, int h) { return obase + (long)(16 * (32 * iblk + i * 8 + (ln >> 3))) * 1024 + h * 64; }); }
    __syncthreads();
}

__device__ __forceinline__ void fft_a_unit(int b, int n2, const bf16_t* __restrict__ Z, const bf16_t* __restrict__ W1, const f32x2* __restrict__ TW, bf16_t* AP, char* lds, int tid) {
    asm volatile("" : "+v"(tid));
    const int wid = tid >> 6, lane = tid & 63, r32 = lane & 31, hi = lane >> 5;
#pragma unroll
    for (int bt = 0; bt < 2; ++bt) { bf16x8 pc[8];
#pragma unroll
        for (int j = 0; j < 8; ++j) { const int p = tid + 512 * (bt * 8 + j), row = p >> 5, c8 = p & 31, cs = row >> 7, n1 = row & 127;
            pc[j] = ld8(Z + ((long)b * SEQ + 64 * n1 + n2) * 512 + cs * 256 + c8 * 8); }
#pragma unroll
        for (int j = 0; j < 8; ++j) { const int p = tid + 512 * (bt * 8 + j), row = p >> 5, c8 = p & 31;
            *(bf16x8*)(lds + ((row >> 6) * 2 + (c8 >> 4)) * 16384 + v_st<4>(row & 63, (c8 & 15) * 8)) = pc[j]; } }
    __syncthreads();
    const int kb = wid & 3, ch = wid >> 2;
    f32x16 acc[2][4] = {};
    const int vb = (int)(uintptr_t)lds + v_rd_base(lane);
    for (int kblk = 0; kblk < 4; ++kblk) {
        bf16x8 af[2][4];
#pragma unroll
        for (int ri = 0; ri < 2; ++ri)
#pragma unroll
            for (int s = 0; s < 4; ++s) af[ri][s] = ld8(W1 + (ri * 128 + 32 * kb + r32) * 256 + kblk * 64 + s * 16 + hi * 8);
        const int vt = vb + (kblk * 2 + ch) * 16384;
#pragma unroll
        for (int ri = 0; ri < 2; ++ri) {
            pv_one<4, 0>(acc[ri][0], vt, af[ri][0], af[ri][1], af[ri][2], af[ri][3]); pv_one<4, 1>(acc[ri][1], vt, af[ri][0], af[ri][1], af[ri][2], af[ri][3]);
            pv_one<4, 2>(acc[ri][2], vt, af[ri][0], af[ri][1], af[ri][2], af[ri][3]); pv_one<4, 3>(acc[ri][3], vt, af[ri][0], af[ri][1], af[ri][2], af[ri][3]); }
    }
    f32x2 tw[16];
#pragma unroll
    for (int r = 0; r < 16; ++r) tw[r] = TW[n2 * 128 + 32 * kb + crow(r, hi)];
    __syncthreads();
    bf16_t* ot = (bf16_t*)lds;
#pragma unroll
    for (int r = 0; r < 16; ++r) { const int k1 = 32 * kb + crow(r, hi); bf16_t* orow = ot + k1 * 512 + 128 * ch + r32;
#pragma unroll
        for (int d0 = 0; d0 < 4; ++d0) { const float re = acc[0][d0][r], im = acc[1][d0][r];
            orow[d0 * 32] = (bf16_t)f2bf(re * tw[r].x + im * tw[r].y); orow[256 + d0 * 32] = (bf16_t)f2bf(im * tw[r].x - re * tw[r].y); } }
    __syncthreads();
#pragma unroll
    for (int j = 0; j < 16; ++j) { const int p = tid + 512 * j, k1 = p >> 6, c = p & 63;
        *(u32x4*)(AP + (((long)b * 128 + k1) * 64 + n2) * 512 + c * 8) = *(const u32x4*)(ot + k1 * 512 + c * 8); }
    __syncthreads();
}
__device__ __forceinline__ void fft_c_units(int u0, int ustep, const bf16_t* __restrict__ AP, const bf16_t* __restrict__ W2, bf16_t* MIX, char* lds, int tid) {
    asm volatile("" : "+v"(tid));
    if (u0 >= 1024) return;
    const int wid = tid >> 6, lane = tid & 63, r32 = lane & 31, hi = lane >> 5;
    const int rb = wid & 1, cq4 = wid >> 1, ch = cq4 >> 1, dsel = cq4 & 1;
    bf16x8 af[2][4];
#pragma unroll
    for (int kblk = 0; kblk < 2; ++kblk)
#pragma unroll
        for (int s = 0; s < 4; ++s) af[kblk][s] = ld8(W2 + (32 * rb + r32) * 128 + kblk * 64 + s * 16 + hi * 8);
    bf16x8 pc[8];
    { const bf16_t* src = AP + ((long)(u0 & 7) * 128 + (u0 >> 3)) * 64 * 512;
#pragma unroll
      for (int j = 0; j < 8; ++j) pc[j] = ld8(src + (long)(tid + 512 * j) * 8); }
    const int vb = (int)(uintptr_t)lds + v_rd_base(lane) + dsel * 1024;
    for (int u = u0; u < 1024; u += ustep) {
        const int b = u & 7, k1 = u >> 3;
#pragma unroll
        for (int j = 0; j < 8; ++j) { const int p = tid + 512 * j, row = p >> 5, c8 = p & 31;
            *(bf16x8*)(lds + ((row >> 6) * 2 + (c8 >> 4)) * 16384 + v_st<4>(row & 63, (c8 & 15) * 8)) = pc[j]; }
        __syncthreads();
        if (u + ustep < 1024) { const int un = u + ustep; const bf16_t* src = AP + ((long)(un & 7) * 128 + (un >> 3)) * 64 * 512;
#pragma unroll
            for (int j = 0; j < 8; ++j) pc[j] = ld8(src + (long)(tid + 512 * j) * 8); }
        f32x16 acc[2] = {};
#pragma unroll
        for (int kblk = 0; kblk < 2; ++kblk) { const int vt = vb + (kblk * 2 + ch) * 16384;
            pv_one<4, 0>(acc[0], vt, af[kblk][0], af[kblk][1], af[kblk][2], af[kblk][3]); pv_one<4, 1>(acc[1], vt, af[kblk][0], af[kblk][1], af[kblk][2], af[kblk][3]); }
        float* ot = (float*)(lds + 65536);
#pragma unroll
        for (int r = 0; r < 16; ++r) { const int k2 = 32 * rb + crow(r, hi);
#pragma unroll
            for (int j = 0; j < 2; ++j) ot[k2 * 260 + 64 * cq4 + 32 * j + r32] = acc[j][r]; }
        __syncthreads();
        { const int k2 = tid >> 3, seg = tid & 7; const float* rp = ot + k2 * 260 + seg * 32; f32x4 x[8]; float s = 0.f;
#pragma unroll
          for (int j = 0; j < 8; ++j) { x[j] = *(const f32x4*)(rp + 4 * j); s += (x[j].x * x[j].x + x[j].y * x[j].y) + (x[j].z * x[j].z + x[j].w * x[j].w); }
          s += __shfl_xor(s, 1); s += __shfl_xor(s, 2); s += __shfl_xor(s, 4);
          const float rstd = rsqrtf(s * (1.0f / 256.0f) + RMS_EPS);
          bf16_t* dst = MIX + ((long)b * SEQ + k1 + 128 * k2) * 1024 + 768 + seg * 32;
#pragma unroll
          for (int j = 0; j < 4; ++j) { u32x4 w; w.x = cvt_pk_bf16(x[2 * j].x * rstd, x[2 * j].y * rstd); w.y = cvt_pk_bf16(x[2 * j].z * rstd, x[2 * j].w * rstd);
              w.z = cvt_pk_bf16(x[2 * j + 1].x * rstd, x[2 * j + 1].y * rstd); w.w = cvt_pk_bf16(x[2 * j + 1].z * rstd, x[2 * j + 1].w * rstd);
              *(u32x4*)(dst + 8 * j) = w; } }
        __syncthreads();
    }
}
}
constexpr int NWAVES = 8;
struct Frame {
    LAS unsigned char* lds; volatile LAS unsigned* MISC; unsigned* ctl; unsigned char* ws;
    int tid, lane, wave, vcu, G; unsigned z;
};
__device__ __forceinline__ int fresh_tid(int wv) { int ln_; asm volatile("v_mbcnt_lo_u32_b32 %0, -1, 0\n\tv_mbcnt_hi_u32_b32 %0, -1, %0" : "=v"(ln_)); return wv * 64 + ln_; }
#define WSF(off) (ws + (size_t)(F.z + (unsigned)(off)))
struct Args { const float* in[18]; float* out; unsigned char* ws; int ph_lo, ph_hi; };

__constant__ double INVF_A[8] = {1.0, 0.19392274474868576, 0.03760603093086393, 0.007292664737217109, 0.001414213562373095, 0.0002742481756762073, 5.318295896944988e-05, 1.031338537721246e-05};
__constant__ double INVF_B[16] = {1.0, 0.44036660267178046, 0.19392274474868576, 0.08539710028576561, 0.03760603093086393, 0.016560440080994446, 0.007292664737217109, 0.003211445994752591,
                                  0.001414213562373095, 0.000622772421914596, 0.0002742481756762073, 0.00012076973741146504, 5.318295896944988e-05, 2.341999896140934e-05, 1.031338537721246e-05, 4.5416704806078695e-06};
__device__ __forceinline__ f32x2 cs_rev(float rev) { return (f32x2){__builtin_amdgcn_cosf(rev), __builtin_amdgcn_sinf(rev)}; }
__device__ __forceinline__ f32x2 cs_angle(double ang) { const double rv = ang * 0.15915494309189535; const double fr = rv - __builtin_floor(rv); return cs_rev((float)fr); }

template <class ColF>
__device__ __forceinline__ void tr_item(LAS float* scr, int lane, bf16_t* dst, int ldd, int k0, int n0, const ColF& colf) {
    const auto col = colf(n0 + (lane & 31));
    float tv[32];
#pragma unroll
    for (int i = 0; i < 32; ++i) tv[i] = col.val(k0 + 2 * i + (lane >> 5));
#pragma unroll
    for (int i = 0; i < 32; ++i) scr[(2 * i + (lane >> 5)) * 33 + (lane & 31)] = tv[i];
    LDS_WAIT(); asm volatile("" ::: "memory");
    const int c = lane & 7;
#pragma unroll
    for (int j = 0; j < 4; ++j) { const int n = (lane >> 3) + 8 * j; const LAS float* s = scr + (8 * c) * 33 + n;
        u32x4 o; o.x = pk2(s[0 * 33], s[1 * 33]); o.y = pk2(s[2 * 33], s[3 * 33]); o.z = pk2(s[4 * 33], s[5 * 33]); o.w = pk2(s[6 * 33], s[7 * 33]);
        *(u32x4*)(dst + (size_t)(n0 + n) * ldd + k0 + 8 * c) = o; }
    LDS_WAIT(); asm volatile("" ::: "memory");
}
template <bool I8 = false, class ColF>
__device__ __forceinline__ void tr_item8(LAS float* scr, int lane, unsigned char* dst, int ldd, int k0, int n0, const ColF& colf, float scale) {
    const auto col = colf(n0 + (lane & 31));
    float tv[32];
#pragma unroll
    for (int i = 0; i < 32; ++i) tv[i] = col.val(k0 + 2 * i + (lane >> 5));
#pragma unroll
    for (int i = 0; i < 32; ++i) scr[(2 * i + (lane >> 5)) * 33 + (lane & 31)] = tv[i] * scale;
    LDS_WAIT(); asm volatile("" ::: "memory");
#pragma unroll
    for (int j = 0; j < 2; ++j) { const int p = lane + 64 * j, n = p >> 2, c = p & 3; const LAS float* s = scr + (16 * c) * 33 + n;
        u32x4 o;
#pragma unroll
        for (int q = 0; q < 4; ++q) o[q] = I8 ? pk4_i8(s[(4 * q) * 33], s[(4 * q + 1) * 33], s[(4 * q + 2) * 33], s[(4 * q + 3) * 33]) : pk4_fp8(s[(4 * q) * 33], s[(4 * q + 1) * 33], s[(4 * q + 2) * 33], s[(4 * q + 3) * 33]);
        *(u32x4*)(dst + (size_t)(n0 + n) * ldd + k0 + 16 * c) = o; }
    LDS_WAIT(); asm volatile("" ::: "memory");
}
struct ColPlain { const float* src; int ld; const float* gain; float scale; int gsel;
    __device__ __forceinline__ float val(int k) const { const float w = src[(size_t)k * ld]; const float gv = gain[k]; return w * scale * (gsel ? gv : 1.0f); } };
struct ColDft { const float* src; int ld; const float* gain; const LAS float* trig;
    __device__ __forceinline__ float val(int k) const { const float* p = src + (size_t)k * ld; float a = 0.f;
#pragma unroll 16
        for (int c = 0; c < 64; ++c) a += p[c] * trig[c * 32];
        return a * gain[k]; } };

__device__ __forceinline__ int rope_src(int ip, int half) { return ip < 2 * half ? ((ip & 1) ? (ip >> 1) + half : (ip >> 1)) : ip; }

struct ColInProj { const float* w; const float* gain;
    __device__ __forceinline__ ColPlain operator()(int n) const {
        ColPlain c; c.src = w; c.ld = D_IN; c.gain = gain; c.scale = 1.f; c.gsel = 1;
        if (n < 768) { const int seg = n / 384, r = n - seg * 384, head = r >> 6, ip = r & 63; c.src = w + seg * 384 + head * 64 + rope_src(ip, 8); if (seg == 0) c.scale = QSCALE_A; }
        else if (n < 1664) c.src = w + n;
        else if (n < 1696) c.src = w + 1664 + rope_src(n - 1664, 16);
        else c.scale = 0.f;
        return c; } };
struct ColInProjDft { const float* w; const float* gain; LAS float* tl; int lane;
    __device__ __forceinline__ ColDft operator()(int n) const { const int c2 = n - 1792, sn = c2 >> 8, cp = c2 & 255, cc = cp & 63; ColDft d; d.src = w + 1696 + (cp >> 6) * 64; d.ld = D_IN; d.gain = gain;
        LAS float* t = tl + (lane & 31);
        if (lane < 32) {
#pragma unroll 8
            for (int c = 0; c < 64; ++c) { const float rev = (float)((c * cc) & 63) * (1.0f / 64.0f); t[c * 32] = sn ? __builtin_amdgcn_sinf(rev) : __builtin_amdgcn_cosf(rev); } }
        LDS_WAIT(); asm volatile("" ::: "memory");
        d.trig = t; return d; } };
struct ColUq { const float* wuq; const float* qn;
    __device__ __forceinline__ ColPlain operator()(int n) const { ColPlain c; c.src = wuq; c.ld = 576; c.gain = qn; c.scale = 0.f; c.gsel = 1;
        if (n < 576) { const int head = n / 96, ip = n - head * 96; c.src = wuq + head * 96 + (ip < 64 ? ip : 64 + rope_src(ip - 64, 16)); c.scale = QSCALE_B; }
        return c; } };
struct ColUkv { const float* wukv; const float* kvn;
    __device__ __forceinline__ ColPlain operator()(int n) const { ColPlain c; c.ld = 768; c.gain = kvn; c.scale = 1.f; c.gsel = 1;
        c.src = wukv + (n < 384 ? (n >> 6) * 128 + (n & 63) : ((n - 384) >> 6) * 128 + 64 + ((n - 384) & 63)); return c; } };
struct ColSimple { const float* w; int ld; const float* gain;
    __device__ __forceinline__ ColPlain operator()(int n) const { ColPlain c; c.src = w + n; c.ld = ld; c.gain = gain ? gain : w; c.scale = 1.f; c.gsel = gain ? 1 : 0; return c; } };
struct ColGU { const float* wg; const float* wu; int ld; const float* gain;
    __device__ __forceinline__ ColPlain operator()(int n) const { const int j = n >> 8, r = n & 255; const uintptr_t msk = r < 128 ? ~(uintptr_t)0 : (uintptr_t)0; ColPlain c; c.src = (const float*)(((uintptr_t)wg & msk) | ((uintptr_t)wu & ~msk)) + 128 * j + (r & 127); c.ld = ld; c.gain = gain; c.scale = 1.f; c.gsel = 1; return c; } };

__device__ __forceinline__ void p0_prologue(Frame& F, const Args& a) {
    LAS float* scr = (LAS float*)(F.lds + F.wave * 16896);
    const int gw = F.vcu * NWAVES + F.wave, NGW = F.G * NWAVES, gt = gw * 64 + F.lane, NGT = NGW * 64;
    unsigned char* ws = F.ws;
    { f32x2* ra = (f32x2*)WSF(WS_ROPEA); for (int i = gt; i < SEQ * 8; i += NGT) ra[i] = cs_angle((double)(i >> 3) * INVF_A[i & 7]);
      f32x2* rb = (f32x2*)WSF(WS_ROPEB); for (int i = gt; i < SEQ * 16; i += NGT) rb[i] = cs_angle((double)(i >> 4) * INVF_B[i & 15]);
      bf16_t* w1 = (bf16_t*)WSF(WS_W1F);
      for (int i = gt; i < 256 * 256; i += NGT) { const int row = i >> 8, k = i & 255, ri = row >> 7, k1 = row & 127, cs = k >> 7, n1 = k & 127;
          const f32x2 t = cs_rev((float)((n1 * k1) & 127) * (1.0f / 128.0f));
          const float v = ri == 0 ? (cs == 0 ? t.x : -t.y) : (cs == 0 ? -t.y : -t.x); w1[i] = (bf16_t)f2bf(v); }
      bf16_t* w2 = (bf16_t*)WSF(WS_W2F);
      for (int i = gt; i < 64 * 128; i += NGT) { const int k2 = i >> 7, k = i & 127, n2 = k >> 1, ri = k & 1; const f32x2 t = cs_rev((float)((n2 * k2) & 63) * (1.0f / 64.0f));
          w2[i] = (bf16_t)f2bf((ri ? t.y : t.x) * FFT_SCALE); }
      f32x2* tw = (f32x2*)WSF(WS_TW);
      for (int i = gt; i < 64 * 128; i += NGT) { const int n2 = i >> 7, k1 = i & 127; tw[i] = cs_rev((float)(n2 * k1) * (1.0f / 8192.0f)); } }
    constexpr int I_IN = 16 * 56, I_UP = 6 * 24 + 2 * 24, I_OUT = 16 * 32, I_L = I_IN + I_UP + I_OUT, I_GU = 16 * 176, I_D = 44 * 32, I_F = I_GU + I_D;
    constexpr int NITEMS = DEPTH * I_L + 2 * I_F;
    for (int it = gw; it < DEPTH * 256; it += NGW) { const int l = it >> 8, r = it & 255, kb = r >> 4, nb = 56 + (r & 15); unsigned char* wl = WSF(WS_WL) + (size_t)l * WL_STRIDE;
        const float* wsrc = a.in[2] + (size_t)l * DM * D_IN; const float* gsrc = a.in[1] + l * DM; ColInProjDft cf{wsrc, gsrc, scr + 64 * 33, F.lane};
        if ((I8_INPROJ >> l) & 1u) tr_item8<true>(scr, F.lane, wl, DM, 64 * kb, 32 * nb, cf, I8_WQ / 8.0f);
        else tr_item(scr, F.lane, (bf16_t*)wl, DM, 64 * kb, 32 * nb, cf); }
    for (int it = gw; it < NITEMS; it += NGW) {
        if (it < DEPTH * I_L) { const int l = it / I_L; int r = it - l * I_L; unsigned char* wl = WSF(WS_WL) + (size_t)l * WL_STRIDE;
            if (r < I_IN) { const int kb = r / 56, nb = r - kb * 56; const float* wsrc = a.in[2] + (size_t)l * DM * D_IN; const float* gsrc = a.in[1] + l * DM; ColInProj cf{wsrc, gsrc};
                if ((I8_INPROJ >> l) & 1u) tr_item8<true>(scr, F.lane, wl, DM, 64 * kb, 32 * nb, cf, nb < 12 ? I8_WQ / QSCALE_A : I8_WQ);
                else tr_item(scr, F.lane, (bf16_t*)wl, DM, 64 * kb, 32 * nb, cf);
                continue; } r -= I_IN;
            if (r < I_UP) { if (r < 144) { const int kb = r / 24, nb = r - kb * 24; ColUq cf{a.in[4] + (size_t)l * 384 * 576, a.in[3] + l * 384}; tr_item(scr, F.lane, (bf16_t*)(wl + WL_WUP), 384, 64 * kb, 32 * nb, cf); }
                else { r -= 144; const int kb = r / 24, nb = r - kb * 24; ColUkv cf{a.in[6] + (size_t)l * 128 * 768, a.in[5] + l * 128}; tr_item(scr, F.lane, (bf16_t*)(wl + WL_WUKV), 128, 64 * kb, 32 * nb, cf); } continue; } r -= I_UP;
            { const int kb = r / 32, nb = r - kb * 32; ColSimple cf{a.in[8] + (size_t)l * DM * DM, DM, a.in[7] + l * DM}; tr_item(scr, F.lane, (bf16_t*)(wl + WL_WOUT), DM, 64 * kb, 32 * nb, cf); }
        } else { int r = it - DEPTH * I_L; const int i = r / I_F; r -= i * I_F; unsigned char* wf = WSF(WS_WFF) + (size_t)i * WFF_STRIDE;
            const bool f8 = (FP8_DENSE >> i) & 1u;
            if (r < I_GU) { const int kb = r / 176, nb = r - kb * 176; ColGU cf{a.in[10] + (size_t)i * DM * D_FF, a.in[11] + (size_t)i * DM * D_FF, D_FF, a.in[9] + (2 * i) * DM};
                if ((I8_DENSE >> i) & 1u) tr_item8<true>(scr, F.lane, wf, DM, 64 * kb, 32 * nb, cf, I8_WQ); else if (f8) tr_item8(scr, F.lane, wf, DM, 64 * kb, 32 * nb, cf, W8_SCALE); else tr_item(scr, F.lane, (bf16_t*)wf, DM, 64 * kb, 32 * nb, cf); continue; } r -= I_GU;
            { const int kb = r / 32, nb = r - kb * 32; ColSimple cf{a.in[12] + (size_t)i * D_FF * DM, DM, nullptr};
              if ((FP8_DDOWN >> i) & 1u) tr_item8(scr, F.lane, wf + WFF_WD, D_FF, 64 * kb, 32 * nb, cf, W8_SCALE); else tr_item(scr, F.lane, (bf16_t*)(wf + WFF_WD), D_FF, 64 * kb, 32 * nb, cf); }
        }
    }
    { const float* x = a.in[0]; bf16_t* XB = (bf16_t*)WSF(WS_XB); f32x4* sq = (f32x4*)WSF(WS_SSQX);
      for (int m0 = gw * 4; m0 < T; m0 += NGW * 4) {
          f32x4 v[4][4]; float s[4];
#pragma unroll
          for (int r = 0; r < 4; ++r)
#pragma unroll
              for (int j = 0; j < 4; ++j) v[r][j] = ((const f32x4*)(x + (size_t)(m0 + r) * DM))[64 * j + F.lane];
#pragma unroll
          for (int r = 0; r < 4; ++r) { float t = 0.f;
#pragma unroll
              for (int j = 0; j < 4; ++j) t += (v[r][j].x * v[r][j].x + v[r][j].y * v[r][j].y) + (v[r][j].z * v[r][j].z + v[r][j].w * v[r][j].w);
              s[r] = wave_sum_dpp(t); }
#pragma unroll
          for (int r = 0; r < 4; ++r) {
              if (I8_INPROJ & 1u) {
                  const float tot = __int_as_float(__builtin_amdgcn_readlane(__float_as_int(s[r]), 63)); const float step = I8_XR * sqrtf(tot * (1.0f / DM) + 1e-12f), iq = 1.0f / step;
                  unsigned* o4 = (unsigned*)(WSF(WS_XB8) + (size_t)(m0 + r) * DM) + F.lane;
#pragma unroll
                  for (int j = 0; j < 4; ++j) o4[64 * j] = pk4_i8(v[r][j].x * iq, v[r][j].y * iq, v[r][j].z * iq, v[r][j].w * iq);
                  if (F.lane == 63) ((float*)WSF(WS_ROWSC2))[m0 + r] = step;
              }
              { u32x2* o8 = (u32x2*)(XB + (size_t)(m0 + r) * DM) + F.lane;
#pragma unroll
                  for (int j = 0; j < 4; ++j) { u32x2 w; w.x = cvt_pk_bf16(v[r][j].x, v[r][j].y); w.y = cvt_pk_bf16(v[r][j].z, v[r][j].w); o8[64 * j] = w; } }
              if (F.lane == 63) sq[m0 + r] = (f32x4){s[r], 0.f, 0.f, 0.f}; } } }
}

struct ConvBlk { const float* src; int ld; const float* gain; unsigned char* dst; int ldd, k0, n0, drow0, rstep, i8; };
__device__ __forceinline__ void conv_load(const Frame& F, const ConvBlk& cb, float scale, f32x4 (&v)[8], float (&g)[8]) {
#pragma unroll
    for (int i = 0; i < 8; ++i) { const int k = cb.k0 + 8 * F.wave + i; v[i] = *(const f32x4*)(cb.src + (size_t)k * cb.ld + cb.n0 + 4 * F.lane); const float sc = cb.i8 ? I8_WQ : scale; g[i] = cb.gain ? cb.gain[k] * sc : sc; }
}
template <bool F8>
__device__ __forceinline__ void conv_put(const Frame& F, const f32x4 (&v)[8], const float (&g)[8], LAS unsigned char* T, int i8) {
    constexpr int PITCH = F8 ? 260 : 516;
#pragma unroll
    for (int i = 0; i < 8; ++i) { const int kr = 8 * F.wave + i; const f32x4 x = v[i] * g[i];
        if (F8) *(LAS unsigned*)(T + kr * PITCH + 4 * F.lane) = i8 ? pk4_i8(x.x, x.y, x.z, x.w) : pk4_fp8(x.x, x.y, x.z, x.w);
        else { *(LAS unsigned*)(T + kr * PITCH + 8 * F.lane) = cvt_pk_bf16(x.x, x.y); *(LAS unsigned*)(T + kr * PITCH + 8 * F.lane + 4) = cvt_pk_bf16(x.z, x.w); } }
}
template <bool F8>
__device__ __forceinline__ void conv_out(const Frame& F, const ConvBlk& cb, const LAS unsigned char* T) {
    constexpr int PITCH = F8 ? 260 : 516;
    if (F8) {
#pragma unroll
        for (int j = 0; j < 2; ++j) { const int p = F.tid + 512 * j, n = p >> 2, c = p & 3; u32x4 o;
#pragma unroll
            for (int q = 0; q < 4; ++q) { unsigned w = 0;
#pragma unroll
                for (int b = 0; b < 4; ++b) w |= (unsigned)T[(16 * c + 4 * q + b) * PITCH + n] << (8 * b);
                o[q] = w; }
            *(u32x4*)(cb.dst + (size_t)(cb.drow0 + (n < 128 ? n : n + cb.rstep)) * cb.ldd + cb.k0 + 16 * c) = o; }
    } else {
#pragma unroll
        for (int j = 0; j < 4; ++j) { const int p = F.tid + 512 * j, n = p >> 3, c = p & 7; u32x4 o;
#pragma unroll
            for (int q = 0; q < 4; ++q) { const unsigned lo = *(const LAS unsigned short*)(T + (8 * c + 2 * q) * PITCH + 2 * n), hi = *(const LAS unsigned short*)(T + (8 * c + 2 * q + 1) * PITCH + 2 * n); o[q] = lo | (hi << 16); }
            *(u32x4*)(cb.dst + ((size_t)(cb.drow0 + (n < 128 ? n : n + cb.rstep)) * cb.ldd + cb.k0 + 8 * c) * 2) = o; }
    }
}
__device__ __forceinline__ ConvBlk moe_blk(const Args& a, unsigned char* dgu0, unsigned char* dd0, const float* fng, int mi, int it, int esz) {
    const int e = it / 672; int r = it - e * 672; const size_t eo = ((size_t)mi * NEXP + e) * DM * D_FFE; ConvBlk cb;
    if (r < 448) { const int up = r >= 224; if (up) r -= 224; const int kb = r / 14, nb = r - kb * 14;
        cb.src = (up ? a.in[15] : a.in[14]) + eo; cb.ld = D_FFE; cb.gain = fng; cb.dst = dgu0 + (size_t)e * 7168 * DM * esz; cb.ldd = DM; cb.k0 = 64 * kb; cb.n0 = 256 * nb; cb.drow0 = 512 * nb + (up ? 128 : 0); cb.rstep = 128; cb.i8 = (int)((I8_MOE >> mi) & 1u); }
    else { r -= 448; const int kb = r >> 2, nb = r & 3;
        cb.src = a.in[16] + eo; cb.ld = DM; cb.gain = nullptr; cb.dst = dd0 + (size_t)e * DM * D_FFE * esz; cb.ldd = D_FFE; cb.k0 = 64 * kb; cb.n0 = 256 * nb; cb.drow0 = 256 * nb; cb.rstep = 0; cb.i8 = 0; }
    return cb;
}
template <bool F8>
__device__ __forceinline__ void moe_convert(Frame& F, const Args& a, const float* fng, int mi) {
    unsigned char* ws = F.ws; unsigned char* dgu0 = (unsigned char*)WSF(WS_WGUE); unsigned char* dd0 = (unsigned char*)WSF(WS_WDE); LAS unsigned char* T0 = F.lds; LAS unsigned char* T1 = F.lds + 40960;
    const float scale = F8 ? W8_SCALE : 1.0f; constexpr int esz = F8 ? 1 : 2; constexpr int NB = NEXP * 672;
    int itA = F.vcu; if (itA >= NB) return;
    int itB = itA + F.G; bool hasB = itB < NB;
    ConvBlk cA = moe_blk(a, dgu0, dd0, fng, mi, itA, esz), cB = cA; f32x4 vA[8], vB[8]; float gA[8], gB[8];
    conv_load(F, cA, scale, vA, gA);
    if (hasB) { cB = moe_blk(a, dgu0, dd0, fng, mi, itB, esz); conv_load(F, cB, scale, vB, gB); }
    for (;;) {
        conv_put<F8>(F, vA, gA, T0, cA.i8);
        const ConvBlk oA = cA; const int nA = itA + 2 * F.G; const bool moreA = nA < NB;
        if (moreA) { cA = moe_blk(a, dgu0, dd0, fng, mi, nA, esz); conv_load(F, cA, scale, vA, gA); }
        __syncthreads();
        conv_out<F8>(F, oA, T0);
        if (!hasB) break;
        conv_put<F8>(F, vB, gB, T1, cB.i8);
        const ConvBlk oB = cB; const int nB = itB + 2 * F.G; const bool moreB = nB < NB;
        if (moreB) { cB = moe_blk(a, dgu0, dd0, fng, mi, nB, esz); conv_load(F, cB, scale, vB, gB); }
        __syncthreads();
        conv_out<F8>(F, oB, T1);
        if (!moreA) break;
        itA = nA; itB = nB; hasB = moreB;
    }
    __syncthreads();
}
__device__ __forceinline__ void moe_r1(Frame& F, const Args& a, int l) {
    const int mi = l >> 1; unsigned char* ws = F.ws;
    const int gw = F.vcu * NWAVES + F.wave, NGW = F.G * NWAVES, gt = gw * 64 + F.lane, NGT = NGW * 64;
    const float* fng = a.in[9] + l * DM;
    REPS(18) { if ((FP8_MOE >> mi) & 1u) moe_convert<true>(F, a, fng, mi); else moe_convert<false>(F, a, fng, mi); }
    { int* rt = (int*)WSF(WS_ROWTOK); float* rs_ = (float*)WSF(WS_ROWRS); for (int i = gt; i < 2 * RT_STRIDE; i += NGT) { rt[i] = -1; rs_[i] = 0.f; } }
    __syncthreads();
    LAS float* Wl = (LAS float*)F.lds; LAS int* cnt = (LAS int*)(F.lds + 32768);
    const float* wr_ = a.in[13] + (size_t)mi * DM * NEXP;
    for (int i = F.tid; i < DM * NEXP; i += NWAVES * 64) { const int k = i >> 3, e = i & 7; Wl[(((k >> 8) * 4 + (k & 3)) * 64 + ((k >> 2) & 63)) * 8 + e] = wr_[i] * fng[k]; }
    const bf16_t* x = (const bf16_t*)WSF(WS_XB); i32x2* toke = (i32x2*)WSF(WS_TOKE); f32x2* tokg = (f32x2*)WSF(WS_TOKG); int* cntwg = (int*)WSF(WS_CNTWG);
    REPS(19) for (int c = F.vcu; c < T / 256; c += F.G) {
        if (F.tid < 16) cnt[F.tid] = 0;
        __syncthreads();
        for (int it = 0; it < 8; ++it) { const int tok0 = c * 256 + F.wave * 32 + it * 4;
            f32x4 xv[4][4]; float lg[4][8]; float sq[4];
#pragma unroll
            for (int t = 0; t < 4; ++t)
#pragma unroll
                for (int j = 0; j < 4; ++j) { const u32x2 w = ((const u32x2*)(x + (size_t)(tok0 + t) * DM))[64 * j + F.lane]; xv[t][j] = (f32x4){bf_lo(w.x), bf_hi(w.x), bf_lo(w.y), bf_hi(w.y)}; }
#pragma unroll
            for (int t = 0; t < 4; ++t) { sq[t] = 0.f;
#pragma unroll
                for (int e = 0; e < 8; ++e) lg[t][e] = 0.f; }
#pragma unroll
            for (int j = 0; j < 4; ++j)
#pragma unroll
                for (int q = 0; q < 4; ++q) { const LAS float* wp = Wl + ((j * 4 + q) * 64 + F.lane) * 8; const f32x4 w0 = *(const LAS f32x4*)wp, w1 = *(const LAS f32x4*)(wp + 4);
#pragma unroll
                    for (int t = 0; t < 4; ++t) { const float xq = xv[t][j][q]; sq[t] += xq * xq;
                        lg[t][0] += xq * w0.x; lg[t][1] += xq * w0.y; lg[t][2] += xq * w0.z; lg[t][3] += xq * w0.w; lg[t][4] += xq * w1.x; lg[t][5] += xq * w1.y; lg[t][6] += xq * w1.z; lg[t][7] += xq * w1.w; } }
#pragma unroll
            for (int t = 0; t < 4; ++t) { const int tok = tok0 + t;
                const float rstd = rsqrtf(wave_sum_dpp(sq[t]) * (1.0f / DM) + RMS_EPS); float l8[8];
#pragma unroll
                for (int e = 0; e < 8; ++e) l8[e] = wave_sum_dpp(lg[t][e]) * rstd;
                int e0 = 0; float v0 = l8[0];
#pragma unroll
                for (int e = 1; e < 8; ++e) if (l8[e] > v0) { v0 = l8[e]; e0 = e; }
                int e1 = -1; float v1 = -INFINITY;
#pragma unroll
                for (int e = 0; e < 8; ++e) if (e != e0 && l8[e] > v1) { v1 = l8[e]; e1 = e; }
                const float g1 = 1.0f / (1.0f + __expf(v0 - v1)), g0 = 1.0f - g1;
                if (F.lane == 63) { toke[tok] = (i32x2){e0, e1}; tokg[tok] = (f32x2){g0, g1}; atomicAdd((int*)&cnt[e0], 1); atomicAdd((int*)&cnt[8 + e1], 1); } } }
        __syncthreads();
        if (F.tid < 16) cntwg[c * 16 + F.tid] = cnt[F.tid];
        __syncthreads();
    }
}
__device__ __forceinline__ void moe_r2(Frame& F, const float* rowsc) {
    unsigned char* ws = F.ws;
    LAS int* cw = (LAS int*)F.lds;
    LAS int* tot = cw + 4096;
    LAS int* wpre = tot + 16;
    LAS int* base = wpre + 64;
    const int* cntwg = (const int*)WSF(WS_CNTWG); const i32x2* toke = (const i32x2*)WSF(WS_TOKE); const f32x2* tokg = (const f32x2*)WSF(WS_TOKG);
    int* rt = (int*)WSF(WS_ROWTOK); float* rg = (float*)WSF(WS_ROWGATE); float* rs_ = (float*)WSF(WS_ROWRS); int* tile_e = (int*)WSF(WS_TILEE);
    for (int i = F.tid; i < 4096; i += NWAVES * 64) cw[i] = cntwg[i];
    __syncthreads();
    if (F.tid < 16) { int s = 0; for (int w = 0; w < 256; ++w) s += cw[w * 16 + F.tid]; tot[F.tid] = s; }
    __syncthreads();
    if (blockIdx.x == 0) { for (int i = F.tid; i < 2 * 272; i += NWAVES * 64) { const int sl = i / 272, t = i - sl * 272; int cum = 0, ex = 7;
        for (int e = 7; e >= 0; --e) { int c2 = 0; for (int q = 0; q <= e; ++q) c2 += (tot[sl * 8 + q] + 255) >> 8; if (t < c2) ex = e; if (e == 7) cum = c2; }
        tile_e[sl * 272 + t] = ex; if (t == 0) tile_e[1024 + sl] = cum; } }
    for (int c = F.vcu; c < T / 256; c += F.G) {
        __syncthreads();
        if (F.tid < 16) { const int sl = F.tid >> 3, e = F.tid & 7; int st = 0; for (int q = 0; q < e; ++q) st += ((tot[sl * 8 + q] + 255) >> 8) << 8;
            int pre = 0; for (int w = 0; w < c; ++w) pre += cw[w * 16 + F.tid]; base[F.tid] = st + pre; }
        i32x2 ee = {0, 0}; f32x2 gg = {0.f, 0.f}; int rk0 = 0, rk1 = 0;
        if (F.tid < 256) { const int tok = c * 256 + F.tid; ee = toke[tok]; gg = tokg[tok];
#pragma unroll
            for (int e = 0; e < 8; ++e) { const unsigned long long m0 = __ballot(ee.x == e), m1 = __ballot(ee.y == e); const unsigned long long lt = (1ull << F.lane) - 1ull;
                if (ee.x == e) rk0 = __popcll(m0 & lt); if (ee.y == e) rk1 = __popcll(m1 & lt);
                if (F.lane == 0) { wpre[F.wave * 16 + e] = __popcll(m0); wpre[F.wave * 16 + 8 + e] = __popcll(m1); } } }
        __syncthreads();
        if (F.tid < 256) { const int tok = c * 256 + F.tid; int p0 = base[ee.x] + rk0, p1 = base[8 + ee.y] + rk1;
            for (int w = 0; w < F.wave; ++w) { p0 += wpre[w * 16 + ee.x]; p1 += wpre[w * 16 + 8 + ee.y]; }
            const f32x4 sq = ((const f32x4*)WSF(WS_SSQX))[tok]; const float rstd = rsqrtf(((sq.x + sq.y) + (sq.z + sq.w)) * (1.0f / DM) + RMS_EPS) * (rowsc ? rowsc[tok] : 1.0f);
            rt[p0] = tok; rg[p0] = gg.x; rs_[p0] = rstd; rt[RT_STRIDE + p1] = tok; rg[RT_STRIDE + p1] = gg.y; rs_[RT_STRIDE + p1] = rstd; }
    }
    __syncthreads();
}
__device__ __forceinline__ void final_norm(Frame& F, const Args& a) {
    const int gw = F.vcu * NWAVES + F.wave, NGW = F.G * NWAVES; const float* g = a.in[17];
    f32x4 gv[4];
#pragma unroll
    for (int j = 0; j < 4; ++j) gv[j] = ((const f32x4*)g)[64 * j + F.lane];
    unsigned char* ws = F.ws;
    for (int m0 = gw * 4; m0 < T; m0 += NGW * 4) {
        u32x2 w[4][4]; float rstd[4];
#pragma unroll
        for (int r = 0; r < 4; ++r)
#pragma unroll
            for (int j = 0; j < 4; ++j) w[r][j] = ((const u32x2*)((const bf16_t*)WSF(WS_XB) + (size_t)(m0 + r) * DM))[64 * j + F.lane];
#pragma unroll
        for (int r = 0; r < 4; ++r) { float s = 0.f;
#pragma unroll
            for (int j = 0; j < 4; ++j) { const float a0 = bf_lo(w[r][j].x), a1 = bf_hi(w[r][j].x), a2 = bf_lo(w[r][j].y), a3 = bf_hi(w[r][j].y); s += (a0 * a0 + a1 * a1) + (a2 * a2 + a3 * a3); }
            rstd[r] = rsqrtf(wave_sum(s) * (1.0f / DM) + RMS_EPS); }
#pragma unroll
        for (int r = 0; r < 4; ++r) { f32x4* xr = (f32x4*)(a.out + (size_t)(m0 + r) * DM) + F.lane;
#pragma unroll
            for (int j = 0; j < 4; ++j) { const f32x4 v = {bf_lo(w[r][j].x), bf_hi(w[r][j].x), bf_lo(w[r][j].y), bf_hi(w[r][j].y)}; xr[64 * j] = v * rstd[r] * gv[j]; } }
    }
}
__global__ void __launch_bounds__(NWAVES * 64, 2) mk_fwd(Args args) {
    extern __shared__ __attribute__((aligned(16))) unsigned char lds[];
    const int wv_ = __builtin_amdgcn_readfirstlane((int)threadIdx.x >> 6);
    for (int u = threadIdx.x; u < (LDS_BYTES - MISC_OFF) / 4; u += NWAVES * 64) ((LAS unsigned*)((LAS unsigned char*)lds + MISC_OFF))[u] = 0u;
    __syncthreads();
#if !MK_PER_PHASE
    { XcdBarrier bar0 = xcd_barrier_post((unsigned*)(args.ws + WS_CTL) + CW_BAR, (volatile LAS unsigned*)((LAS unsigned char*)lds + MISC_OFF) + 8); (void)bar0; }
#define GRID_BAR() do { XcdBarrier bar; bar.bar = (unsigned*)WSP(WS_CTL) + CW_BAR; bar.x = xb_xcc_id(); bar.st = F.MISC + 8; bar.tid = fresh_tid(wv_); xcd_barrier(bar); } while (0)
#else
#define GRID_BAR() do {} while (0)
#endif
    const int lo = args.ph_lo, hi = args.ph_hi;
#define IN(k) (lo <= (k) && (k) < hi)
    typedef const __attribute__((address_space(4))) Args* ArgsP;
#define WSP(off) (ws + (size_t)(z_ + (unsigned)(off)))
#define PHASE_ENTRY() unsigned z_ = 0u; asm volatile("" : "+s"(z_)); ArgsP ap_; { auto p_ = __builtin_amdgcn_kernarg_segment_ptr(); asm volatile("" : "+s"(p_)); ap_ = (ArgsP)p_; } \
    Args A; _Pragma("unroll") for (int i_ = 0; i_ < 18; ++i_) A.in[i_] = ap_->in[i_]; A.out = ap_->out; A.ws = ap_->ws; A.ph_lo = 0; A.ph_hi = 0; unsigned char* ws = A.ws; Frame F; F.lds = (LAS unsigned char*)lds; F.MISC = (volatile LAS unsigned*)(F.lds + MISC_OFF); \
    { int ln_; asm volatile("v_mbcnt_lo_u32_b32 %0, -1, 0\n\tv_mbcnt_hi_u32_b32 %0, -1, %0" : "=v"(ln_)); F.tid = wv_ * 64 + ln_; } F.lane = F.tid & 63; F.wave = __builtin_amdgcn_readfirstlane(F.tid >> 6); \
    { int g_ = gridDim.x; asm volatile("" : "+s"(g_)); F.G = g_; } int bx = (int)blockIdx.x; asm volatile("" : "+s"(bx)); F.vcu = (F.G % 8 == 0) ? (bx % 8) * (F.G / 8) + bx / 8 : bx; F.z = z_; F.ws = ws; F.ctl = (unsigned*)WSP(WS_CTL); \
    LAS unsigned char* ring = F.lds; LAS unsigned char* lepi = F.lds + EPI_OFF; unsigned char* wl = WSP(WS_WL) + (size_t)l * WL_STRIDE; (void)wl; (void)ring; (void)lepi; (void)bx

    if (IN(0)) { const int l = 0; PHASE_ENTRY(); REPS(9) p0_prologue(F, A); GRID_BAR(); }

    for (int l = 0; l < DEPTH; ++l) {
        const int base = 1 + 16 * l;
        if (IN(base + 0)) { PHASE_ENTRY();
            pg8::PlainOrder S; S.init(T / 256, NIN / 256, F.G, bx);
            if ((I8_INPROJ >> l) & 1u) {
                pg8::Gemm g{WSP(WS_XB8), wl, DM, DM, DM, 1};
                pg8::EpiInProj E{(const f32x4*)WSP(WS_SSQX), (bf16_t*)WSP(WS_QA), (bf16_t*)WSP(WS_KA), (bf16_t*)WSP(WS_VA), (bf16_t*)WSP(WS_CQK), (bf16_t*)WSP(WS_KB), (bf16_t*)WSP(WS_Z),
                                 (float*)WSP(WS_SSQC), (const f32x2*)WSP(WS_ROPEA), (const f32x2*)WSP(WS_ROPEB), (const float*)WSP(WS_ROWSC2)};
                pg8::gemm_phase<3>(ring, lepi, g, S, E, F.tid);
            } else {
                pg8::Gemm g{(const bf16_t*)WSP(WS_XB), (const bf16_t*)wl, DM, DM, DM, 2};
                pg8::EpiInProj E{(const f32x4*)WSP(WS_SSQX), (bf16_t*)WSP(WS_QA), (bf16_t*)WSP(WS_KA), (bf16_t*)WSP(WS_VA), (bf16_t*)WSP(WS_CQK), (bf16_t*)WSP(WS_KB), (bf16_t*)WSP(WS_Z),
                                 (float*)WSP(WS_SSQC), (const f32x2*)WSP(WS_ROPEA), (const f32x2*)WSP(WS_ROPEB), nullptr};
                REPS(0) pg8::gemm_phase<2>(ring, lepi, g, S, E, F.tid);
            }
            GRID_BAR();
        }
        if (IN(base + 1)) { PHASE_ENTRY();
            { pg8::Gemm g{WSP(WS_CQK), wl + WL_WUP, 512, 384, 384, 2}; pg8::PlainOrder S; S.init(T / 256, 3, F.G, bx);
              pg8::EpiUp E{(const f32x4*)WSP(WS_SSQC), (bf16_t*)WSP(WS_QB), (bf16_t*)WSP(WS_KB), (bf16_t*)WSP(WS_VB), (const f32x2*)WSP(WS_ROPEB), true};
              REPS(1) pg8::gemm_phase<2>(ring, lepi, g, S, E, F.tid); }
            { pg8::Gemm g{WSP(WS_CQK) + 384 * 2, wl + WL_WUKV, 512, 128, 128, 2}; pg8::PlainOrder S; S.init(T / 256, 3, F.G, bx);
              pg8::EpiUp E{(const f32x4*)WSP(WS_SSQC), (bf16_t*)WSP(WS_QB), (bf16_t*)WSP(WS_KB), (bf16_t*)WSP(WS_VB), (const f32x2*)WSP(WS_ROPEB), false};
              pg8::gemm_phase<2>(ring, lepi, g, S, E, F.tid); }
            __syncthreads();
            REPS(2) for (int u = F.vcu; u < 512; u += F.G)
                att::fft_a_unit(u & 7, u >> 3, (const bf16_t*)WSP(WS_Z), (const bf16_t*)WSP(WS_W1F), (const f32x2*)WSP(WS_TW), (bf16_t*)WSP(WS_AP), (char*)lds, F.tid);
            GRID_BAR();
        }
        if (IN(base + 2)) { PHASE_ENTRY();
            REPS(3) for (int u = bx; u < 256; u += F.G)
                att::mla_unit(u & 7, u >> 3, (const bf16_t*)WSP(WS_QB), (const bf16_t*)WSP(WS_KB), (const bf16_t*)WSP(WS_VB), (bf16_t*)WSP(WS_MIX), (char*)lds, fresh_tid(wv_));
            __syncthreads();
            REPS(4) for (int u = bx; u < 256; u += F.G) { const int j = u >> 3;
                att::dil_unit(u & 7, j >> 1, j & 1, (const bf16_t*)WSP(WS_QA), (const bf16_t*)WSP(WS_KA), (const bf16_t*)WSP(WS_VA), (bf16_t*)WSP(WS_MIX), (char*)lds, fresh_tid(wv_)); }
            __syncthreads();
            REPS(5) att::fft_c_units(F.vcu, F.G, (const bf16_t*)WSP(WS_AP), (const bf16_t*)WSP(WS_W2F), (bf16_t*)WSP(WS_MIX), (char*)lds, fresh_tid(wv_));
            if ((((l & 1) ? I8_MOE : I8_DENSE) >> (l >> 1)) & 1u) {
                const f32x4* sq = (const f32x4*)WSP(WS_SSQX); float* rsc = (float*)WSP(WS_ROWSC);
                for (int r = bx * 512 + fresh_tid(wv_); r < T; r += F.G * 512) { const f32x4 s = sq[r]; rsc[r] = I8_XR * sqrtf(((s.x + s.y) + (s.z + s.w)) * (1.0f / DM) + 1.0f); } }
            GRID_BAR();
        }
        if (IN(base + 3)) { PHASE_ENTRY();
            pg8::Gemm g{(const bf16_t*)WSP(WS_MIX), (const bf16_t*)(wl + WL_WOUT), DM, DM, DM, 2}; pg8::PlainOrder S; S.init(T / 256, 4, F.G, bx);
            const bool i8 = (((l & 1) ? I8_MOE : I8_DENSE) >> (l >> 1)) & 1u;
            const bool f8 = i8 || ((l & 1) ? ((FP8_MOE >> (l >> 1)) & 1u) : ((FP8_DENSE >> (l >> 1)) & 1u));
            pg8::EpiResid E{(bf16_t*)WSP(WS_XB), (float*)WSP(WS_SSQX), f8 ? (unsigned char*)WSP(WS_XB8) : nullptr, i8 ? (const float*)WSP(WS_ROWSC) : nullptr, 1.0f};
            pg8::gemm_phase<2>(ring, lepi, g, S, E, F.tid);
            GRID_BAR();
        }
        if ((l & 1) == 0) {
            if (IN(base + 4)) { PHASE_ENTRY(); unsigned char* wf = WSP(WS_WFF) + (size_t)(l >> 1) * WFF_STRIDE;
                if (l + 1 < DEPTH && ((I8_INPROJ >> (l + 1)) & 1u)) {
                    const f32x4* sq = (const f32x4*)WSP(WS_SSQX); float* rsc = (float*)WSP(WS_ROWSC2);
                    for (int r = bx * 512 + F.tid; r < T; r += F.G * 512) { const f32x4 s = sq[r]; rsc[r] = I8_XR * sqrtf(((s.x + s.y) + (s.z + s.w)) * (1.0f / DM) + 1.0f); } }
                pg8::PlainOrder S; S.init(T / 256, 2 * D_FF / 256, F.G, bx);
                if ((I8_DENSE >> (l >> 1)) & 1u) {
                    pg8::Gemm g{WSP(WS_XB8), wf, DM, DM, DM, 1};
                    pg8::EpiSwiGLU E{(const f32x4*)WSP(WS_SSQX), (bf16_t*)WSP(WS_HID), D_FF, nullptr, I8_WINV, (int)((FP8_DDOWN >> (l >> 1)) & 1u), nullptr, (const float*)WSP(WS_ROWSC)};
                    pg8::gemm_phase<3>(ring, lepi, g, S, E, F.tid);
                } else if ((FP8_DENSE >> (l >> 1)) & 1u) {
                    pg8::Gemm g{WSP(WS_XB8), wf, DM, DM, DM, 1};
                    pg8::EpiSwiGLU E{(const f32x4*)WSP(WS_SSQX), (bf16_t*)WSP(WS_HID), D_FF, nullptr, W8_INV, 1, nullptr, nullptr};
                    pg8::gemm_phase<1>(ring, lepi, g, S, E, F.tid);
                } else {
                    pg8::Gemm g{WSP(WS_XB), wf, DM, DM, DM, 2};
                    pg8::EpiSwiGLU E{(const f32x4*)WSP(WS_SSQX), (bf16_t*)WSP(WS_HID), D_FF, nullptr, 1.0f, (int)((FP8_DDOWN >> (l >> 1)) & 1u), nullptr, nullptr};
                    REPS(6) pg8::gemm_phase<2>(ring, lepi, g, S, E, F.tid);
                }
                GRID_BAR();
            }
            if (IN(base + 5)) { PHASE_ENTRY(); unsigned char* wf = WSP(WS_WFF) + (size_t)(l >> 1) * WFF_STRIDE;
                const bool nx8 = l + 1 < DEPTH && ((I8_INPROJ >> (l + 1)) & 1u);
                unsigned char* x8n = nx8 ? (unsigned char*)WSP(WS_XB8) : nullptr; const float* rs2 = nx8 ? (const float*)WSP(WS_ROWSC2) : nullptr;
                pg8::PlainOrder S; S.init(T / 256, 4, F.G, bx);
                if ((FP8_DDOWN >> (l >> 1)) & 1u) {
                    pg8::Gemm g{WSP(WS_HID), wf + WFF_WD, D_FF, D_FF, D_FF, 1};
                    pg8::EpiResid E{(bf16_t*)WSP(WS_XB), (float*)WSP(WS_SSQX), x8n, rs2, W8_INV};
                    pg8::gemm_phase<1>(ring, lepi, g, S, E, F.tid);
                } else {
                    pg8::Gemm g{WSP(WS_HID), wf + WFF_WD, D_FF, D_FF, D_FF, 2};
                    pg8::EpiResid E{(bf16_t*)WSP(WS_XB), (float*)WSP(WS_SSQX), x8n, rs2, 1.0f};
                    pg8::gemm_phase<2>(ring, lepi, g, S, E, F.tid);
                }
                GRID_BAR();
            }
        } else {
            if (IN(base + 4)) { PHASE_ENTRY();
                if (l + 1 < DEPTH && ((I8_INPROJ >> (l + 1)) & 1u)) {
                    const f32x4* sq = (const f32x4*)WSP(WS_SSQX); float* rsc = (float*)WSP(WS_ROWSC2);
                    for (int r = bx * 512 + F.tid; r < T; r += F.G * 512) { const f32x4 s = sq[r]; rsc[r] = I8_XR * sqrtf(((s.x + s.y) + (s.z + s.w)) * (1.0f / DM) + 1.0f); } }
                REPS(8) moe_r1(F, A, l); GRID_BAR(); }
            if (IN(base + 5)) { PHASE_ENTRY(); moe_r2(F, ((I8_MOE >> (l >> 1)) & 1u) ? (const float*)WSP(WS_ROWSC) : nullptr); GRID_BAR(); }
            static_assert(I8_MOE == 3u && FP8_MOE == 3u, "the MoE stage program below is the int8 gate/up + fp8 down one");
            if (IN(base + 6)) { PHASE_ENTRY();
                const int* rt = (const int*)WSP(WS_ROWTOK);
                const int ntl0 = __builtin_amdgcn_readfirstlane(((const int*)WSP(WS_TILEE))[1024]), ntl1 = __builtin_amdgcn_readfirstlane(((const int*)WSP(WS_TILEE))[1025]);
                pg8::Gemm g{WSP(WS_XB8), WSP(WS_WGUE), DM, DM, DM, 1};
                pg8::MoeOrder<true> S; S.init(ntl0 + ntl1, 2 * D_FFE / 256, F.G, bx); S.tile_e = (const int*)WSP(WS_TILEE); S.row_tok = rt; S.estride = (size_t)7168 * DM; S.ntl0 = ntl0;
                pg8::EpiSwiGLU E{(const f32x4*)WSP(WS_SSQX), (bf16_t*)WSP(WS_HID), D_FFE, rt, I8_WINV, 1, (const float*)WSP(WS_ROWRS), nullptr};
                pg8::gemm_phase<3>(ring, lepi, g, S, E, F.tid);
                GRID_BAR();
            }
            for (int sl = 0; sl < 2; ++sl) {
                if (IN(base + 7 + 2 * sl)) { PHASE_ENTRY();
                    const int* tile_e = (const int*)WSP(WS_TILEE) + sl * 272; const int* rt = (const int*)WSP(WS_ROWTOK) + sl * RT_STRIDE; const float* rg = (const float*)WSP(WS_ROWGATE) + sl * RT_STRIDE;
                    const int ntl = __builtin_amdgcn_readfirstlane(((const int*)WSP(WS_TILEE))[1024 + sl]);
                    const bool nx8 = l + 1 < DEPTH && ((I8_INPROJ >> (l + 1)) & 1u);
                    unsigned char* x8n = nx8 ? (unsigned char*)WSP(WS_XB8) : nullptr; const float* rs2 = (const float*)WSP(WS_ROWSC2);
                    pg8::Gemm g{WSP(WS_HID) + (size_t)sl * RT_STRIDE * D_FFE, WSP(WS_WDE), D_FFE, D_FFE, D_FFE, 1};
                    pg8::MoeOrder<false> S; S.init(ntl, 4, F.G, bx); S.tile_e = tile_e; S.row_tok = rt; S.estride = (size_t)DM * D_FFE;
                    pg8::EpiMoeDown E{(bf16_t*)WSP(WS_XB), (float*)WSP(WS_SSQX), rt, rg, x8n, rs2, sl, W8_INV};
                    pg8::gemm_phase<1>(ring, lepi, g, S, E, F.tid);
                    GRID_BAR();
                }
            }
        }
    }
    if (IN(65)) { const int l = 0; PHASE_ENTRY(); final_norm(F, A); }
#undef IN
#undef GRID_BAR
}

extern "C" void kernel_launch(void* const* d_in, const int* in_sizes, int n_in, void* d_out, int out_size, void* d_ws, size_t ws_size, hipStream_t stream) {
    static int grid = 0;
    if (grid == 0) {
        if (n_in != 18 || in_sizes[0] != T * DM || out_size != T * DM || ws_size < WS_END) {
            fprintf(stderr, "kernel_launch: shape mismatch: n_in %d in0 %d out %d ws %zu (need >= %zu); nothing launched\n", n_in, n_in > 0 ? in_sizes[0] : -1, out_size, ws_size, (size_t)WS_END); grid = -1; return; }
        int dev = 0, cus = 0, per_cu = 0;
        if (hipGetDevice(&dev) != hipSuccess || hipDeviceGetAttribute(&cus, hipDeviceAttributeMultiprocessorCount, dev) != hipSuccess) { fprintf(stderr, "kernel_launch: device query failed\n"); grid = -1; return; }
        if (hipFuncSetAttribute((const void*)mk_fwd, hipFuncAttributeMaxDynamicSharedMemorySize, LDS_BYTES) != hipSuccess) { fprintf(stderr, "kernel_launch: hipFuncSetAttribute failed\n"); grid = -1; return; }
        if (hipOccupancyMaxActiveBlocksPerMultiprocessor(&per_cu, (const void*)mk_fwd, NWAVES * 64, LDS_BYTES) != hipSuccess || per_cu < 1)
            fprintf(stderr, "kernel_launch: note: occupancy query reports %d workgroups per CU\n", per_cu);
        (void)hipGetLastError();
        grid = cus;
        if (grid > 256) grid = 256;
    }
    if (grid < 0) return;
    if (hipMemsetAsync((char*)d_ws + WS_CTL, 0, CTL_ZERO_BYTES, stream) != hipSuccess) { fprintf(stderr, "kernel_launch: memset failed\n"); return; }
    Args a{};
    for (int i = 0; i < 18; ++i) a.in[i] = (const float*)d_in[i];
    a.out = (float*)d_out; a.ws = (unsigned char*)d_ws;
#if MK_PER_PHASE
    int ids[80]; int n = 0; ids[n++] = 0;
    for (int l = 0; l < DEPTH; ++l) { const int base = 1 + 16 * l; const int np = (l & 1) ? 10 : 6; for (int p = 0; p < np; ++p) ids[n++] = base + p; }
    ids[n++] = 65;
    for (int i = 0; i < n; ++i) { a.ph_lo = ids[i]; a.ph_hi = ids[i] + 1; hipLaunchKernelGGL(mk_fwd, dim3(grid), dim3(NWAVES * 64), LDS_BYTES, stream, a); }
#else
    a.ph_lo = 0; a.ph_hi = 1000;
    hipLaunchKernelGGL(mk_fwd, dim3(grid), dim3(NWAVES * 64), LDS_BYTES, stream, a);
#endif
    const hipError_t le = hipPeekAtLastError();
    if (le != hipSuccess) fprintf(stderr, "kernel_launch: launch failed: %s\n", hipGetErrorName(le));
}
```

```cpp
#include <hip/hip_runtime.h>
#include <cstdio>
#include <cstdint>

#ifndef MK_PER_PHASE
#define MK_PER_PHASE 0
#endif

#ifndef PROBE_DUP
#define PROBE_DUP -1
#endif
#define REPS(k) for (int rep_ = 0; rep_ < ((PROBE_DUP) == (k) ? 2 : 1); ++rep_)

#define GAS __attribute__((address_space(1)))
#define LAS __attribute__((address_space(3)))
typedef unsigned short bf16_t;
typedef short bf16x8 __attribute__((ext_vector_type(8)));
typedef short s16x4 __attribute__((ext_vector_type(4)));
typedef float f32x4 __attribute__((ext_vector_type(4)));
typedef float f32x2 __attribute__((ext_vector_type(2)));
typedef float f32x16 __attribute__((ext_vector_type(16)));
typedef unsigned u32x4 __attribute__((ext_vector_type(4)));
typedef unsigned u32x2 __attribute__((ext_vector_type(2)));
typedef int i32x2 __attribute__((ext_vector_type(2)));
typedef int i32x4 __attribute__((ext_vector_type(4)));

constexpr int T = 65536, DM = 1024, SEQ = 8192, NBATCH = 8, DEPTH = 4;
constexpr int D_IN = 1952, NIN = 2304;
constexpr int D_FF = 2816, D_FFE = 3584, NEXP = 8;
constexpr float RMS_EPS = 1e-6f;
constexpr float QSCALE_A = 0.18033688011112042f;
constexpr float QSCALE_B = 0.14724444602590306f;
constexpr float FFT_SCALE = 0.0013810679320049755f;
constexpr int RT_STRIDE = T + 8 * 256;
constexpr int MAX_TILES = RT_STRIDE / 256;

constexpr size_t MiB = 1u << 20;
constexpr size_t WS_CTL = 0, CTL_ZERO_BYTES = 1 * MiB;
constexpr size_t WS_ROPEA = 1 * MiB;
constexpr size_t WS_ROPEB = 2 * MiB;
constexpr size_t WS_W1F = 3 * MiB;
constexpr size_t WS_W2F = 3 * MiB + 128 * 1024;
constexpr size_t WS_TW = 3 * MiB + 256 * 1024;
constexpr size_t WS_SSQX = 4 * MiB;
constexpr size_t WS_SSQC = 5 * MiB;
constexpr size_t WS_TOKE = 6 * MiB;
constexpr size_t WS_TOKG = 6 * MiB + 512 * 1024;
constexpr size_t WS_CNTWG = 7 * MiB;
constexpr size_t WS_ROWTOK = 8 * MiB;
constexpr size_t WS_ROWGATE = 9 * MiB;
constexpr size_t WS_TILEE = 10 * MiB;
constexpr size_t WS_ROWSC = 11 * MiB;
constexpr size_t WS_ROWSC2 = 11 * MiB + 512 * 1024;
constexpr size_t WS_ROWRS = 12 * MiB;
constexpr size_t WS_WL = 16 * MiB, WL_STRIDE = 8 * MiB;
constexpr size_t WL_WUP = 4608 * 1024, WL_WUKV = 4608 * 1024 + 1 * MiB, WL_WOUT = 6 * MiB;
constexpr size_t WS_WFF = 48 * MiB, WFF_STRIDE = 17 * MiB;
constexpr size_t WFF_WD = 11 * MiB;
constexpr size_t WS_WGUE = 82 * MiB;
constexpr size_t WS_WDE = 194 * MiB;
constexpr size_t WS_XB = 250 * MiB;
constexpr size_t WS_AP = 970 * MiB;
constexpr size_t WS_QA = 378 * MiB, WS_KA = 426 * MiB, WS_VA = 474 * MiB;
constexpr size_t WS_CQK = 522 * MiB;
constexpr size_t WS_Z = 586 * MiB;
constexpr size_t WS_QB = 650 * MiB, WS_KB = 722 * MiB;
constexpr size_t WS_VB = 794 * MiB;
constexpr size_t WS_MIX = 842 * MiB;
constexpr size_t WS_HID = 378 * MiB;
constexpr size_t WS_XB8 = 970 * MiB;
constexpr size_t WS_END = 1034 * MiB;
static_assert(WS_HID + (size_t)RT_STRIDE * D_FFE * 2 <= WS_MIX, "hidden overlay");

constexpr int CW_TMO = 0, CW_DBG = 16, CW_BAR = 4096;

constexpr int RING_BYTES = 131072;
constexpr int EPI_OFF = RING_BYTES;
constexpr int MISC_OFF = EPI_OFF + 4096;
constexpr int TAB_OFF = MISC_OFF + 1024;
constexpr int TAB_SLOT = 5120, TAB_REL = TAB_OFF - EPI_OFF;
constexpr int LDS_BYTES = TAB_OFF + 3 * TAB_SLOT;

#define RLX_AGENT __ATOMIC_RELAXED, __HIP_MEMORY_SCOPE_AGENT
#define LDS_WAIT() asm volatile("s_waitcnt lgkmcnt(0)" ::: "memory")
#define VM_WAIT() asm volatile("s_waitcnt vmcnt(0)" ::: "memory")
#define SBAR() __builtin_amdgcn_sched_barrier(0)

__device__ __forceinline__ unsigned cvt_pk_bf16(float lo, float hi) { unsigned r; asm volatile("v_cvt_pk_bf16_f32 %0, %1, %2" : "=v"(r) : "v"(lo), "v"(hi)); return r; }
__device__ __forceinline__ unsigned f2bf(float f) { unsigned u = __builtin_bit_cast(unsigned, f); return (u + 0x7fffu + ((u >> 16) & 1u)) >> 16; }
__device__ __forceinline__ unsigned pk2(float lo, float hi) { return f2bf(lo) | (f2bf(hi) << 16); }
__device__ __forceinline__ float bflo(unsigned w) { return __uint_as_float(w << 16); }
__device__ __forceinline__ float bfhi(unsigned w) { return __uint_as_float(w & 0xffff0000u); }
__device__ __forceinline__ float wave_sum(float v) {
#pragma unroll
    for (int o = 1; o < 64; o <<= 1) v += __shfl_xor(v, o);
    return v;
}
__device__ __forceinline__ float clamp448(float v) { return __builtin_amdgcn_fmed3f(v, -448.f, 448.f); }
__device__ __forceinline__ unsigned pk4_fp8(float a, float b, float c, float d) {
    int w = __builtin_amdgcn_cvt_pk_fp8_f32(clamp448(a), clamp448(b), 0, false); w = __builtin_amdgcn_cvt_pk_fp8_f32(clamp448(c), clamp448(d), w, true); return (unsigned)w; }
__device__ __forceinline__ float bf_lo(unsigned w) { return __uint_as_float(w << 16); }
__device__ __forceinline__ float bf_hi(unsigned w) { return __uint_as_float(w & 0xffff0000u); }
__device__ __forceinline__ unsigned pk4_i8(float a, float b, float c, float d) {
    const float M = 12582912.f;
    const unsigned ia = __float_as_uint(__builtin_amdgcn_fmed3f(a, -127.f, 127.f) + M), ib = __float_as_uint(__builtin_amdgcn_fmed3f(b, -127.f, 127.f) + M);
    const unsigned ic = __float_as_uint(__builtin_amdgcn_fmed3f(c, -127.f, 127.f) + M), id = __float_as_uint(__builtin_amdgcn_fmed3f(d, -127.f, 127.f) + M);
    return __builtin_amdgcn_perm(ib, ia, 0x0c0c0400u) | __builtin_amdgcn_perm(id, ic, 0x04000c0cu); }
constexpr float I8_WQ = 127.f * 32.f / 4.0f, I8_WINV = 4.0f / (127.f * 32.f);
constexpr float I8_XR = 4.0f / 127.f;
constexpr float W8_SCALE = 64.f, W8_INV = 1.0f / 64.f;
constexpr unsigned FP8_MOE = 3u;
constexpr unsigned I8_INPROJ = 15u;
constexpr unsigned I8_MOE = 3u;
constexpr unsigned I8_DENSE = 3u;
constexpr unsigned FP8_DENSE = 3u;
constexpr unsigned FP8_DDOWN = 3u;
template <int CTRL, int ROWMASK> __device__ __forceinline__ float dpp_step(float x) {
    return x + __builtin_bit_cast(float, __builtin_amdgcn_update_dpp(0, __builtin_bit_cast(int, x), CTRL, ROWMASK, 0xf, false)); }
__device__ __forceinline__ float wave_sum_dpp(float x) {
    x = dpp_step<0xB1, 0xf>(x); x = dpp_step<0x4E, 0xf>(x); x = dpp_step<0x124, 0xf>(x); x = dpp_step<0x128, 0xf>(x);
    x = dpp_step<0x142, 0xa>(x); x = dpp_step<0x143, 0xc>(x);
    return x; }
__device__ __forceinline__ u32x4 pack8(const float (&v)[8]) { u32x4 w; w.x = cvt_pk_bf16(v[0], v[1]); w.y = cvt_pk_bf16(v[2], v[3]); w.z = cvt_pk_bf16(v[4], v[5]); w.w = cvt_pk_bf16(v[6], v[7]); return w; }

#define XB_TMO      128
#define XB_XCNT(j)  (256  + 64 * (j))
#define XB_XSUB(j)  (1280 + 64 * (j))
#define XB_XGEN(j)  (2304 + 64 * (j))
#define XB_TOP      3328
#define XB_TOPGEN   3392
#define XCD_BAR_WORDS 3456
#define XB_SPIN_CAP (1u << 20)

__device__ __forceinline__ unsigned xb_ld(unsigned* p)              { return __hip_atomic_load(p, __ATOMIC_RELAXED, __HIP_MEMORY_SCOPE_AGENT); }
__device__ __forceinline__ unsigned xb_add(unsigned* p, unsigned v) { return __hip_atomic_fetch_add(p, v, __ATOMIC_RELAXED, __HIP_MEMORY_SCOPE_AGENT); }
__device__ __forceinline__ unsigned xb_xcc_id() { return (unsigned)__builtin_amdgcn_s_getreg((3 << 11) | 20) & 0xFu; }
#define XB_SPIN(cond, bar) do { unsigned _sp = 0; while (cond) { __builtin_amdgcn_s_sleep(1); \
    if ((++_sp & 255u) == 0u) { if (xb_ld(&(bar)[XB_TMO])) break; if (_sp > XB_SPIN_CAP) { atomicAdd(&(bar)[XB_TMO], 1u); break; } } } } while (0)

struct XcdBarrier { unsigned* bar; unsigned x; volatile LAS unsigned* st; int tid; };

__device__ __forceinline__ XcdBarrier xcd_barrier_post(unsigned* bar, volatile LAS unsigned* st) {
    XcdBarrier b; b.bar = bar; b.x = xb_xcc_id(); b.st = st;
    if (threadIdx.x == 0) (void)xb_add(&bar[XB_XCNT(b.x)], 1u);
    return b;
}
__device__ __forceinline__ void xcd_barrier_complete(unsigned* bar, unsigned x, unsigned& nloc, unsigned& nx) {
    const unsigned G = gridDim.x * gridDim.y * gridDim.z;
    unsigned sum, cnt, mine, sp = 0u;
    for (;;) {
        sum = 0u; cnt = 0u; mine = 0u;
#pragma unroll
        for (unsigned j = 0; j < 16; ++j) { const unsigned c = xb_ld(&bar[XB_XCNT(j)]); sum += c; cnt += (c > 0u) ? 1u : 0u; mine = (j == x) ? c : mine; }
        if (sum == G) break;
        __builtin_amdgcn_s_sleep(1);
        if ((++sp & 255u) == 0u) { if (xb_ld(&bar[XB_TMO])) break; if (sp > XB_SPIN_CAP) { atomicAdd(&bar[XB_TMO], 1u); break; } }
    }
    nloc = mine > 0u ? mine : 1u; nx = cnt > 0u ? cnt : 1u;
}
__device__ __forceinline__ void xcd_barrier(const XcdBarrier& b) {
    asm volatile("s_waitcnt vmcnt(0)" ::: "memory");
    __syncthreads();
    if (b.tid == 0) {
        unsigned* bar = b.bar;
        __builtin_amdgcn_s_waitcnt(0);
        unsigned nloc = b.st[0], nx = b.st[1];
        if (nloc == 0u) { xcd_barrier_complete(bar, b.x, nloc, nx); b.st[0] = nloc; b.st[1] = nx; }
        const unsigned old = xb_add(&bar[XB_XSUB(b.x)], 1u);
        const unsigned gen = old / nloc;
        if (old + 1u == (gen + 1u) * nloc) {
            __builtin_amdgcn_fence(__ATOMIC_RELEASE, "agent");
            asm volatile("s_waitcnt vmcnt(0)" ::: "memory");
            const unsigned og = xb_add(&bar[XB_TOP], 1u);
            const unsigned tg = og / nx;
            if (og + 1u == (tg + 1u) * nx) xb_add(&bar[XB_TOPGEN], 1u);
            else XB_SPIN(xb_ld(&bar[XB_TOPGEN]) == tg, bar);
            __builtin_amdgcn_fence(__ATOMIC_ACQUIRE, "agent");
            xb_add(&bar[XB_XGEN(b.x)], 1u);
            asm volatile("s_waitcnt vmcnt(0)" ::: "memory");
        } else {
            XB_SPIN(xb_ld(&bar[XB_XGEN(b.x)]) == gen, bar);
            __builtin_amdgcn_fence(__ATOMIC_ACQUIRE, "agent");
            asm volatile("s_waitcnt vmcnt(0)" ::: "memory");
        }
    }
    __syncthreads();
}
namespace pg8 {
constexpr int BM = 256, BK = 64, HALF = 128, HTB = HALF * BK * 2, STAGE_BYTES = 8 * HTB, NXCD = 8, WGM = 8;
__host__ __device__ __forceinline__ int lds_byte(int r, int c) { const int st = (r >> 4) * 2 + (c >> 5), rr = r & 15, cc = c & 31, ob = rr * 64 + cc * 2; return st * 1024 + (ob ^ (((ob >> 9) & 1) << 5)); }
__host__ __device__ __forceinline__ void stage_rc(int b, int& R, int& C) { const int st = b / 1024, sb = b % 1024, swz = sb ^ (((sb >> 9) & 1) << 5); R = (st >> 1) * 16 + swz / 64; C = (st & 1) * 32 + (swz % 64) / 2; }
__host__ __device__ __forceinline__ int perm32(int rho) { const int n = rho >> 4, i = rho & 15; return 8 * (i >> 2) + 4 * n + (i & 3); }

struct Unit { int pm, pn; };
typedef int i32x4 __attribute__((ext_vector_type(4)));
typedef int i32x8 __attribute__((ext_vector_type(8)));
__device__ __forceinline__ i32x8 cat16(bf16x8 lo, bf16x8 hi) { const i32x4 a = __builtin_bit_cast(i32x4, lo), b = __builtin_bit_cast(i32x4, hi); return __builtin_shufflevector(a, b, 0, 1, 2, 3, 4, 5, 6, 7); }
struct Gemm { const void* A; const void* Bt; int lda, ldb, K, esz; };

struct OrderBase {
    int nM, nN, nwg, G, c;
    __device__ __forceinline__ void init(int nM_, int nN_, int G_, int c_) { nM = nM_; nN = nN_; nwg = nM * nN; G = G_; c = c_; }
    __device__ __forceinline__ bool next(int i, Unit& u) const {
        const long L = (long)i * G + c; if (L >= nwg) return false;
        int wgid = (int)L; { const int q = nwg / NXCD, r = nwg % NXCD, xcd = wgid % NXCD, off = wgid / NXCD; wgid = (xcd < r ? xcd * (q + 1) : r * (q + 1) + (xcd - r) * q) + off; }
        const int nig = WGM * nN, gid = wgid / nig, fm = gid * WGM, gsz = (nM - fm) < WGM ? (nM - fm) : WGM;
        u.pm = fm + ((wgid % nig) % gsz); u.pn = (wgid % nig) / gsz; return true;
    }
};
struct PlainOrder : OrderBase {
    __device__ __forceinline__ const char* b_base(const Gemm& g, const Unit& u) const { return (const char*)g.Bt + (size_t)u.pn * BM * g.ldb * g.esz; }
    __device__ __forceinline__ void a_offs(const Gemm& g, const Unit& u, int R0, int C0, unsigned (&ao)[2][2]) const {
#pragma unroll
        for (int h = 0; h < 2; ++h)
#pragma unroll
            for (int i = 0; i < 2; ++i) ao[h][i] = (unsigned)((u.pm * BM + h * HALF + i * 64 + R0) * g.lda) * (unsigned)g.esz + (unsigned)C0 * 2u;
    }
};
template <bool GATHER> struct MoeOrder : OrderBase {
    const int* tile_e; const int* row_tok; size_t estride;
    int ntl0 = 1 << 30;
    __device__ __forceinline__ bool next(int i, Unit& u) const { if (!OrderBase::next(i, u)) return false; if (u.pm >= ntl0) u.pm += MAX_TILES - ntl0; return true; }
    __device__ __forceinline__ const char* b_base(const Gemm& g, const Unit& u) const {
        const int e = __builtin_amdgcn_readfirstlane(tile_e[u.pm + (u.pm >= MAX_TILES ? 8 : 0)]);
        return (const char*)g.Bt + ((size_t)e * estride + (size_t)u.pn * BM * g.ldb) * g.esz; }
    __device__ __forceinline__ void a_offs(const Gemm& g, const Unit& u, int R0, int C0, unsigned (&ao)[2][2]) const {
#pragma unroll
        for (int h = 0; h < 2; ++h)
#pragma unroll
            for (int i = 0; i < 2; ++i) {
                int r = u.pm * BM + h * HALF + i * 64 + R0;
                if (GATHER) { const int t = row_tok[r]; r = t < 0 ? 0 : t; }
                ao[h][i] = (unsigned)(r * g.lda) * (unsigned)g.esz + (unsigned)C0 * 2u; }
    }
};

template <int MODE, class Epi, class Sched>
__device__ __forceinline__ void gemm_phase(LAS unsigned char* lds, LAS unsigned char* lds_epi, const Gemm g, const Sched& S, const Epi& E, int tid) {
    asm volatile("" : "+v"(tid));
    const int wid = __builtin_amdgcn_readfirstlane(tid >> 6), lane = tid & 63, wr = wid >> 2, wc = wid & 3, fr = lane & 15, fq = lane >> 4;
    constexpr int ESZ = MODE == 2 ? 2 : 1;
    int nt = g.K * ESZ / 128;
    asm volatile("" : "+s"(nt));
    int R0, C0; stage_rc(tid * 16, R0, C0);
    unsigned voffB[2];
#pragma unroll
    for (int i = 0; i < 2; ++i) { const int R = R0 + i * 64; const int Rb = (R & ~31) + perm32(R & 31); voffB[i] = (unsigned)(Rb * g.ldb) * (unsigned)ESZ + (unsigned)C0 * 2u; }
    const size_t kstep = (size_t)(BK * 2);
    const size_t hstepB = (size_t)HALF * g.ldb * ESZ;
    const unsigned ldsw = (unsigned)wid * 1024u;
    const int aoff = lds_byte(wr * 64 + fr, fq * 8), boff = lds_byte(wc * 32 + fr, fq * 8);
    LAS unsigned char* abase = lds + aoff; LAS unsigned char* bbase = lds + 4 * HTB + boff; asm volatile("" : "+v"(abase), "+v"(bbase));
#define PG8_SA(b, h) (((b) * 2 + (h)) * HTB)
#define PG8_SB(b, h) ((4 + (b) * 2 + (h)) * HTB)
#define PG8_STAGE(bufoff, gbase, voff) do { _Pragma("unroll") for (int _i = 0; _i < 2; ++_i) \
        __builtin_amdgcn_global_load_lds((const unsigned*)((const char*)(gbase) + (voff)[_i]), (LAS unsigned*)(lds + (bufoff) + ldsw + _i * 8192), 16, 0, 0); } while (0)
#define PG8_LD16(base, off) (*(const LAS bf16x8*)((base) + (off)))
#define PG8_LDA(dst, b, h) do { if constexpr (MODE != 1) { _Pragma("unroll") for (int m = 0; m < 4; ++m) _Pragma("unroll") for (int k = 0; k < 2; ++k) dst[m][k] = PG8_LD16(abase, PG8_SA(b, h) + m * 2048 + k * 1024); } \
      else { _Pragma("unroll") for (int m = 0; m < 4; ++m) dst##8[m] = cat16(PG8_LD16(abase, PG8_SA(b, h) + m * 2048), PG8_LD16(abase, PG8_SA(b, h) + m * 2048 + 1024)); } } while (0)
#define PG8_LDB(dst, b, h) do { if constexpr (MODE != 1) { _Pragma("unroll") for (int n = 0; n < 2; ++n) _Pragma("unroll") for (int k = 0; k < 2; ++k) dst[n][k] = PG8_LD16(bbase, PG8_SA(b, h) + n * 2048 + k * 1024); } \
      else { _Pragma("unroll") for (int n = 0; n < 2; ++n) dst##8[n] = cat16(PG8_LD16(bbase, PG8_SA(b, h) + n * 2048), PG8_LD16(bbase, PG8_SA(b, h) + n * 2048 + 1024)); } } while (0)
#define PG8_MMA(ai, bj, At, Bt) do { __builtin_amdgcn_s_setprio(1); if constexpr (MODE == 2) { _Pragma("unroll") for (int m = 0; m < 4; ++m) _Pragma("unroll") for (int n = 0; n < 2; ++n) _Pragma("unroll") for (int k = 0; k < 2; ++k) \
        acc[ai][bj][m][n] = __builtin_amdgcn_mfma_f32_16x16x32_bf16(Bt[n][k], At[m][k], acc[ai][bj][m][n], 0, 0, 0); } \
      else if constexpr (MODE == 3) { _Pragma("unroll") for (int m = 0; m < 4; ++m) _Pragma("unroll") for (int n = 0; n < 2; ++n) _Pragma("unroll") for (int k = 0; k < 2; ++k) \
        acc[ai][bj][m][n] = __builtin_bit_cast(f32x4, __builtin_amdgcn_mfma_i32_16x16x64_i8(__builtin_bit_cast(i32x4, Bt[n][k]), __builtin_bit_cast(i32x4, At[m][k]), __builtin_bit_cast(i32x4, acc[ai][bj][m][n]), 0, 0, 0)); } \
      else { _Pragma("unroll") for (int m = 0; m < 4; ++m) _Pragma("unroll") for (int n = 0; n < 2; ++n) \
        asm volatile("s_nop 1\n\tv_mfma_scale_f32_16x16x128_f8f6f4 %0, %1, %2, %0, %3, %3 op_sel_hi:[0,0,0]" : "+v"(acc[ai][bj][m][n]) : "v"(Bt##8[n]), "v"(At##8[m]), "v"(0x7f7f7f7f)); } \
      __builtin_amdgcn_s_setprio(0); } while (0)
#define PG8_WAIT_V(n) asm volatile("s_waitcnt vmcnt(" #n ")" ::: "memory")
#define PG8_WAIT_L(n) asm volatile("s_waitcnt lgkmcnt(" #n ")" ::: "memory")
#define PG8_BAR __builtin_amdgcn_s_barrier()
#define PG8_SCHED __builtin_amdgcn_sched_barrier(0)
    Unit cur, nxt; int ui = 0;
    if (!S.next(0, cur)) return;
    f32x4 acc[2][2][4][2];
#pragma unroll
    for (int a = 0; a < 2; ++a)
#pragma unroll
        for (int b = 0; b < 2; ++b)
#pragma unroll
            for (int m = 0; m < 4; ++m)
#pragma unroll
                for (int n = 0; n < 2; ++n) acc[a][b][m][n] = (f32x4){0.f, 0.f, 0.f, 0.f};
    bf16x8 At[4][2], B0[2][2], B1[2][2]; i32x8 At8[4], B08[2], B18[2];
    unsigned ao[2][2], nao[2][2];
    S.a_offs(g, cur, R0, C0, ao);
    const char* const A0 = (const char*)g.A;
    const char* cB = S.b_base(g, cur);
    int eslot = 0; E.prefetch(cur, lds_epi, 0, wid, fq * 16 + fr);
    PG8_STAGE(PG8_SB(0, 0), cB, voffB); PG8_STAGE(PG8_SB(0, 1), cB + hstepB, voffB); PG8_STAGE(PG8_SA(0, 0), A0, ao[0]); PG8_STAGE(PG8_SA(0, 1), A0, ao[1]);
    if (wr == 1) PG8_BAR;
    PG8_WAIT_V(2); PG8_BAR;
    PG8_STAGE(PG8_SB(1, 0), cB + kstep, voffB); PG8_STAGE(PG8_SA(1, 0), A0 + kstep, ao[0]); PG8_STAGE(PG8_SB(1, 1), cB + hstepB + kstep, voffB);
    PG8_WAIT_V(6); PG8_BAR;
    for (;;) {
        const bool has_next = S.next(ui + 1, nxt);
        const char* nB = cB;
        if (has_next) { S.a_offs(g, nxt, R0, C0, nao); nB = S.b_base(g, nxt); E.prefetch(nxt, lds_epi, eslot == 2 ? 0 : eslot + 1, wid, fq * 16 + fr); }
        else {
#pragma unroll
            for (int h = 0; h < 2; ++h)
#pragma unroll
                for (int i = 0; i < 2; ++i) nao[h][i] = ao[h][i]; }
        for (int t = 0; t < nt; t += 2) {
            const bool last = (t == nt - 2);
            const char* a1 = A0 + (size_t)(t + 1) * kstep;
            const char* a2 = last ? A0 : A0 + (size_t)(t + 2) * kstep; const char* b2 = last ? nB : cB + (size_t)(t + 2) * kstep;
            const char* a3 = a2 + kstep; const char* b3 = b2 + kstep;
            unsigned a2o[2][2];
#pragma unroll
            for (int h = 0; h < 2; ++h)
#pragma unroll
                for (int i = 0; i < 2; ++i) a2o[h][i] = last ? nao[h][i] : ao[h][i];
            PG8_LDB(B0, 0, 0); PG8_LDB(B1, 0, 1); PG8_SCHED; PG8_LDA(At, 0, 0); PG8_STAGE(PG8_SA(1, 1), a1, ao[1]);
            PG8_WAIT_V(8); PG8_WAIT_L(0); PG8_BAR; PG8_MMA(0, 0, At, B0); PG8_MMA(0, 1, At, B1); PG8_BAR; PG8_SCHED;
            PG8_LDA(At, 0, 1); PG8_STAGE(PG8_SB(0, 0), b2, voffB); PG8_STAGE(PG8_SB(0, 1), b2 + hstepB, voffB); PG8_STAGE(PG8_SA(0, 0), a2, a2o[0]);
            PG8_WAIT_V(8); PG8_WAIT_L(0); PG8_BAR; PG8_MMA(1, 0, At, B0); PG8_MMA(1, 1, At, B1); PG8_BAR; PG8_SCHED;
            PG8_LDB(B0, 1, 0); PG8_LDB(B1, 1, 1); PG8_SCHED; PG8_LDA(At, 1, 0); PG8_STAGE(PG8_SA(0, 1), a2, a2o[1]);
            PG8_WAIT_V(8); PG8_WAIT_L(0); PG8_BAR; PG8_MMA(0, 0, At, B0); PG8_MMA(0, 1, At, B1); PG8_BAR; PG8_SCHED;
            PG8_LDA(At, 1, 1); PG8_STAGE(PG8_SB(1, 0), b3, voffB); PG8_STAGE(PG8_SB(1, 1), b3 + hstepB, voffB); PG8_STAGE(PG8_SA(1, 0), a3, a2o[0]);
            PG8_WAIT_V(8); PG8_WAIT_L(0); PG8_BAR; PG8_MMA(1, 0, At, B0); PG8_MMA(1, 1, At, B1); PG8_BAR; PG8_SCHED;
        }
        if constexpr (MODE == 3) {
#pragma unroll
            for (int a = 0; a < 2; ++a)
#pragma unroll
                for (int b = 0; b < 2; ++b)
#pragma unroll
                    for (int m = 0; m < 4; ++m)
#pragma unroll
                        for (int n = 0; n < 2; ++n) acc[a][b][m][n] = __builtin_convertvector(__builtin_bit_cast(i32x4, acc[a][b][m][n]), f32x4);
        }
        if constexpr (MODE == 1) asm volatile("s_nop 15\n\ts_nop 15" ::: "memory");
        if (wr == 0) PG8_BAR;
        E.eslot = eslot; E(acc, cur, wr, wc, fr, fq, lds_epi, tid); eslot = eslot == 2 ? 0 : eslot + 1;
        if (!has_next) break;
#pragma unroll
        for (int a = 0; a < 2; ++a)
#pragma unroll
            for (int b = 0; b < 2; ++b)
#pragma unroll
                for (int m = 0; m < 4; ++m)
#pragma unroll
                    for (int n = 0; n < 2; ++n) acc[a][b][m][n] = (f32x4){0.f, 0.f, 0.f, 0.f};
        cur = nxt; cB = nB; ++ui;
#pragma unroll
        for (int h = 0; h < 2; ++h)
#pragma unroll
            for (int i = 0; i < 2; ++i) ao[h][i] = nao[h][i];
        if (wr == 1) PG8_BAR;
    }
    PG8_WAIT_V(0);
    PG8_BAR;
#undef PG8_SA
#undef PG8_SB
#undef PG8_STAGE
#undef PG8_LD16
#undef PG8_LDA
#undef PG8_LDB
#undef PG8_MMA
#undef PG8_WAIT_V
#undef PG8_WAIT_L
#undef PG8_BAR
#undef PG8_SCHED
}

__device__ __forceinline__ void row_reduce_store(const float (&part)[2][4], LAS unsigned char* lds_epi, int pm, int wr, int wc, int fr, int fq, int tid, float* dst, int slot, const int* rowmap) {
    LAS float* P = (LAS float*)lds_epi;
#pragma unroll
    for (int ai = 0; ai < 2; ++ai)
#pragma unroll
        for (int m = 0; m < 4; ++m) { float s = part[ai][m]; s += __shfl_xor(s, 16); s += __shfl_xor(s, 32);
            if (fq == 0) P[(ai * HALF + wr * 64 + m * 16 + fr) * 4 + wc] = s; }
    asm volatile("s_waitcnt lgkmcnt(0)" ::: "memory"); __builtin_amdgcn_s_barrier(); asm volatile("" ::: "memory");
    if (tid < 256) { const f32x4 p = *(const LAS f32x4*)(P + tid * 4); int r = pm * BM + tid; if (rowmap) r = rowmap[r];
        if (r >= 0) dst[(size_t)r * 4 + slot] = (p.x + p.y) + (p.z + p.w); }
}
__device__ __forceinline__ void st16(bf16_t* p, const float (&v)[8]) { *(u32x4*)p = pack8(v); }
__device__ __forceinline__ void rot_pairs(float (&v)[8], const f32x4 c01, const f32x4 c23) {
    const float c[4] = {c01.x, c01.z, c23.x, c23.z}, s[4] = {c01.y, c01.w, c23.y, c23.w};
#pragma unroll
    for (int i = 0; i < 4; ++i) { const float a = v[2 * i], b = v[2 * i + 1]; v[2 * i] = a * c[i] - b * s[i]; v[2 * i + 1] = b * c[i] + a * s[i]; }
}
__device__ __forceinline__ LAS unsigned char* epi_tab(LAS unsigned char* lds_epi, int slot) { return lds_epi + TAB_REL + slot * TAB_SLOT; }
__device__ __forceinline__ void epi_tab_fetch(const f32x4* sq, const float* sc, int pm, LAS unsigned char* tab, int wid, int lane) {
    asm volatile("" : "+v"(lane));
    pm = __builtin_amdgcn_readfirstlane(pm);
    if (wid < 4) __builtin_amdgcn_global_load_lds((const unsigned*)((const char*)sq + (size_t)(pm * BM + wid * 64) * 16 + (size_t)(unsigned)(lane * 16)), (LAS unsigned*)(tab + wid * 1024), 16, 0, 0);
    else if (sc) __builtin_amdgcn_global_load_lds((const unsigned*)((const char*)sc + (size_t)(pm * BM + (wid - 4) * 64) * 4 + (size_t)(unsigned)(lane * 4)), (LAS unsigned*)(tab + 4096 + (wid - 4) * 256), 4, 0, 0);
}

struct EpiInProj {
    const f32x4* ssqx; bf16_t *QA, *KA, *VA, *CQK, *KB, *Z; float* ssqc; const f32x2* ropeA; const f32x2* ropeB; const float* rowsc;
    mutable int eslot = 0;
    __device__ __forceinline__ void prefetch(const Unit& u, LAS unsigned char* lds_epi, int slot, int wid, int lane) const { epi_tab_fetch(ssqx, rowsc, u.pm, epi_tab(lds_epi, slot), wid, lane); }
    __device__ __forceinline__ void operator()(const f32x4 (&acc)[2][2][4][2], const Unit& u, int wr, int wc, int fr, int fq, LAS unsigned char* lds_epi, int tid) const {
        int cw = wc * 32 + fq * 8; asm volatile("" : "+v"(cw));
        const int row0 = u.pm * BM + wr * 64 + fr;
        float rs[2][4], part[2][4];
        { f32x4 sq[2][4]; const LAS unsigned char* tab = epi_tab(lds_epi, eslot);
#pragma unroll
          for (int ai = 0; ai < 2; ++ai)
#pragma unroll
              for (int m = 0; m < 4; ++m) sq[ai][m] = ((const LAS f32x4*)tab)[ai * HALF + wr * 64 + m * 16 + fr];
#pragma unroll
          for (int ai = 0; ai < 2; ++ai)
#pragma unroll
              for (int m = 0; m < 4; ++m) { const f32x4 s = sq[ai][m]; rs[ai][m] = rsqrtf(((s.x + s.y) + (s.z + s.w)) * (1.0f / DM) + RMS_EPS); part[ai][m] = 0.f; }
          if (rowsc) { float sc[2][4];
#pragma unroll
              for (int ai = 0; ai < 2; ++ai)
#pragma unroll
                  for (int m = 0; m < 4; ++m) sc[ai][m] = ((const LAS float*)(tab + 4096))[ai * HALF + wr * 64 + m * 16 + fr];
#pragma unroll
              for (int ai = 0; ai < 2; ++ai)
#pragma unroll
                  for (int m = 0; m < 4; ++m) rs[ai][m] *= sc[ai][m] * I8_WINV; } }
#pragma unroll
        for (int bj = 0; bj < 2; ++bj) {
            const int ht = u.pn * 2 + bj;
            const float segf = rowsc ? (ht < 3 ? QSCALE_A : ht >= 14 ? 8.0f : 1.0f) : 1.0f;
            bf16_t* dst = nullptr; int pitch = 0; int kind = 0;
            if (ht < 3) { dst = QA + ht * 128 + cw; pitch = 384; kind = 1; }
            else if (ht < 6) { dst = KA + (ht - 3) * 128 + cw; pitch = 384; kind = 1; }
            else if (ht < 9) { dst = VA + (ht - 6) * 128 + cw; pitch = 384; }
            else if (ht < 12) { dst = CQK + (ht - 9) * 128 + cw; pitch = 512; kind = 3; }
            else if (ht == 12) { dst = CQK + 384 + cw; pitch = 512; kind = 3; }
            else if (ht == 13) { kind = 2; }
            else { dst = Z + (ht - 14) * 128 + cw; pitch = 512; }
            const bool rotA = (wc & 1) == 0 && fq < 2;
            const f32x2* tb = kind == 1 ? ropeA + (fq & 1) * 4 : ropeB + fq * 4; const int tp = kind == 1 ? 8 : 16;
#pragma unroll
            for (int ai = 0; ai < 2; ++ai) {
                f32x4 cs[4][2];
                if (kind == 1 || kind == 2) {
#pragma unroll
                    for (int m = 0; m < 4; ++m) { const f32x2* q = tb + (size_t)((row0 + ai * HALF + m * 16) & (SEQ - 1)) * tp; cs[m][0] = *(const f32x4*)q; cs[m][1] = *(const f32x4*)(q + 2); }
                }
#pragma unroll
                for (int m = 0; m < 4; ++m) {
                    const int row = row0 + ai * HALF + m * 16; const float r = rs[ai][m] * segf;
                    float v[8];
#pragma unroll
                    for (int n = 0; n < 2; ++n)
#pragma unroll
                        for (int j = 0; j < 4; ++j) v[4 * n + j] = acc[ai][bj][m][n][j] * r;
                    if (kind == 1) { if (rotA) rot_pairs(v, cs[m][0], cs[m][1]); st16(dst + (size_t)row * pitch, v); }
                    else if (kind == 2) { if (wc == 0) { rot_pairs(v, cs[m][0], cs[m][1]); const u32x4 w = pack8(v);
#pragma unroll
                            for (int h = 0; h < 6; ++h) *(u32x4*)(KB + (size_t)row * 576 + h * 96 + 64 + fq * 8) = w; } }
                    else { if (kind == 3) { float s = 0.f;
#pragma unroll
                            for (int j = 0; j < 8; ++j) s += v[j] * v[j];
                            part[ai][m] += s; }
                        st16(dst + (size_t)row * pitch, v); }
                }
                asm volatile("" ::: "memory");
            }
        }
        if (u.pn >= 4 && u.pn <= 6) row_reduce_store(part, lds_epi, u.pm, wr, wc, fr, fq, tid, ssqc, u.pn - 4, nullptr);
    }
};

struct EpiUp {
    const f32x4* ssqc; bf16_t *QB, *KB, *VB; const f32x2* ropeB; bool isq;
    mutable int eslot = 0;
    __device__ __forceinline__ void prefetch(const Unit& u, LAS unsigned char* lds_epi, int slot, int wid, int lane) const { epi_tab_fetch(ssqc, nullptr, u.pm, epi_tab(lds_epi, slot), wid, lane); }
    __device__ __forceinline__ void operator()(const f32x4 (&acc)[2][2][4][2], const Unit& u, int wr, int wc, int fr, int fq, LAS unsigned char* lds_epi, int tid) const {
        int cw = wc * 32 + fq * 8; asm volatile("" : "+v"(cw));
        const int row0 = u.pm * BM + wr * 64 + fr;
        float rs[2][4];
        { f32x4 sq[2][4];
#pragma unroll
          for (int ai = 0; ai < 2; ++ai)
#pragma unroll
              for (int m = 0; m < 4; ++m) sq[ai][m] = ((const LAS f32x4*)epi_tab(lds_epi, eslot))[ai * HALF + wr * 64 + m * 16 + fr];
#pragma unroll
          for (int ai = 0; ai < 2; ++ai)
#pragma unroll
              for (int m = 0; m < 4; ++m) { const f32x4 s = sq[ai][m]; rs[ai][m] = isq ? rsqrtf((s.x + s.y) * (1.0f / 384.0f) + RMS_EPS) : rsqrtf(s.z * (1.0f / 128.0f) + RMS_EPS); } }
#pragma unroll
        for (int bj = 0; bj < 2; ++bj) {
            const int n0 = u.pn * BM + bj * HALF + cw;
            bf16_t* dst; int pitch; int ropeoff = -1; bool valid = true;
            if (isq) { const int head = n0 / 96, ip = n0 - head * 96; valid = n0 < 576; dst = QB + n0; pitch = 576; if (ip >= 64) ropeoff = (ip - 64) >> 1; }
            else if (n0 < 384) { const int head = n0 >> 6; dst = KB + head * 96 + (n0 & 63); pitch = 576; }
            else { dst = VB + (n0 - 384); pitch = 384; }
            const f32x2* tb = ropeB + (ropeoff < 0 ? 0 : ropeoff);
#pragma unroll
            for (int ai = 0; ai < 2; ++ai) {
                f32x4 cs[4][2];
                if (isq) {
#pragma unroll
                    for (int m = 0; m < 4; ++m) { const f32x2* q = tb + (size_t)((row0 + ai * HALF + m * 16) & (SEQ - 1)) * 16; cs[m][0] = *(const f32x4*)q; cs[m][1] = *(const f32x4*)(q + 2); } }
#pragma unroll
                for (int m = 0; m < 4; ++m) {
                    const int row = row0 + ai * HALF + m * 16; const float r = rs[ai][m];
                    float v[8];
#pragma unroll
                    for (int n = 0; n < 2; ++n)
#pragma unroll
                        for (int j = 0; j < 4; ++j) v[4 * n + j] = acc[ai][bj][m][n][j] * r;
                    if (ropeoff >= 0) rot_pairs(v, cs[m][0], cs[m][1]);
                    if (valid) st16(dst + (size_t)row * pitch, v);
                }
                asm volatile("" ::: "memory");
            }
        }
    }
};

struct EpiResid {
    bf16_t* XM; float* ssqx; unsigned char* XB8; const float* rowsc; float ascale;
    mutable int eslot = 0;
    __device__ __forceinline__ void prefetch(const Unit&, LAS unsigned char*, int, int, int) const {}
    __device__ __forceinline__ void operator()(const f32x4 (&acc)[2][2][4][2], const Unit& u, int wr, int wc, int fr, int fq, LAS unsigned char* lds_epi, int tid) const {
        int cw = wc * 32 + fq * 8; asm volatile("" : "+v"(cw));
        const int row0 = u.pm * BM + wr * 64 + fr, col0 = u.pn * BM + cw;
        float part[2][4];
#pragma unroll
        for (int ai = 0; ai < 2; ++ai)
          {
            u32x4 xr[4][2]; float qs[4] = {1.f, 1.f, 1.f, 1.f};
            if (rowsc) {
#pragma unroll
                for (int mm = 0; mm < 4; ++mm) qs[mm] = rowsc[row0 + ai * HALF + mm * 16]; }
#pragma unroll
            for (int mm = 0; mm < 4; ++mm) { const size_t off = (size_t)(row0 + ai * HALF + mm * 16) * DM + col0;
#pragma unroll
                for (int bj = 0; bj < 2; ++bj) xr[mm][bj] = *(const u32x4*)(XM + off + bj * HALF); }
#pragma unroll
            for (int mm = 0; mm < 4; ++mm) { const int m = mm; const size_t off = (size_t)(row0 + ai * HALF + m * 16) * DM + col0; float s = 0.f; const float iq = __builtin_amdgcn_rcpf(qs[mm]);
#pragma unroll
                for (int bj = 0; bj < 2; ++bj) { const u32x4 xw = xr[mm][bj];
                    const f32x4 x0 = {bf_lo(xw.x), bf_hi(xw.x), bf_lo(xw.y), bf_hi(xw.y)}, x1 = {bf_lo(xw.z), bf_hi(xw.z), bf_lo(xw.w), bf_hi(xw.w)};
                    const f32x4 y0 = x0 + acc[ai][bj][m][0] * ascale, y1 = x1 + acc[ai][bj][m][1] * ascale;
                    u32x4 w; w.x = cvt_pk_bf16(y0.x, y0.y); w.y = cvt_pk_bf16(y0.z, y0.w); w.z = cvt_pk_bf16(y1.x, y1.y); w.w = cvt_pk_bf16(y1.z, y1.w);
                    *(u32x4*)(XM + off + bj * HALF) = w;
                    if (XB8) { u32x2 w8;
                        if (rowsc) { w8.x = pk4_i8(y0.x * iq, y0.y * iq, y0.z * iq, y0.w * iq); w8.y = pk4_i8(y1.x * iq, y1.y * iq, y1.z * iq, y1.w * iq); }
                        else { w8.x = pk4_fp8(y0.x, y0.y, y0.z, y0.w); w8.y = pk4_fp8(y1.x, y1.y, y1.z, y1.w); }
                        *(u32x2*)(XB8 + off + bj * HALF) = w8; }
                    s += (y0.x * y0.x + y0.y * y0.y) + (y0.z * y0.z + y0.w * y0.w) + (y1.x * y1.x + y1.y * y1.y) + (y1.z * y1.z + y1.w * y1.w);
                }
                part[ai][m] = s; }
            asm volatile("" ::: "memory");
          }
        row_reduce_store(part, lds_epi, u.pm, wr, wc, fr, fq, tid, ssqx, u.pn, nullptr);
    }
};

__device__ __forceinline__ float silu_mul(float g, float u) { return g * u * __builtin_amdgcn_rcpf(1.0f + __builtin_amdgcn_exp2f(-1.4426950408889634f * g)); }
struct EpiSwiGLU {
    const f32x4* ssqx; bf16_t* HID; int ldh; const int* rowmap; float ascale; int out8; const float* rowrs; const float* rowsc; mutable int eslot = 0;
    __device__ __forceinline__ void prefetch(const Unit& u, LAS unsigned char* lds_epi, int slot, int wid, int lane) const {
        LAS unsigned char* tab = epi_tab(lds_epi, slot);
        if (rowrs) { if (wid < 4) { asm volatile("" : "+v"(lane)); const int pm = __builtin_amdgcn_readfirstlane(u.pm);
                __builtin_amdgcn_global_load_lds((const unsigned*)((const char*)rowrs + (size_t)(pm * BM + wid * 64) * 4 + (size_t)(unsigned)(lane * 4)), (LAS unsigned*)(tab + wid * 256), 4, 0, 0); } }
        else if (!rowmap) epi_tab_fetch(ssqx, rowsc, u.pm, tab, wid, lane); }
    __device__ __forceinline__ void operator()(const f32x4 (&acc)[2][2][4][2], const Unit& u, int wr, int wc, int fr, int fq, LAS unsigned char* lds_epi, int tid) const {
        int cw = wc * 32 + fq * 8; asm volatile("" : "+v"(cw));
        const int row0 = u.pm * BM + wr * 64 + fr, col0 = u.pn * HALF + cw;
        float rs[2][4];
        if (rowrs) {
            const LAS float* T = (const LAS float*)epi_tab(lds_epi, eslot);
#pragma unroll
            for (int ai = 0; ai < 2; ++ai)
#pragma unroll
                for (int m = 0; m < 4; ++m) rs[ai][m] = T[ai * HALF + wr * 64 + m * 16 + fr] * ascale;
        } else {
            int tok[2][4];
#pragma unroll
            for (int ai = 0; ai < 2; ++ai)
#pragma unroll
                for (int m = 0; m < 4; ++m) { const int row = row0 + ai * HALF + m * 16; tok[ai][m] = rowmap ? rowmap[row] : row; }
            f32x4 sq[2][4]; float sc[2][4];
            if (!rowmap) {
                const LAS unsigned char* tab = epi_tab(lds_epi, eslot);
#pragma unroll
                for (int ai = 0; ai < 2; ++ai)
#pragma unroll
                    for (int m = 0; m < 4; ++m) { const int rr = ai * HALF + wr * 64 + m * 16 + fr; sq[ai][m] = ((const LAS f32x4*)tab)[rr]; sc[ai][m] = rowsc ? ((const LAS float*)(tab + 4096))[rr] : 1.0f; }
            } else {
#pragma unroll
            for (int ai = 0; ai < 2; ++ai)
#pragma unroll
                for (int m = 0; m < 4; ++m) { sq[ai][m] = ssqx[tok[ai][m] < 0 ? 0 : tok[ai][m]]; sc[ai][m] = rowsc ? rowsc[tok[ai][m] < 0 ? 0 : tok[ai][m]] : 1.0f; }
            }
#pragma unroll
            for (int ai = 0; ai < 2; ++ai)
#pragma unroll
                for (int m = 0; m < 4; ++m) { const f32x4 s = sq[ai][m]; const float r = rsqrtf(((s.x + s.y) + (s.z + s.w)) * (1.0f / DM) + RMS_EPS) * (ascale * sc[ai][m]); rs[ai][m] = tok[ai][m] < 0 ? 0.f : r; }
        }
#pragma unroll
        for (int ai = 0; ai < 2; ++ai)
#pragma unroll
            for (int m = 0; m < 4; ++m) {
                const int row = row0 + ai * HALF + m * 16; const float r = rs[ai][m]; const float c1 = -1.4426950408889634f * r, ir2 = __builtin_amdgcn_rcpf(r * r);
                float v[8];
#pragma unroll
                for (int n = 0; n < 2; ++n)
#pragma unroll
                    for (int j = 0; j < 4; ++j) { const float ag = acc[ai][0][m][n][j], au = acc[ai][1][m][n][j];
                        const float e = __builtin_amdgcn_exp2f(ag * c1); v[4 * n + j] = (ag * au) * __builtin_amdgcn_rcpf(__builtin_fmaf(e, ir2, ir2)); }
                if (out8) { u32x2 w8; w8.x = pk4_fp8(v[0], v[1], v[2], v[3]); w8.y = pk4_fp8(v[4], v[5], v[6], v[7]); *(u32x2*)((unsigned char*)HID + (size_t)row * ldh + col0) = w8; }
                else st16(HID + (size_t)row * ldh + col0, v);
            }
    }
};

struct EpiMoeDown {
    bf16_t* XM; float* ssqx; const int* rowmap; const float* rowgate; unsigned char* XB8; const float* rowsc; int last; float ascale;
    mutable int eslot = 0;
    __device__ __forceinline__ void prefetch(const Unit& u, LAS unsigned char* lds_epi, int slot, int wid, int lane) const {
        asm volatile("" : "+v"(lane)); const int pm = __builtin_amdgcn_readfirstlane(u.pm); LAS unsigned char* tab = epi_tab(lds_epi, slot);
        if (wid < 4) __builtin_amdgcn_global_load_lds((const unsigned*)((const char*)rowmap + (size_t)(pm * BM + wid * 64) * 4 + (size_t)(unsigned)(lane * 4)), (LAS unsigned*)(tab + wid * 256), 4, 0, 0);
        else __builtin_amdgcn_global_load_lds((const unsigned*)((const char*)rowgate + (size_t)(pm * BM + (wid - 4) * 64) * 4 + (size_t)(unsigned)(lane * 4)), (LAS unsigned*)(tab + 4096 + (wid - 4) * 256), 4, 0, 0); }
    __device__ __forceinline__ void operator()(const f32x4 (&acc)[2][2][4][2], const Unit& u, int wr, int wc, int fr, int fq, LAS unsigned char* lds_epi, int tid) const {
        int cw = wc * 32 + fq * 8; asm volatile("" : "+v"(cw));
        const int row0 = u.pm * BM + wr * 64 + fr, col0 = u.pn * BM + cw;
        float part[2][4]; int tok[2][4];
#pragma unroll
        for (int ai = 0; ai < 2; ++ai)
#pragma unroll
            for (int m = 0; m < 4; ++m) tok[ai][m] = ((const LAS int*)epi_tab(lds_epi, eslot))[ai * HALF + wr * 64 + m * 16 + fr];
#pragma unroll
        for (int ai = 0; ai < 2; ++ai)
          {
            u32x4 xr[4][2]; float gt[4], qs[4] = {1.f, 1.f, 1.f, 1.f};
#pragma unroll
            for (int mm = 0; mm < 4; ++mm) gt[mm] = ((const LAS float*)(epi_tab(lds_epi, eslot) + 4096))[ai * HALF + wr * 64 + mm * 16 + fr] * ascale;
            if (XB8) {
#pragma unroll
                for (int mm = 0; mm < 4; ++mm) { const int tk = tok[ai][mm]; qs[mm] = rowsc[tk < 0 ? 0 : tk]; } }
#pragma unroll
            for (int mm = 0; mm < 4; ++mm) { const int m = mm; const size_t off = (size_t)(tok[ai][m] < 0 ? 0 : tok[ai][m]) * DM + col0;
#pragma unroll
                for (int bj = 0; bj < 2; ++bj) xr[mm][bj] = *(const u32x4*)(XM + off + bj * HALF); }
#pragma unroll
            for (int mm = 0; mm < 4; ++mm) { const int m = mm; const int tk = tok[ai][m]; const float g1 = gt[mm]; float s = 0.f; const float iq = __builtin_amdgcn_rcpf(qs[mm]);
                if (tk >= 0) { const size_t off = (size_t)tk * DM + col0;
#pragma unroll
                    for (int bj = 0; bj < 2; ++bj) { const u32x4 xw = xr[mm][bj];
                        const f32x4 x0 = {bf_lo(xw.x), bf_hi(xw.x), bf_lo(xw.y), bf_hi(xw.y)}, x1 = {bf_lo(xw.z), bf_hi(xw.z), bf_lo(xw.w), bf_hi(xw.w)};
                        const f32x4 y0 = x0 + acc[ai][bj][m][0] * g1, y1 = x1 + acc[ai][bj][m][1] * g1;
                        u32x4 w; w.x = cvt_pk_bf16(y0.x, y0.y); w.y = cvt_pk_bf16(y0.z, y0.w); w.z = cvt_pk_bf16(y1.x, y1.y); w.w = cvt_pk_bf16(y1.z, y1.w);
                        *(u32x4*)(XM + off + bj * HALF) = w;
                        if (last) {
                            if (XB8) { u32x2 w8; w8.x = pk4_i8(y0.x * iq, y0.y * iq, y0.z * iq, y0.w * iq); w8.y = pk4_i8(y1.x * iq, y1.y * iq, y1.z * iq, y1.w * iq); *(u32x2*)(XB8 + off + bj * HALF) = w8; }
                            s += (y0.x * y0.x + y0.y * y0.y) + (y0.z * y0.z + y0.w * y0.w) + (y1.x * y1.x + y1.y * y1.y) + (y1.z * y1.z + y1.w * y1.w); }
                    } }
                part[ai][m] = s; }
            asm volatile("" ::: "memory");
          }
        if (last) row_reduce_store(part, lds_epi, u.pm, wr, wc, fr, fq, tid, ssqx, u.pn, rowmap);
    }
};
struct EpiNull { float* sink; mutable int eslot = 0;
    __device__ __forceinline__ void prefetch(const Unit&, LAS unsigned char*, int, int, int) const {}
    __device__ __forceinline__ void operator()(const f32x4 (&acc)[2][2][4][2], const Unit& u, int wr, int wc, int fr, int fq, LAS unsigned char* lds_epi, int tid) const {
        f32x4 s = {0.f, 0.f, 0.f, 0.f};
#pragma unroll
        for (int ai = 0; ai < 2; ++ai)
#pragma unroll
            for (int bj = 0; bj < 2; ++bj)
#pragma unroll
                for (int m = 0; m < 4; ++m) { s += acc[ai][bj][m][0]; s += acc[ai][bj][m][1]; }
        if ((s.x + s.y) + (s.z + s.w) == 12345.678f) sink[tid] = s.x;
    }
};
}
namespace att {
__device__ __forceinline__ int crow(int r, int hi) { return (r & 3) + 8 * (r >> 2) + 4 * hi; }
__device__ __forceinline__ bf16x8 ld8(const bf16_t* p) { return *reinterpret_cast<const bf16x8*>(p); }
constexpr float THR = 8.f;
__device__ __forceinline__ void partialSM(f32x16& p0, f32x16& p1, float& m_reg, float& alpha) {
    float pmax = p0[0];
#pragma unroll
    for (int r = 1; r < 16; ++r) pmax = fmaxf(pmax, p0[r]);
#pragma unroll
    for (int r = 0; r < 16; ++r) pmax = fmaxf(pmax, p1[r]);
    { auto rr = __builtin_amdgcn_permlane32_swap(__float_as_uint(pmax), __float_as_uint(pmax), false, false);
      pmax = fmaxf(__uint_as_float(rr[0]), __uint_as_float(rr[1])); }
    float mn;
    if (__builtin_expect(__all(pmax - m_reg <= THR), 1)) { mn = m_reg; alpha = 1.f; }
    else { mn = fmaxf(m_reg, pmax); alpha = __builtin_amdgcn_exp2f(m_reg - mn); m_reg = mn; }
#pragma unroll
    for (int r = 0; r < 16; ++r) p0[r] = p0[r] - mn;
#pragma unroll
    for (int r = 0; r < 16; ++r) p1[r] = p1[r] - mn;
#pragma unroll
    for (int r = 0; r < 16; ++r) p0[r] = __builtin_amdgcn_exp2f(p0[r]);
}
template <bool FIRST>
__device__ __forceinline__ void partialSM_neg(f32x16& p0, f32x16& p1, float& m_reg, f32x16& negm, float& alpha) {
    float pmax = p0[0];
#pragma unroll
    for (int r = 1; r < 16; ++r) pmax = fmaxf(pmax, p0[r]);
#pragma unroll
    for (int r = 0; r < 16; ++r) pmax = fmaxf(pmax, p1[r]);
    { auto rr = __builtin_amdgcn_permlane32_swap(__float_as_uint(pmax), __float_as_uint(pmax), false, false);
      pmax = fmaxf(__uint_as_float(rr[0]), __uint_as_float(rr[1])); }
    if (!FIRST && __builtin_expect(__all(pmax <= THR), 1)) { alpha = 1.f; }
    else { const float dl = FIRST ? pmax : fmaxf(pmax, 0.f); m_reg += dl;
#pragma unroll
        for (int r = 0; r < 16; ++r) { p0[r] -= dl; p1[r] -= dl; }
        const float nm = -m_reg;
#pragma unroll
        for (int r = 0; r < 16; ++r) negm[r] = nm;
        alpha = FIRST ? 1.f : __builtin_amdgcn_exp2f(-dl); }
#pragma unroll
    for (int r = 0; r < 16; ++r) p0[r] = __builtin_amdgcn_exp2f(p0[r]);
}
__device__ __forceinline__ void finishSM(f32x16& p0, f32x16& p1, float alpha, float& l_reg, bf16x8& pa0, bf16x8& pa1, bf16x8& pa2, bf16x8& pa3) {
#pragma unroll
    for (int r = 0; r < 16; ++r) p1[r] = __builtin_amdgcn_exp2f(p1[r]);
    float ps = 0;
#pragma unroll
    for (int r = 0; r < 16; ++r) ps += p0[r];
#pragma unroll
    for (int r = 0; r < 16; ++r) ps += p1[r];
    { auto rr = __builtin_amdgcn_permlane32_swap(__float_as_uint(ps), __float_as_uint(ps), false, false);
      ps = __uint_as_float(rr[0]) + __uint_as_float(rr[1]); }
    l_reg = l_reg * alpha + ps;
#define PK4(P, BASE, OUT) do { unsigned a0 = cvt_pk_bf16(P[BASE + 0], P[BASE + 1]), a1 = cvt_pk_bf16(P[BASE + 2], P[BASE + 3]);   \
    unsigned b0 = cvt_pk_bf16(P[BASE + 4], P[BASE + 5]), b1 = cvt_pk_bf16(P[BASE + 6], P[BASE + 7]);                              \
    auto r0 = __builtin_amdgcn_permlane32_swap(a0, b0, false, false); auto r1 = __builtin_amdgcn_permlane32_swap(a1, b1, false, false); \
    u32x4 w = {r0[0], r1[0], r0[1], r1[1]}; OUT = *reinterpret_cast<bf16x8*>(&w); } while (0)
    PK4(p0, 0, pa0); PK4(p0, 8, pa1); PK4(p1, 0, pa2); PK4(p1, 8, pa3);
#undef PK4
}
__device__ __forceinline__ void finishSM_ns(f32x16& p0, f32x16& p1, float alpha, float& l_reg, bf16x8& pa0, bf16x8& pa1, bf16x8& pa2, bf16x8& pa3) {
#pragma unroll
    for (int r = 0; r < 16; ++r) p1[r] = __builtin_amdgcn_exp2f(p1[r]);
    float ps = 0;
#pragma unroll
    for (int r = 0; r < 16; ++r) ps += p0[r];
#pragma unroll
    for (int r = 0; r < 16; ++r) ps += p1[r];
    { auto rr = __builtin_amdgcn_permlane32_swap(__float_as_uint(ps), __float_as_uint(ps), false, false);
      ps = __uint_as_float(rr[0]) + __uint_as_float(rr[1]); }
    l_reg = l_reg * alpha + ps;
#define PK4N(P, BASE, OUT) do { u32x4 w = {cvt_pk_bf16(P[BASE + 0], P[BASE + 1]), cvt_pk_bf16(P[BASE + 2], P[BASE + 3]), cvt_pk_bf16(P[BASE + 4], P[BASE + 5]), cvt_pk_bf16(P[BASE + 6], P[BASE + 7])}; \
    OUT = *reinterpret_cast<bf16x8*>(&w); } while (0)
    PK4N(p0, 0, pa0); PK4N(p0, 8, pa1); PK4N(p1, 0, pa2); PK4N(p1, 8, pa3);
#undef PK4N
}
template <int NCG> __device__ __forceinline__ int v_st_ns(int k, int c) { return ((k >> 3) * NCG + (c >> 5)) * 512 + ((k & 7) * 32 + (c & 31)) * 2; }
template <int NCG> __device__ __forceinline__ int v_st(int k, int c) { const int kk = (k & ~0xC) | ((k & 4) << 1) | ((k & 8) >> 1); return ((kk >> 3) * NCG + (c >> 5)) * 512 + ((kk & 7) * 32 + (c & 31)) * 2; }
__device__ __forceinline__ int v_rd_base(int lane) { return ((lane & 3) << 3) | (((lane >> 2) & 3) << 6) | (((lane >> 4) & 1) << 5) | (((lane >> 5) & 1) << 8); }
template <int OFF> __device__ __forceinline__ s16x4 tr_read(int vb) { s16x4 r; asm volatile("ds_read_b64_tr_b16 %0, %1 offset:%2" : "=&v"(r) : "v"(vb), "i"(OFF) : "memory"); return r; }
template <int NCG, int D0> __device__ __forceinline__ void pv_one(f32x16& od, int vb, bf16x8 pa0, bf16x8 pa1, bf16x8 pa2, bf16x8 pa3) {
    constexpr int HS = NCG * 512, KS = 2 * HS, O = D0 * 512;
    const s16x4 l0 = tr_read<O>(vb), h0 = tr_read<O + HS>(vb), l1 = tr_read<O + KS>(vb), h1 = tr_read<O + KS + HS>(vb);
    const s16x4 l2 = tr_read<O + 2 * KS>(vb), h2 = tr_read<O + 2 * KS + HS>(vb), l3 = tr_read<O + 3 * KS>(vb), h3 = tr_read<O + 3 * KS + HS>(vb);
    asm volatile("s_waitcnt lgkmcnt(0)" ::: "memory"); SBAR();
#define PK(L, H) (bf16x8){L[0], L[1], L[2], L[3], H[0], H[1], H[2], H[3]}
    od = __builtin_amdgcn_mfma_f32_32x32x16_bf16(pa0, PK(l0, h0), od, 0, 0, 0);
    od = __builtin_amdgcn_mfma_f32_32x32x16_bf16(pa1, PK(l1, h1), od, 0, 0, 0);
    od = __builtin_amdgcn_mfma_f32_32x32x16_bf16(pa2, PK(l2, h2), od, 0, 0, 0);
    od = __builtin_amdgcn_mfma_f32_32x32x16_bf16(pa3, PK(l3, h3), od, 0, 0, 0);
#undef PK
}
__device__ __forceinline__ u32x4 ld16_sys(const void* p) { u32x4 v; asm volatile("global_load_dwordx4 %0, %1, off sc0 sc1\n\ts_waitcnt vmcnt(0)" : "=v"(v) : "v"(p) : "memory"); return v; }

template <class RowPtr>
__device__ __forceinline__ void head_tail(const f32x16 (&o)[2], float l_reg, float* wsf, bf16_t* stg, int lane, int r32, int hi, float (&ss)[4], const RowPtr& rowptr) {
    if (hi == 0) wsf[r32] = l_reg; asm volatile("s_waitcnt lgkmcnt(0)" ::: "memory");
    float rli[16];
#pragma unroll
    for (int r = 0; r < 16; ++r) rli[r] = __builtin_amdgcn_rcpf(wsf[crow(r, hi)]);
#pragma unroll
    for (int r = 0; r < 16; ++r) { const int orow = crow(r, hi);
#pragma unroll
        for (int d0 = 0; d0 < 2; ++d0) stg[orow * 64 + d0 * 32 + r32] = (bf16_t)f2bf(o[d0][r] * rli[r]); }
    asm volatile("s_waitcnt lgkmcnt(0)" ::: "memory");
#pragma unroll
    for (int i = 0; i < 4; ++i) { const int row = i * 8 + (lane >> 3), ch = lane & 7; const u32x4 v = *(const u32x4*)(stg + row * 64 + ch * 8);
        *(u32x4*)(rowptr(i) + ch * 8) = v;
        float s = 0.f;
#pragma unroll
        for (int j = 0; j < 4; ++j) { const float a = bflo(v[j]), b = bfhi(v[j]); s += a * a + b * b; }
        ss[i] += s; }
    asm volatile("s_waitcnt lgkmcnt(0)" ::: "memory");
}
__device__ __forceinline__ u32x4 ld16_dev(const void* p) {
    const unsigned long long a = __hip_atomic_load((const unsigned long long*)p, __ATOMIC_RELAXED, __HIP_MEMORY_SCOPE_AGENT), b = __hip_atomic_load((const unsigned long long*)p + 1, __ATOMIC_RELAXED, __HIP_MEMORY_SCOPE_AGENT);
    u32x4 v; v.x = (unsigned)a; v.y = (unsigned)(a >> 32); v.z = (unsigned)b; v.w = (unsigned)(b >> 32); return v; }
template <class RowPtr>
__device__ __forceinline__ void group_norm_rows(float (&ss)[4], int lane, const RowPtr& rowptr  ) {
    float rstd[4];
#pragma unroll
    for (int i = 0; i < 4; ++i) { float s = ss[i]; s += __shfl_xor(s, 1); s += __shfl_xor(s, 2); s += __shfl_xor(s, 4); rstd[i] = rsqrtf(s * (1.0f / 384.0f) + RMS_EPS); }
    asm volatile("s_waitcnt vmcnt(0)" ::: "memory");
#pragma unroll
    for (int hb = 0; hb < 6; hb += 2) {
        u32x4 v[2][4];
#pragma unroll
        for (int h = 0; h < 2; ++h)
#pragma unroll
            for (int i = 0; i < 4; ++i) v[h][i] = ld16_dev(rowptr(i, hb + h) + (lane & 7) * 8);
#pragma unroll
        for (int h = 0; h < 2; ++h)
#pragma unroll
            for (int i = 0; i < 4; ++i) { bf16_t* p = rowptr(i, hb + h) + (lane & 7) * 8; u32x4 w;
#pragma unroll
                for (int j = 0; j < 4; ++j) w[j] = cvt_pk_bf16(bflo(v[h][i][j]) * rstd[i], bfhi(v[h][i][j]) * rstd[i]);
                *(u32x4*)p = w; }
    }
}

constexpr int KP = 208;
constexpr int SHM_K = 64 * KP, SHM_V = 8192;
constexpr int SLOT = 2 * SHM_K + 2 * SHM_V, L_WS = 3 * SLOT, MLA_LDS = L_WS + 8 * 384;
__device__ __forceinline__ void qkt96(f32x16& p0, f32x16& p1, const char* Ks, const bf16x8* qr, const f32x16& negm, int r32, int hi) {
#pragma unroll
    for (int d0 = 0; d0 < 6; ++d0) { const int cb = (d0 * 16 + hi * 8) * 2;
        const bf16x8 b0 = *reinterpret_cast<const bf16x8*>(Ks + r32 * KP + cb);
        const bf16x8 b1 = *reinterpret_cast<const bf16x8*>(Ks + (32 + r32) * KP + cb);
        if (d0 == 0) { p0 = __builtin_amdgcn_mfma_f32_32x32x16_bf16(b0, qr[0], negm, 0, 0, 0); p1 = __builtin_amdgcn_mfma_f32_32x32x16_bf16(b1, qr[0], negm, 0, 0, 0); }
        else { p0 = __builtin_amdgcn_mfma_f32_32x32x16_bf16(b0, qr[d0], p0, 0, 0, 0); p1 = __builtin_amdgcn_mfma_f32_32x32x16_bf16(b1, qr[d0], p1, 0, 0, 0); } }
}
__device__ __forceinline__ void mla_unit(int b, int qt, const bf16_t* __restrict__ QB, const bf16_t* __restrict__ KB, const bf16_t* __restrict__ VB, bf16_t* MIX, char* lds, int tid) {
    asm volatile("" : "+v"(tid));
    const int wid = __builtin_amdgcn_readfirstlane(tid >> 6), lane = tid & 63, r32 = lane & 31, hi = lane >> 5;
    float* wsf = (float*)(lds + L_WS) + wid * 96; float* al_l = wsf + 32; float* ssrow = wsf + 64;
    bf16_t* stg = (bf16_t*)lds + wid * 2048;
    const long rowbase = (long)b * SEQ; const int q0 = qt * 256 + wid * 32;
    int kgo[3], klo[3], vgo[2], vlo[2];
#pragma unroll
    for (int i = 0; i < 3; ++i) { const int p = tid + 512 * i, row = p / 12, c = p - row * 12; kgo[i] = row * 576 + c * 8; klo[i] = (row >> 6) * SHM_K + (row & 63) * KP + c * 16; }
#pragma unroll
    for (int i = 0; i < 2; ++i) { const int p = tid + 512 * i, row = p >> 3, c = p & 7; vgo[i] = row * 384 + c * 8; vlo[i] = 2 * SHM_K + (row >> 6) * SHM_V + v_st_ns<2>(row & 63, c * 8); }
    const int vrd = (int)(uintptr_t)lds + v_rd_base(lane);
    if (lane < 32) ssrow[lane] = 0.f;
    constexpr int NP = SEQ / 128;
    if (wid >= 4) __builtin_amdgcn_s_setprio(1);
    bf16x8 ks[3], vs[2];
    for (int h = 0; h < 6; ++h) {
        const bf16_t* Qw = QB + (rowbase + q0 + r32) * 576 + h * 96 + hi * 8;
        const bf16_t* Kh = KB + rowbase * 576 + h * 96; const bf16_t* Vh = VB + rowbase * 384 + h * 64;
        bf16x8 qr[6];
#pragma unroll
        for (int d0 = 0; d0 < 6; ++d0) qr[d0] = ld8(Qw + d0 * 16);
        float m_reg = 0.f, l_reg = 0; f32x16 o[2] = {}; f32x16 negm = {};

#define SLOAD(P) do { _Pragma("unroll") for (int i = 0; i < 3; ++i) ks[i] = ld8(Kh + (long)(P) * (128 * 576) + kgo[i]); _Pragma("unroll") for (int i = 0; i < 2; ++i) vs[i] = ld8(Vh + (long)(P) * (128 * 384) + vgo[i]); } while (0)
#define LBAR() asm volatile("s_waitcnt lgkmcnt(0)\n\ts_barrier" ::: "memory")
#define SWRITE(sl) do { char* sb_ = lds + (sl) * SLOT; _Pragma("unroll") for (int i = 0; i < 3; ++i) *(bf16x8*)(sb_ + klo[i]) = ks[i]; _Pragma("unroll") for (int i = 0; i < 2; ++i) *(bf16x8*)(sb_ + vlo[i]) = vs[i]; } while (0)
#define KT(sl, sub) (lds + (sl) * SLOT + (sub) * SHM_K)
#define VT(sl, sub) (vrd + (sl) * SLOT + 2 * SHM_K + (sub) * SHM_V)
#define RESC(a) do { if (__any((a) < 1.f)) { if (hi == 0) al_l[r32] = (a); asm volatile("s_waitcnt lgkmcnt(0)" ::: "memory"); \
        _Pragma("unroll") for (int d = 0; d < 2; ++d) _Pragma("unroll") for (int r = 0; r < 16; ++r) o[d][r] *= al_l[crow(r, hi)]; } } while (0)
#define PV2(vb) do { pv_one<2, 0>(o[0], (vb), pa0, pa1, pa2, pa3); pv_one<2, 1>(o[1], (vb), pa0, pa1, pa2, pa3); } while (0)
        f32x16 pA0, pA1, pB0, pB1; float alA, alB; bf16x8 pa0, pa1, pa2, pa3;
        int s0 = 0, s1 = 1, s2 = 2;
        if (h == 0) SLOAD(0);
        SWRITE(0); SLOAD(1); LBAR();
        qkt96(pA0, pA1, KT(0, 0), qr, negm, r32, hi); partialSM_neg<true>(pA0, pA1, m_reg, negm, alA);
        SWRITE(1); SLOAD(2); LBAR();
        for (int J = 0; J < NP - 1; ++J) {
            if (J + 2 < NP) SWRITE(s2); if (J + 3 < NP) SLOAD(J + 3);
            SBAR(); qkt96(pB0, pB1, KT(s0, 1), qr, negm, r32, hi);
            finishSM_ns(pA0, pA1, alA, l_reg, pa0, pa1, pa2, pa3); SBAR();
            PV2(VT(s0, 0)); partialSM_neg<false>(pB0, pB1, m_reg, negm, alB);
            RESC(alB);
            SBAR(); qkt96(pA0, pA1, KT(s1, 0), qr, negm, r32, hi);
            finishSM_ns(pB0, pB1, alB, l_reg, pa0, pa1, pa2, pa3); SBAR();
            PV2(VT(s0, 1)); partialSM_neg<false>(pA0, pA1, m_reg, negm, alA);
            RESC(alA); LBAR();
            { const int t_ = s0; s0 = s1; s1 = s2; s2 = t_; }
        }
        if (h + 1 < 6) {
#pragma unroll
            for (int i = 0; i < 3; ++i) ks[i] = ld8(Kh + 96 + kgo[i]);
#pragma unroll
            for (int i = 0; i < 2; ++i) vs[i] = ld8(Vh + 64 + vgo[i]); }
        SBAR(); qkt96(pB0, pB1, KT(s0, 1), qr, negm, r32, hi);
        finishSM_ns(pA0, pA1, alA, l_reg, pa0, pa1, pa2, pa3); SBAR();
        PV2(VT(s0, 0)); partialSM_neg<false>(pB0, pB1, m_reg, negm, alB);
        RESC(alB);
        finishSM_ns(pB0, pB1, alB, l_reg, pa0, pa1, pa2, pa3); SBAR();
        PV2(VT(s0, 1));
#undef KT
#undef VT
#undef RESC
#undef PV2
#undef SLOAD
#undef SWRITE
        __syncthreads();
        bf16_t* obase = MIX + (rowbase + q0) * 1024 + 384 + h * 64;
        { float ssh[4] = {0.f, 0.f, 0.f, 0.f};
          head_tail(o, l_reg, wsf, stg, lane, r32, hi, ssh, [&](int i) { return obase + (long)(i * 8 + (lane >> 3)) * 1024; });
#pragma unroll
          for (int i = 0; i < 4; ++i) { float t = ssh[i]; t += __shfl_xor(t, 1); t += __shfl_xor(t, 2); t += __shfl_xor(t, 4); if ((lane & 7) == 0) ssrow[i * 8 + (lane >> 3)] += t; } }
        __syncthreads();
    }
    __builtin_amdgcn_s_setprio(0);
    { int ln = lane; asm volatile("" : "+v"(ln));
      int q0l = q0; asm volatile("" : "+v"(q0l));
      bf16_t* obase = MIX + (rowbase + q0l) * 1024 + 384; float ss[4];
      asm volatile("s_waitcnt lgkmcnt(0)" ::: "memory");
#pragma unroll
      for (int i = 0; i < 4; ++i) ss[i] = ssrow[i * 8 + (ln >> 3)] * 0.125f;
      group_norm_rows(ss, ln, [&](int i, int h) { return obase + (long)(i * 8 + (ln >> 3)) * 1024 + h * 64; }); }
}

constexpr int DL_X = 0, DL_ML = 65536, DL_V = 67584, DL_WS = 133120, DIL_LDS = 135168;
template <int SH>
__device__ __forceinline__ void dil_loadk(bf16x8 (&kf)[2][4], int kb, const bf16_t* __restrict__ Kb, int r32, int hi) {
    kb = __builtin_amdgcn_readfirstlane(kb);
    const char* kbase = (const char*)Kb + ((long)kb << SH) * 768; const unsigned koff = (unsigned)((r32 << SH) * 768 + hi * 16);
#pragma unroll
    for (int hf = 0; hf < 2; ++hf)
#pragma unroll
        for (int d0 = 0; d0 < 4; ++d0) kf[hf][d0] = *(const bf16x8*)(kbase + (size_t)(hf * ((32 << SH) * 768) + d0 * 32) + (size_t)koff);
}
template <int SH>
__device__ __forceinline__ void dil_tile(int kb, int qidx, bf16x8 (&kf)[2][4], bool nv, const bf16_t* __restrict__ Kb, const bf16_t* __restrict__ Vb, const bf16x8 (&qr)[4], float& m_reg, float& l_reg, f32x16 (&o)[2],
                                         char* V_lds, int vb0, float* al_l, int lane, int r32, int hi) {
    constexpr int L = SEQ >> SH;
    { const int kbu = __builtin_amdgcn_readfirstlane(kb);
      const char* vbase = (const char*)Vb + ((long)kbu << SH) * 768; const unsigned voff = (unsigned)((((lane & 31) >> 2) << SH) * 768 + ((lane >> 5) * 32 + (lane & 3) * 8) * 2);
      LAS unsigned char* vdst = (LAS unsigned char*)(unsigned)(uintptr_t)V_lds;
#pragma unroll
      for (int j = 0; j < 8; ++j) __builtin_amdgcn_global_load_lds((const unsigned*)(vbase + (size_t)(j * ((8 << SH) * 768)) + (size_t)voff), (LAS unsigned*)(vdst + j * 1024), 16, 0, 0); }
    f32x16 p0 = {}, p1 = {};
#pragma unroll
    for (int d0 = 0; d0 < 4; ++d0) { p0 = __builtin_amdgcn_mfma_f32_32x32x16_bf16(kf[0][d0], qr[d0], p0, 0, 0, 0); p1 = __builtin_amdgcn_mfma_f32_32x32x16_bf16(kf[1][d0], qr[d0], p1, 0, 0, 0); }
    if (nv) dil_loadk<SH>(kf, kb + 64, Kb, r32, hi);
    const int rel = kb - qidx + 64 + 4 * hi;
    if (kb < 0 || kb + 63 >= L) {
#pragma unroll
        for (int r = 0; r < 16; ++r) { const int cr = (r & 3) + 8 * (r >> 2); const int k0 = kb + 4 * hi + cr, k1 = k0 + 32;
            const bool v0 = (unsigned)(rel + cr) <= 128u && (unsigned)k0 < (unsigned)L, v1 = (unsigned)(rel + cr + 32) <= 128u && (unsigned)k1 < (unsigned)L;
            p0[r] = v0 ? p0[r] : -INFINITY; p1[r] = v1 ? p1[r] : -INFINITY; }
    } else {
#pragma unroll
        for (int r = 0; r < 16; ++r) { const int cr = (r & 3) + 8 * (r >> 2);
            p0[r] = (unsigned)(rel + cr) <= 128u ? p0[r] : -INFINITY; p1[r] = (unsigned)(rel + cr + 32) <= 128u ? p1[r] : -INFINITY; }
    }
    float alpha; bf16x8 pa0, pa1, pa2, pa3;
    partialSM(p0, p1, m_reg, alpha);
    finishSM_ns(p0, p1, alpha, l_reg, pa0, pa1, pa2, pa3);
    if (__any(alpha < 1.f)) { if (hi == 0) al_l[r32] = alpha; asm volatile("s_waitcnt lgkmcnt(0)" ::: "memory");
#pragma unroll
        for (int d = 0; d < 2; ++d)
#pragma unroll
            for (int r = 0; r < 16; ++r) o[d][r] *= al_l[crow(r, hi)]; }
    if (nv) asm volatile("s_waitcnt vmcnt(8) lgkmcnt(0)" ::: "memory"); else asm volatile("s_waitcnt vmcnt(0) lgkmcnt(0)" ::: "memory");
    pv_one<2, 0>(o[0], vb0, pa0, pa1, pa2, pa3); pv_one<2, 1>(o[1], vb0, pa0, pa1, pa2, pa3);
}
__device__ __forceinline__ void dil_unit(int b, int iblk, int h8, const bf16_t* __restrict__ QA, const bf16_t* __restrict__ KA, const bf16_t* __restrict__ VA, bf16_t* MIX, char* lds, int tid_) {
    asm volatile("" : "+v"(tid_));
    const int lane = tid_ & 63, r32 = lane & 31, hi = lane >> 5, w = __builtin_amdgcn_readfirstlane(tid_ >> 6);
    float* X = (float*)(lds + DL_X); float* ML = (float*)(lds + DL_ML);
    char* V_lds = lds + DL_V + w * 8192; bf16_t* stg = (bf16_t*)V_lds; float* wsf = (float*)(lds + DL_WS) + w * 64; float* al_l = wsf + 32;
    const long rowbase = (long)b * SEQ;
    const int vb0 = (int)(uintptr_t)V_lds + v_rd_base(lane);
    const int rho = 8 * h8 + w;
    float ss[4] = {0.f, 0.f, 0.f, 0.f};
    const int lane_o = lane;
    for (int h = 0; h < 6; ++h) {
        float m_reg = -1e30f, l_reg = 0; f32x16 o[2] = {};
        bf16x8 qr[4];
        const bf16_t* Kh = KA + rowbase * 384 + h * 64; const bf16_t* Vh = VA + rowbase * 384 + h * 64;
        int ln1 = lane_o; asm volatile("" : "+v"(ln1));
        {   const int lane = ln1, r32 = ln1 & 31, hi = ln1 >> 5;
            const int a = r32 >> 3, c = r32 & 7, pos = 16 * (32 * iblk + 4 * w + a) + 8 * h8 + c;
            const bf16_t* Qw = QA + (rowbase + pos) * 384 + h * 64 + hi * 8;
#pragma unroll
            for (int d0 = 0; d0 < 4; ++d0) qr[d0] = ld8(Qw + d0 * 16);
            const int kb0 = 16 * (32 * iblk + 4 * w) + 8 * h8 - 64;
            { bf16x8 kf[2][4]; int t = kb0 + 63 >= 0 ? 0 : (-kb0) >> 6;
              if (t < 3 && kb0 + 64 * t < SEQ) dil_loadk<0>(kf, kb0 + 64 * t, Kh, r32, hi);
#pragma unroll 1
              for (; t < 3 && kb0 + 64 * t < SEQ; ++t) { const int kb = kb0 + 64 * t; const bool nv = t + 1 < 3 && kb + 64 < SEQ;
                  dil_tile<0>(kb, pos, kf, nv, Kh, Vh, qr, m_reg, l_reg, o, V_lds, vb0, al_l, lane, r32, hi); } }
#pragma unroll
            for (int r = 0; r < 16; ++r) { const int q = crow(r, hi); float* xp = X + ((q & 7) * 32 + 4 * w + (q >> 3)) * 64 + r32; xp[0] = o[0][r]; xp[32] = o[1][r]; }
            if (hi == 0) { ML[c * 32 + 4 * w + a] = m_reg; ML[256 + c * 32 + 4 * w + a] = l_reg; }
        }
        asm volatile("s_waitcnt lgkmcnt(0)" ::: "memory"); __syncthreads();
        int ln2 = lane_o; asm volatile("" : "+v"(ln2));
        {   const int lane = ln2, r32 = ln2 & 31, hi = ln2 >> 5;
            const int pos = 16 * (32 * iblk + r32) + rho;
            const bf16_t* Qw = QA + (rowbase + pos) * 384 + h * 64 + hi * 8;
#pragma unroll
            for (int d0 = 0; d0 < 4; ++d0) qr[d0] = ld8(Qw + d0 * 16);
#pragma unroll
            for (int r = 0; r < 16; ++r) { const float* xp = X + (w * 32 + crow(r, hi)) * 64 + r32; o[0][r] = xp[0]; o[1][r] = xp[32]; }
            m_reg = ML[w * 32 + r32]; l_reg = ML[256 + w * 32 + r32];
            asm volatile("s_waitcnt lgkmcnt(0)" ::: "memory"); __syncthreads();
            { bf16x8 kf[2][4]; const int kb16 = 32 * iblk - 64, kb4 = 128 * iblk - 64;
              int t = kb16 + 63 >= 0 ? 0 : (-kb16) >> 6;
              if (t < 3 && kb16 + 64 * t < (SEQ >> 4)) dil_loadk<4>(kf, kb16 + 64 * t, Kh + rho * 384, r32, hi);
#pragma unroll 1
              for (; t < 3 && kb16 + 64 * t < (SEQ >> 4); ++t) { const int kb = kb16 + 64 * t; const bool nv = t + 1 < 3 && kb + 64 < (SEQ >> 4);
                  dil_tile<4>(kb, 32 * iblk + r32, kf, nv, Kh + rho * 384, Vh + rho * 384, qr, m_reg, l_reg, o, V_lds, vb0, al_l, lane, r32, hi); }
              t = kb4 + 63 >= 0 ? 0 : (-kb4) >> 6;
              if (t < 4 && kb4 + 64 * t < (SEQ >> 2)) dil_loadk<2>(kf, kb4 + 64 * t, Kh + (rho & 3) * 384, r32, hi);
#pragma unroll 1
              for (; t < 4 && kb4 + 64 * t < (SEQ >> 2); ++t) { const int kb = kb4 + 64 * t; const bool nv = t + 1 < 4 && kb + 64 < (SEQ >> 2);
                  dil_tile<2>(kb, 4 * (32 * iblk + r32) + (rho >> 2), kf, nv, Kh + (rho & 3) * 384, Vh + (rho & 3) * 384, qr, m_reg, l_reg, o, V_lds, vb0, al_l, lane, r32, hi); } }
        }
        bf16_t* obase = MIX + (rowbase + rho) * 1024 + h * 64;
        head_tail(o, l_reg, wsf, stg, lane, r32, hi, ss, [&](int i) { return obase + (long)(16 * (32 * iblk + i * 8 + (lane >> 3))) * 1024; });
    }
    { int ln = lane; asm volatile("" : "+v"(ln));
      bf16_t* obase = MIX + (rowbase + rho) * 1024;
      group_norm_rows(ss, ln, [&](int i, int h) { return obase + (long)(16 * (32 * iblk + i * 8 + (ln >> 3))) * 1024 + h * 64; }); }
    __syncthreads();
}

__device__ __forceinline__ void fft_a_unit(int b, int n2, const bf16_t* __restrict__ Z, const bf16_t* __restrict__ W1, const f32x2* __restrict__ TW, bf16_t* AP, char* lds, int tid) {
    asm volatile("" : "+v"(tid));
    const int wid = tid >> 6, lane = tid & 63, r32 = lane & 31, hi = lane >> 5;
#pragma unroll
    for (int bt = 0; bt < 2; ++bt) { bf16x8 pc[8];
#pragma unroll
        for (int j = 0; j < 8; ++j) { const int p = tid + 512 * (bt * 8 + j), row = p >> 5, c8 = p & 31, cs = row >> 7, n1 = row & 127;
            pc[j] = ld8(Z + ((long)b * SEQ + 64 * n1 + n2) * 512 + cs * 256 + c8 * 8); }
#pragma unroll
        for (int j = 0; j < 8; ++j) { const int p = tid + 512 * (bt * 8 + j), row = p >> 5, c8 = p & 31;
            *(bf16x8*)(lds + ((row >> 6) * 2 + (c8 >> 4)) * 16384 + v_st<4>(row & 63, (c8 & 15) * 8)) = pc[j]; } }
    __syncthreads();
    const int kb = wid & 3, ch = wid >> 2;
    f32x16 acc[2][4] = {};
    const int vb = (int)(uintptr_t)lds + v_rd_base(lane);
    for (int kblk = 0; kblk < 4; ++kblk) {
        bf16x8 af[2][4];
#pragma unroll
        for (int ri = 0; ri < 2; ++ri)
#pragma unroll
            for (int s = 0; s < 4; ++s) af[ri][s] = ld8(W1 + (ri * 128 + 32 * kb + r32) * 256 + kblk * 64 + s * 16 + hi * 8);
        const int vt = vb + (kblk * 2 + ch) * 16384;
#pragma unroll
        for (int ri = 0; ri < 2; ++ri) {
            pv_one<4, 0>(acc[ri][0], vt, af[ri][0], af[ri][1], af[ri][2], af[ri][3]); pv_one<4, 1>(acc[ri][1], vt, af[ri][0], af[ri][1], af[ri][2], af[ri][3]);
            pv_one<4, 2>(acc[ri][2], vt, af[ri][0], af[ri][1], af[ri][2], af[ri][3]); pv_one<4, 3>(acc[ri][3], vt, af[ri][0], af[ri][1], af[ri][2], af[ri][3]); }
    }
    f32x2 tw[16];
#pragma unroll
    for (int r = 0; r < 16; ++r) tw[r] = TW[n2 * 128 + 32 * kb + crow(r, hi)];
    __syncthreads();
    bf16_t* ot = (bf16_t*)lds;
#pragma unroll
    for (int r = 0; r < 16; ++r) { const int k1 = 32 * kb + crow(r, hi); bf16_t* orow = ot + k1 * 512 + 128 * ch + r32;
#pragma unroll
        for (int d0 = 0; d0 < 4; ++d0) { const float re = acc[0][d0][r], im = acc[1][d0][r];
            orow[d0 * 32] = (bf16_t)f2bf(re * tw[r].x + im * tw[r].y); orow[256 + d0 * 32] = (bf16_t)f2bf(im * tw[r].x - re * tw[r].y); } }
    __syncthreads();
#pragma unroll
    for (int j = 0; j < 16; ++j) { const int p = tid + 512 * j, k1 = p >> 6, c = p & 63;
        *(u32x4*)(AP + (((long)b * 128 + k1) * 64 + n2) * 512 + c * 8) = *(const u32x4*)(ot + k1 * 512 + c * 8); }
    __syncthreads();
}
__device__ __forceinline__ void fft_c_units(int u0, int ustep, const bf16_t* __restrict__ AP, const bf16_t* __restrict__ W2, bf16_t* MIX, char* lds, int tid) {
    asm volatile("" : "+v"(tid));
    if (u0 >= 1024) return;
    const int wid = tid >> 6, lane = tid & 63, r32 = lane & 31, hi = lane >> 5;
    const int rb = wid & 1, cq4 = wid >> 1, ch = cq4 >> 1, dsel = cq4 & 1;
    bf16x8 af[2][4];
#pragma unroll
    for (int kblk = 0; kblk < 2; ++kblk)
#pragma unroll
        for (int s = 0; s < 4; ++s) af[kblk][s] = ld8(W2 + (32 * rb + r32) * 128 + kblk * 64 + s * 16 + hi * 8);
    bf16x8 pc[8];
    { const bf16_t* src = AP + ((long)(u0 & 7) * 128 + (u0 >> 3)) * 64 * 512;
#pragma unroll
      for (int j = 0; j < 8; ++j) pc[j] = ld8(src + (long)(tid + 512 * j) * 8); }
    const int vb = (int)(uintptr_t)lds + v_rd_base(lane) + dsel * 1024;
    for (int u = u0; u < 1024; u += ustep) {
        const int b = u & 7, k1 = u >> 3;
#pragma unroll
        for (int j = 0; j < 8; ++j) { const int p = tid + 512 * j, row = p >> 5, c8 = p & 31;
            *(bf16x8*)(lds + ((row >> 6) * 2 + (c8 >> 4)) * 16384 + v_st<4>(row & 63, (c8 & 15) * 8)) = pc[j]; }
        __syncthreads();
        if (u + ustep < 1024) { const int un = u + ustep; const bf16_t* src = AP + ((long)(un & 7) * 128 + (un >> 3)) * 64 * 512;
#pragma unroll
            for (int j = 0; j < 8; ++j) pc[j] = ld8(src + (long)(tid + 512 * j) * 8); }
        f32x16 acc[2] = {};
#pragma unroll
        for (int kblk = 0; kblk < 2; ++kblk) { const int vt = vb + (kblk * 2 + ch) * 16384;
            pv_one<4, 0>(acc[0], vt, af[kblk][0], af[kblk][1], af[kblk][2], af[kblk][3]); pv_one<4, 1>(acc[1], vt, af[kblk][0], af[kblk][1], af[kblk][2], af[kblk][3]); }
        float* ot = (float*)(lds + 65536);
#pragma unroll
        for (int r = 0; r < 16; ++r) { const int k2 = 32 * rb + crow(r, hi);
#pragma unroll
            for (int j = 0; j < 2; ++j) ot[k2 * 260 + 64 * cq4 + 32 * j + r32] = acc[j][r]; }
        __syncthreads();
        { const int k2 = tid >> 3, seg = tid & 7; const float* rp = ot + k2 * 260 + seg * 32; f32x4 x[8]; float s = 0.f;
#pragma unroll
          for (int j = 0; j < 8; ++j) { x[j] = *(const f32x4*)(rp + 4 * j); s += (x[j].x * x[j].x + x[j].y * x[j].y) + (x[j].z * x[j].z + x[j].w * x[j].w); }
          s += __shfl_xor(s, 1); s += __shfl_xor(s, 2); s += __shfl_xor(s, 4);
          const float rstd = rsqrtf(s * (1.0f / 256.0f) + RMS_EPS);
          bf16_t* dst = MIX + ((long)b * SEQ + k1 + 128 * k2) * 1024 + 768 + seg * 32;
#pragma unroll
          for (int j = 0; j < 4; ++j) { u32x4 w; w.x = cvt_pk_bf16(x[2 * j].x * rstd, x[2 * j].y * rstd); w.y = cvt_pk_bf16(x[2 * j].z * rstd, x[2 * j].w * rstd);
              w.z = cvt_pk_bf16(x[2 * j + 1].x * rstd, x[2 * j + 1].y * rstd); w.w = cvt_pk_bf16(x[2 * j + 1].z * rstd, x[2 * j + 1].w * rstd);
              *(u32x4*)(dst + 8 * j) = w; } }
        __syncthreads();
    }
}
}
constexpr int NWAVES = 8;
struct Frame {
    LAS unsigned char* lds; volatile LAS unsigned* MISC; unsigned* ctl; unsigned char* ws;
    int tid, lane, wave, vcu, G; unsigned z;
};
__device__ __forceinline__ int fresh_tid(int wv) { int ln_; asm volatile("v_mbcnt_lo_u32_b32 %0, -1, 0\n\tv_mbcnt_hi_u32_b32 %0, -1, %0" : "=v"(ln_)); return wv * 64 + ln_; }
#define WSF(off) (ws + (size_t)(F.z + (unsigned)(off)))
struct Args { const float* in[18]; float* out; unsigned char* ws; int ph_lo, ph_hi; };

__constant__ double INVF_A[8] = {1.0, 0.19392274474868576, 0.03760603093086393, 0.007292664737217109, 0.001414213562373095, 0.0002742481756762073, 5.318295896944988e-05, 1.031338537721246e-05};
__constant__ double INVF_B[16] = {1.0, 0.44036660267178046, 0.19392274474868576, 0.08539710028576561, 0.03760603093086393, 0.016560440080994446, 0.007292664737217109, 0.003211445994752591,
                                  0.001414213562373095, 0.000622772421914596, 0.0002742481756762073, 0.00012076973741146504, 5.318295896944988e-05, 2.341999896140934e-05, 1.031338537721246e-05, 4.5416704806078695e-06};
__device__ __forceinline__ f32x2 cs_rev(float rev) { return (f32x2){__builtin_amdgcn_cosf(rev), __builtin_amdgcn_sinf(rev)}; }
__device__ __forceinline__ f32x2 cs_angle(double ang) { const double rv = ang * 0.15915494309189535; const double fr = rv - __builtin_floor(rv); return cs_rev((float)fr); }

template <class ColF>
__device__ __forceinline__ void tr_item(LAS float* scr, int lane, bf16_t* dst, int ldd, int k0, int n0, const ColF& colf) {
    const auto col = colf(n0 + (lane & 31));
    float tv[32];
#pragma unroll
    for (int i = 0; i < 32; ++i) tv[i] = col.val(k0 + 2 * i + (lane >> 5));
#pragma unroll
    for (int i = 0; i < 32; ++i) scr[(2 * i + (lane >> 5)) * 33 + (lane & 31)] = tv[i];
    LDS_WAIT(); asm volatile("" ::: "memory");
    const int c = lane & 7;
#pragma unroll
    for (int j = 0; j < 4; ++j) { const int n = (lane >> 3) + 8 * j; const LAS float* s = scr + (8 * c) * 33 + n;
        u32x4 o; o.x = pk2(s[0 * 33], s[1 * 33]); o.y = pk2(s[2 * 33], s[3 * 33]); o.z = pk2(s[4 * 33], s[5 * 33]); o.w = pk2(s[6 * 33], s[7 * 33]);
        *(u32x4*)(dst + (size_t)(n0 + n) * ldd + k0 + 8 * c) = o; }
    LDS_WAIT(); asm volatile("" ::: "memory");
}
template <bool I8 = false, class ColF>
__device__ __forceinline__ void tr_item8(LAS float* scr, int lane, unsigned char* dst, int ldd, int k0, int n0, const ColF& colf, float scale) {
    const auto col = colf(n0 + (lane & 31));
    float tv[32];
#pragma unroll
    for (int i = 0; i < 32; ++i) tv[i] = col.val(k0 + 2 * i + (lane >> 5));
#pragma unroll
    for (int i = 0; i < 32; ++i) scr[(2 * i + (lane >> 5)) * 33 + (lane & 31)] = tv[i] * scale;
    LDS_WAIT(); asm volatile("" ::: "memory");
#pragma unroll
    for (int j = 0; j < 2; ++j) { const int p = lane + 64 * j, n = p >> 2, c = p & 3; const LAS float* s = scr + (16 * c) * 33 + n;
        u32x4 o;
#pragma unroll
        for (int q = 0; q < 4; ++q) o[q] = I8 ? pk4_i8(s[(4 * q) * 33], s[(4 * q + 1) * 33], s[(4 * q + 2) * 33], s[(4 * q + 3) * 33]) : pk4_fp8(s[(4 * q) * 33], s[(4 * q + 1) * 33], s[(4 * q + 2) * 33], s[(4 * q + 3) * 33]);
        *(u32x4*)(dst + (size_t)(n0 + n) * ldd + k0 + 16 * c) = o; }
    LDS_WAIT(); asm volatile("" ::: "memory");
}
struct ColPlain { const float* src; int ld; const float* gain; float scale; int gsel;
    __device__ __forceinline__ float val(int k) const { const float w = src[(size_t)k * ld]; const float gv = gain[k]; return w * scale * (gsel ? gv : 1.0f); } };
struct ColDft { const float* src; int ld; const float* gain; const LAS float* trig;
    __device__ __forceinline__ float val(int k) const { const float* p = src + (size_t)k * ld; float a = 0.f;
#pragma unroll 16
        for (int c = 0; c < 64; ++c) a += p[c] * trig[c * 32];
        return a * gain[k]; } };

__device__ __forceinline__ int rope_src(int ip, int half) { return ip < 2 * half ? ((ip & 1) ? (ip >> 1) + half : (ip >> 1)) : ip; }

struct ColInProj { const float* w; const float* gain;
    __device__ __forceinline__ ColPlain operator()(int n) const {
        ColPlain c; c.src = w; c.ld = D_IN; c.gain = gain; c.scale = 1.f; c.gsel = 1;
        if (n < 768) { const int seg = n / 384, r = n - seg * 384, head = r >> 6, ip = r & 63; c.src = w + seg * 384 + head * 64 + rope_src(ip, 8); if (seg == 0) c.scale = QSCALE_A; }
        else if (n < 1664) c.src = w + n;
        else if (n < 1696) c.src = w + 1664 + rope_src(n - 1664, 16);
        else c.scale = 0.f;
        return c; } };
struct ColInProjDft { const float* w; const float* gain; LAS float* tl; int lane;
    __device__ __forceinline__ ColDft operator()(int n) const { const int c2 = n - 1792, sn = c2 >> 8, cp = c2 & 255, cc = cp & 63; ColDft d; d.src = w + 1696 + (cp >> 6) * 64; d.ld = D_IN; d.gain = gain;
        LAS float* t = tl + (lane & 31);
        if (lane < 32) {
#pragma unroll 8
            for (int c = 0; c < 64; ++c) { const float rev = (float)((c * cc) & 63) * (1.0f / 64.0f); t[c * 32] = sn ? __builtin_amdgcn_sinf(rev) : __builtin_amdgcn_cosf(rev); } }
        LDS_WAIT(); asm volatile("" ::: "memory");
        d.trig = t; return d; } };
struct ColUq { const float* wuq; const float* qn;
    __device__ __forceinline__ ColPlain operator()(int n) const { ColPlain c; c.src = wuq; c.ld = 576; c.gain = qn; c.scale = 0.f; c.gsel = 1;
        if (n < 576) { const int head = n / 96, ip = n - head * 96; c.src = wuq + head * 96 + (ip < 64 ? ip : 64 + rope_src(ip - 64, 16)); c.scale = QSCALE_B; }
        return c; } };
struct ColUkv { const float* wukv; const float* kvn;
    __device__ __forceinline__ ColPlain operator()(int n) const { ColPlain c; c.ld = 768; c.gain = kvn; c.scale = 1.f; c.gsel = 1;
        c.src = wukv + (n < 384 ? (n >> 6) * 128 + (n & 63) : ((n - 384) >> 6) * 128 + 64 + ((n - 384) & 63)); return c; } };
struct ColSimple { const float* w; int ld; const float* gain;
    __device__ __forceinline__ ColPlain operator()(int n) const { ColPlain c; c.src = w + n; c.ld = ld; c.gain = gain ? gain : w; c.scale = 1.f; c.gsel = gain ? 1 : 0; return c; } };
struct ColGU { const float* wg; const float* wu; int ld; const float* gain;
    __device__ __forceinline__ ColPlain operator()(int n) const { const int j = n >> 8, r = n & 255; const uintptr_t msk = r < 128 ? ~(uintptr_t)0 : (uintptr_t)0; ColPlain c; c.src = (const float*)(((uintptr_t)wg & msk) | ((uintptr_t)wu & ~msk)) + 128 * j + (r & 127); c.ld = ld; c.gain = gain; c.scale = 1.f; c.gsel = 1; return c; } };

__device__ __forceinline__ void p0_prologue(Frame& F, const Args& a) {
    LAS float* scr = (LAS float*)(F.lds + F.wave * 16896);
    const int gw = F.vcu * NWAVES + F.wave, NGW = F.G * NWAVES, gt = gw * 64 + F.lane, NGT = NGW * 64;
    unsigned char* ws = F.ws;
    { f32x2* ra = (f32x2*)WSF(WS_ROPEA); for (int i = gt; i < SEQ * 8; i += NGT) ra[i] = cs_angle((double)(i >> 3) * INVF_A[i & 7]);
      f32x2* rb = (f32x2*)WSF(WS_ROPEB); for (int i = gt; i < SEQ * 16; i += NGT) rb[i] = cs_angle((double)(i >> 4) * INVF_B[i & 15]);
      bf16_t* w1 = (bf16_t*)WSF(WS_W1F);
      for (int i = gt; i < 256 * 256; i += NGT) { const int row = i >> 8, k = i & 255, ri = row >> 7, k1 = row & 127, cs = k >> 7, n1 = k & 127;
          const f32x2 t = cs_rev((float)((n1 * k1) & 127) * (1.0f / 128.0f));
          const float v = ri == 0 ? (cs == 0 ? t.x : -t.y) : (cs == 0 ? -t.y : -t.x); w1[i] = (bf16_t)f2bf(v); }
      bf16_t* w2 = (bf16_t*)WSF(WS_W2F);
      for (int i = gt; i < 64 * 128; i += NGT) { const int k2 = i >> 7, k = i & 127, n2 = k >> 1, ri = k & 1; const f32x2 t = cs_rev((float)((n2 * k2) & 63) * (1.0f / 64.0f));
          w2[i] = (bf16_t)f2bf((ri ? t.y : t.x) * FFT_SCALE); }
      f32x2* tw = (f32x2*)WSF(WS_TW);
      for (int i = gt; i < 64 * 128; i += NGT) { const int n2 = i >> 7, k1 = i & 127; tw[i] = cs_rev((float)(n2 * k1) * (1.0f / 8192.0f)); } }
    constexpr int I_IN = 16 * 56, I_UP = 6 * 24 + 2 * 24, I_OUT = 16 * 32, I_L = I_IN + I_UP + I_OUT, I_GU = 16 * 176, I_D = 44 * 32, I_F = I_GU + I_D;
    constexpr int NITEMS = DEPTH * I_L + 2 * I_F;
    for (int it = gw; it < DEPTH * 256; it += NGW) { const int l = it >> 8, r = it & 255, kb = r >> 4, nb = 56 + (r & 15); unsigned char* wl = WSF(WS_WL) + (size_t)l * WL_STRIDE;
        const float* wsrc = a.in[2] + (size_t)l * DM * D_IN; const float* gsrc = a.in[1] + l * DM; ColInProjDft cf{wsrc, gsrc, scr + 64 * 33, F.lane};
        if ((I8_INPROJ >> l) & 1u) tr_item8<true>(scr, F.lane, wl, DM, 64 * kb, 32 * nb, cf, I8_WQ / 8.0f);
        else tr_item(scr, F.lane, (bf16_t*)wl, DM, 64 * kb, 32 * nb, cf); }
    for (int it = gw; it < NITEMS; it += NGW) {
        if (it < DEPTH * I_L) { const int l = it / I_L; int r = it - l * I_L; unsigned char* wl = WSF(WS_WL) + (size_t)l * WL_STRIDE;
            if (r < I_IN) { const int kb = r / 56, nb = r - kb * 56; const float* wsrc = a.in[2] + (size_t)l * DM * D_IN; const float* gsrc = a.in[1] + l * DM; ColInProj cf{wsrc, gsrc};
                if ((I8_INPROJ >> l) & 1u) tr_item8<true>(scr, F.lane, wl, DM, 64 * kb, 32 * nb, cf, nb < 12 ? I8_WQ / QSCALE_A : I8_WQ);
                else tr_item(scr, F.lane, (bf16_t*)wl, DM, 64 * kb, 32 * nb, cf);
                continue; } r -= I_IN;
            if (r < I_UP) { if (r < 144) { const int kb = r / 24, nb = r - kb * 24; ColUq cf{a.in[4] + (size_t)l * 384 * 576, a.in[3] + l * 384}; tr_item(scr, F.lane, (bf16_t*)(wl + WL_WUP), 384, 64 * kb, 32 * nb, cf); }
                else { r -= 144; const int kb = r / 24, nb = r - kb * 24; ColUkv cf{a.in[6] + (size_t)l * 128 * 768, a.in[5] + l * 128}; tr_item(scr, F.lane, (bf16_t*)(wl + WL_WUKV), 128, 64 * kb, 32 * nb, cf); } continue; } r -= I_UP;
            { const int kb = r / 32, nb = r - kb * 32; ColSimple cf{a.in[8] + (size_t)l * DM * DM, DM, a.in[7] + l * DM}; tr_item(scr, F.lane, (bf16_t*)(wl + WL_WOUT), DM, 64 * kb, 32 * nb, cf); }
        } else { int r = it - DEPTH * I_L; const int i = r / I_F; r -= i * I_F; unsigned char* wf = WSF(WS_WFF) + (size_t)i * WFF_STRIDE;
            const bool f8 = (FP8_DENSE >> i) & 1u;
            if (r < I_GU) { const int kb = r / 176, nb = r - kb * 176; ColGU cf{a.in[10] + (size_t)i * DM * D_FF, a.in[11] + (size_t)i * DM * D_FF, D_FF, a.in[9] + (2 * i) * DM};
                if ((I8_DENSE >> i) & 1u) tr_item8<true>(scr, F.lane, wf, DM, 64 * kb, 32 * nb, cf, I8_WQ); else if (f8) tr_item8(scr, F.lane, wf, DM, 64 * kb, 32 * nb, cf, W8_SCALE); else tr_item(scr, F.lane, (bf16_t*)wf, DM, 64 * kb, 32 * nb, cf); continue; } r -= I_GU;
            { const int kb = r / 32, nb = r - kb * 32; ColSimple cf{a.in[12] + (size_t)i * D_FF * DM, DM, nullptr};
              if ((FP8_DDOWN >> i) & 1u) tr_item8(scr, F.lane, wf + WFF_WD, D_FF, 64 * kb, 32 * nb, cf, W8_SCALE); else tr_item(scr, F.lane, (bf16_t*)(wf + WFF_WD), D_FF, 64 * kb, 32 * nb, cf); }
        }
    }
    { const float* x = a.in[0]; bf16_t* XB = (bf16_t*)WSF(WS_XB); f32x4* sq = (f32x4*)WSF(WS_SSQX);
      for (int m0 = gw * 4; m0 < T; m0 += NGW * 4) {
          f32x4 v[4][4]; float s[4];
#pragma unroll
          for (int r = 0; r < 4; ++r)
#pragma unroll
              for (int j = 0; j < 4; ++j) v[r][j] = ((const f32x4*)(x + (size_t)(m0 + r) * DM))[64 * j + F.lane];
#pragma unroll
          for (int r = 0; r < 4; ++r) { float t = 0.f;
#pragma unroll
              for (int j = 0; j < 4; ++j) t += (v[r][j].x * v[r][j].x + v[r][j].y * v[r][j].y) + (v[r][j].z * v[r][j].z + v[r][j].w * v[r][j].w);
              s[r] = wave_sum_dpp(t); }
#pragma unroll
          for (int r = 0; r < 4; ++r) {
              if (I8_INPROJ & 1u) {
                  const float tot = __int_as_float(__builtin_amdgcn_readlane(__float_as_int(s[r]), 63)); const float step = I8_XR * sqrtf(tot * (1.0f / DM) + 1e-12f), iq = 1.0f / step;
                  unsigned* o4 = (unsigned*)(WSF(WS_XB8) + (size_t)(m0 + r) * DM) + F.lane;
#pragma unroll
                  for (int j = 0; j < 4; ++j) o4[64 * j] = pk4_i8(v[r][j].x * iq, v[r][j].y * iq, v[r][j].z * iq, v[r][j].w * iq);
                  if (F.lane == 63) ((float*)WSF(WS_ROWSC2))[m0 + r] = step;
              }
              { u32x2* o8 = (u32x2*)(XB + (size_t)(m0 + r) * DM) + F.lane;
#pragma unroll
                  for (int j = 0; j < 4; ++j) { u32x2 w; w.x = cvt_pk_bf16(v[r][j].x, v[r][j].y); w.y = cvt_pk_bf16(v[r][j].z, v[r][j].w); o8[64 * j] = w; } }
              if (F.lane == 63) sq[m0 + r] = (f32x4){s[r], 0.f, 0.f, 0.f}; } } }
}

struct ConvBlk { const float* src; int ld; const float* gain; unsigned char* dst; int ldd, k0, n0, drow0, rstep, i8; };
__device__ __forceinline__ void conv_load(const Frame& F, const ConvBlk& cb, float scale, f32x4 (&v)[8], float (&g)[8]) {
#pragma unroll
    for (int i = 0; i < 8; ++i) { const int k = cb.k0 + 8 * F.wave + i; v[i] = *(const f32x4*)(cb.src + (size_t)k * cb.ld + cb.n0 + 4 * F.lane); const float sc = cb.i8 ? I8_WQ : scale; g[i] = cb.gain ? cb.gain[k] * sc : sc; }
}
template <bool F8>
__device__ __forceinline__ void conv_put(const Frame& F, const f32x4 (&v)[8], const float (&g)[8], LAS unsigned char* T, int i8) {
    constexpr int PITCH = F8 ? 260 : 516;
#pragma unroll
    for (int i = 0; i < 8; ++i) { const int kr = 8 * F.wave + i; const f32x4 x = v[i] * g[i];
        if (F8) *(LAS unsigned*)(T + kr * PITCH + 4 * F.lane) = i8 ? pk4_i8(x.x, x.y, x.z, x.w) : pk4_fp8(x.x, x.y, x.z, x.w);
        else { *(LAS unsigned*)(T + kr * PITCH + 8 * F.lane) = cvt_pk_bf16(x.x, x.y); *(LAS unsigned*)(T + kr * PITCH + 8 * F.lane + 4) = cvt_pk_bf16(x.z, x.w); } }
}
template <bool F8>
__device__ __forceinline__ void conv_out(const Frame& F, const ConvBlk& cb, const LAS unsigned char* T) {
    constexpr int PITCH = F8 ? 260 : 516;
    if (F8) {
#pragma unroll
        for (int j = 0; j < 2; ++j) { const int p = F.tid + 512 * j, n = p >> 2, c = p & 3; u32x4 o;
#pragma unroll
            for (int q = 0; q < 4; ++q) { unsigned w = 0;
#pragma unroll
                for (int b = 0; b < 4; ++b) w |= (unsigned)T[(16 * c + 4 * q + b) * PITCH + n] << (8 * b);
                o[q] = w; }
            *(u32x4*)(cb.dst + (size_t)(cb.drow0 + (n < 128 ? n : n + cb.rstep)) * cb.ldd + cb.k0 + 16 * c) = o; }
    } else {
#pragma unroll
        for (int j = 0; j < 4; ++j) { const int p = F.tid + 512 * j, n = p >> 3, c = p & 7; u32x4 o;
#pragma unroll
            for (int q = 0; q < 4; ++q) { const unsigned lo = *(const LAS unsigned short*)(T + (8 * c + 2 * q) * PITCH + 2 * n), hi = *(const LAS unsigned short*)(T + (8 * c + 2 * q + 1) * PITCH + 2 * n); o[q] = lo | (hi << 16); }
            *(u32x4*)(cb.dst + ((size_t)(cb.drow0 + (n < 128 ? n : n + cb.rstep)) * cb.ldd + cb.k0 + 8 * c) * 2) = o; }
    }
}
__device__ __forceinline__ ConvBlk moe_blk(const Args& a, unsigned char* dgu0, unsigned char* dd0, const float* fng, int mi, int it, int esz) {
    const int e = it / 672; int r = it - e * 672; const size_t eo = ((size_t)mi * NEXP + e) * DM * D_FFE; ConvBlk cb;
    if (r < 448) { const int up = r >= 224; if (up) r -= 224; const int kb = r / 14, nb = r - kb * 14;
        cb.src = (up ? a.in[15] : a.in[14]) + eo; cb.ld = D_FFE; cb.gain = fng; cb.dst = dgu0 + (size_t)e * 7168 * DM * esz; cb.ldd = DM; cb.k0 = 64 * kb; cb.n0 = 256 * nb; cb.drow0 = 512 * nb + (up ? 128 : 0); cb.rstep = 128; cb.i8 = (int)((I8_MOE >> mi) & 1u); }
    else { r -= 448; const int kb = r >> 2, nb = r & 3;
        cb.src = a.in[16] + eo; cb.ld = DM; cb.gain = nullptr; cb.dst = dd0 + (size_t)e * DM * D_FFE * esz; cb.ldd = D_FFE; cb.k0 = 64 * kb; cb.n0 = 256 * nb; cb.drow0 = 256 * nb; cb.rstep = 0; cb.i8 = 0; }
    return cb;
}
template <bool F8>
__device__ __forceinline__ void moe_convert(Frame& F, const Args& a, const float* fng, int mi) {
    unsigned char* ws = F.ws; unsigned char* dgu0 = (unsigned char*)WSF(WS_WGUE); unsigned char* dd0 = (unsigned char*)WSF(WS_WDE); LAS unsigned char* T0 = F.lds; LAS unsigned char* T1 = F.lds + 40960;
    const float scale = F8 ? W8_SCALE : 1.0f; constexpr int esz = F8 ? 1 : 2; constexpr int NB = NEXP * 672;
    int itA = F.vcu; if (itA >= NB) return;
    int itB = itA + F.G; bool hasB = itB < NB;
    ConvBlk cA = moe_blk(a, dgu0, dd0, fng, mi, itA, esz), cB = cA; f32x4 vA[8], vB[8]; float gA[8], gB[8];
    conv_load(F, cA, scale, vA, gA);
    if (hasB) { cB = moe_blk(a, dgu0, dd0, fng, mi, itB, esz); conv_load(F, cB, scale, vB, gB); }
    for (;;) {
        conv_put<F8>(F, vA, gA, T0, cA.i8);
        const ConvBlk oA = cA; const int nA = itA + 2 * F.G; const bool moreA = nA < NB;
        if (moreA) { cA = moe_blk(a, dgu0, dd0, fng, mi, nA, esz); conv_load(F, cA, scale, vA, gA); }
        __syncthreads();
        conv_out<F8>(F, oA, T0);
        if (!hasB) break;
        conv_put<F8>(F, vB, gB, T1, cB.i8);
        const ConvBlk oB = cB; const int nB = itB + 2 * F.G; const bool moreB = nB < NB;
        if (moreB) { cB = moe_blk(a, dgu0, dd0, fng, mi, nB, esz); conv_load(F, cB, scale, vB, gB); }
        __syncthreads();
        conv_out<F8>(F, oB, T1);
        if (!moreA) break;
        itA = nA; itB = nB; hasB = moreB;
    }
    __syncthreads();
}
__device__ __forceinline__ void moe_r1(Frame& F, const Args& a, int l) {
    const int mi = l >> 1; unsigned char* ws = F.ws;
    const int gw = F.vcu * NWAVES + F.wave, NGW = F.G * NWAVES, gt = gw * 64 + F.lane, NGT = NGW * 64;
    const float* fng = a.in[9] + l * DM;
    REPS(18) { if ((FP8_MOE >> mi) & 1u) moe_convert<true>(F, a, fng, mi); else moe_convert<false>(F, a, fng, mi); }
    { int* rt = (int*)WSF(WS_ROWTOK); float* rs_ = (float*)WSF(WS_ROWRS); for (int i = gt; i < 2 * RT_STRIDE; i += NGT) { rt[i] = -1; rs_[i] = 0.f; } }
    __syncthreads();
    LAS float* Wl = (LAS float*)F.lds; LAS int* cnt = (LAS int*)(F.lds + 32768);
    const float* wr_ = a.in[13] + (size_t)mi * DM * NEXP;
    for (int i = F.tid; i < DM * NEXP; i += NWAVES * 64) { const int k = i >> 3, e = i & 7; Wl[(((k >> 8) * 4 + (k & 3)) * 64 + ((k >> 2) & 63)) * 8 + e] = wr_[i] * fng[k]; }
    const bf16_t* x = (const bf16_t*)WSF(WS_XB); i32x2* toke = (i32x2*)WSF(WS_TOKE); f32x2* tokg = (f32x2*)WSF(WS_TOKG); int* cntwg = (int*)WSF(WS_CNTWG);
    REPS(19) for (int c = F.vcu; c < T / 256; c += F.G) {
        if (F.tid < 16) cnt[F.tid] = 0;
        __syncthreads();
        for (int it = 0; it < 8; ++it) { const int tok0 = c * 256 + F.wave * 32 + it * 4;
            f32x4 xv[4][4]; float lg[4][8]; float sq[4];
#pragma unroll
            for (int t = 0; t < 4; ++t)
#pragma unroll
                for (int j = 0; j < 4; ++j) { const u32x2 w = ((const u32x2*)(x + (size_t)(tok0 + t) * DM))[64 * j + F.lane]; xv[t][j] = (f32x4){bf_lo(w.x), bf_hi(w.x), bf_lo(w.y), bf_hi(w.y)}; }
#pragma unroll
            for (int t = 0; t < 4; ++t) { sq[t] = 0.f;
#pragma unroll
                for (int e = 0; e < 8; ++e) lg[t][e] = 0.f; }
#pragma unroll
            for (int j = 0; j < 4; ++j)
#pragma unroll
                for (int q = 0; q < 4; ++q) { const LAS float* wp = Wl + ((j * 4 + q) * 64 + F.lane) * 8; const f32x4 w0 = *(const LAS f32x4*)wp, w1 = *(const LAS f32x4*)(wp + 4);
#pragma unroll
                    for (int t = 0; t < 4; ++t) { const float xq = xv[t][j][q]; sq[t] += xq * xq;
                        lg[t][0] += xq * w0.x; lg[t][1] += xq * w0.y; lg[t][2] += xq * w0.z; lg[t][3] += xq * w0.w; lg[t][4] += xq * w1.x; lg[t][5] += xq * w1.y; lg[t][6] += xq * w1.z; lg[t][7] += xq * w1.w; } }
#pragma unroll
            for (int t = 0; t < 4; ++t) { const int tok = tok0 + t;
                const float rstd = rsqrtf(wave_sum_dpp(sq[t]) * (1.0f / DM) + RMS_EPS); float l8[8];
#pragma unroll
                for (int e = 0; e < 8; ++e) l8[e] = wave_sum_dpp(lg[t][e]) * rstd;
                int e0 = 0; float v0 = l8[0];
#pragma unroll
                for (int e = 1; e < 8; ++e) if (l8[e] > v0) { v0 = l8[e]; e0 = e; }
                int e1 = -1; float v1 = -INFINITY;
#pragma unroll
                for (int e = 0; e < 8; ++e) if (e != e0 && l8[e] > v1) { v1 = l8[e]; e1 = e; }
                const float g1 = 1.0f / (1.0f + __expf(v0 - v1)), g0 = 1.0f - g1;
                if (F.lane == 63) { toke[tok] = (i32x2){e0, e1}; tokg[tok] = (f32x2){g0, g1}; atomicAdd((int*)&cnt[e0], 1); atomicAdd((int*)&cnt[8 + e1], 1); } } }
        __syncthreads();
        if (F.tid < 16) cntwg[c * 16 + F.tid] = cnt[F.tid];
        __syncthreads();
    }
}
__device__ __forceinline__ void moe_r2(Frame& F, const float* rowsc) {
    unsigned char* ws = F.ws;
    LAS int* cw = (LAS int*)F.lds;
    LAS int* tot = cw + 4096;
    LAS int* wpre = tot + 16;
    LAS int* base = wpre + 64;
    const int* cntwg = (const int*)WSF(WS_CNTWG); const i32x2* toke = (const i32x2*)WSF(WS_TOKE); const f32x2* tokg = (const f32x2*)WSF(WS_TOKG);
    int* rt = (int*)WSF(WS_ROWTOK); float* rg = (float*)WSF(WS_ROWGATE); float* rs_ = (float*)WSF(WS_ROWRS); int* tile_e = (int*)WSF(WS_TILEE);
    for (int i = F.tid; i < 4096; i += NWAVES * 64) cw[i] = cntwg[i];
    __syncthreads();
    if (F.tid < 16) { int s = 0; for (int w = 0; w < 256; ++w) s += cw[w * 16 + F.tid]; tot[F.tid] = s; }
    __syncthreads();
    if (blockIdx.x == 0) { for (int i = F.tid; i < 2 * 272; i += NWAVES * 64) { const int sl = i / 272, t = i - sl * 272; int cum = 0, ex = 7;
        for (int e = 7; e >= 0; --e) { int c2 = 0; for (int q = 0; q <= e; ++q) c2 += (tot[sl * 8 + q] + 255) >> 8; if (t < c2) ex = e; if (e == 7) cum = c2; }
        tile_e[sl * 272 + t] = ex; if (t == 0) tile_e[1024 + sl] = cum; } }
    for (int c = F.vcu; c < T / 256; c += F.G) {
        __syncthreads();
        if (F.tid < 16) { const int sl = F.tid >> 3, e = F.tid & 7; int st = 0; for (int q = 0; q < e; ++q) st += ((tot[sl * 8 + q] + 255) >> 8) << 8;
            int pre = 0; for (int w = 0; w < c; ++w) pre += cw[w * 16 + F.tid]; base[F.tid] = st + pre; }
        i32x2 ee = {0, 0}; f32x2 gg = {0.f, 0.f}; int rk0 = 0, rk1 = 0;
        if (F.tid < 256) { const int tok = c * 256 + F.tid; ee = toke[tok]; gg = tokg[tok];
#pragma unroll
            for (int e = 0; e < 8; ++e) { const unsigned long long m0 = __ballot(ee.x == e), m1 = __ballot(ee.y == e); const unsigned long long lt = (1ull << F.lane) - 1ull;
                if (ee.x == e) rk0 = __popcll(m0 & lt); if (ee.y == e) rk1 = __popcll(m1 & lt);
                if (F.lane == 0) { wpre[F.wave * 16 + e] = __popcll(m0); wpre[F.wave * 16 + 8 + e] = __popcll(m1); } } }
        __syncthreads();
        if (F.tid < 256) { const int tok = c * 256 + F.tid; int p0 = base[ee.x] + rk0, p1 = base[8 + ee.y] + rk1;
            for (int w = 0; w < F.wave; ++w) { p0 += wpre[w * 16 + ee.x]; p1 += wpre[w * 16 + 8 + ee.y]; }
            const f32x4 sq = ((const f32x4*)WSF(WS_SSQX))[tok]; const float rstd = rsqrtf(((sq.x + sq.y) + (sq.z + sq.w)) * (1.0f / DM) + RMS_EPS) * (rowsc ? rowsc[tok] : 1.0f);
            rt[p0] = tok; rg[p0] = gg.x; rs_[p0] = rstd; rt[RT_STRIDE + p1] = tok; rg[RT_STRIDE + p1] = gg.y; rs_[RT_STRIDE + p1] = rstd; }
    }
    __syncthreads();
}
__device__ __forceinline__ void final_norm(Frame& F, const Args& a) {
    const int gw = F.vcu * NWAVES + F.wave, NGW = F.G * NWAVES; const float* g = a.in[17];
    f32x4 gv[4];
#pragma unroll
    for (int j = 0; j < 4; ++j) gv[j] = ((const f32x4*)g)[64 * j + F.lane];
    unsigned char* ws = F.ws;
    for (int m0 = gw * 4; m0 < T; m0 += NGW * 4) {
        u32x2 w[4][4]; float rstd[4];
#pragma unroll
        for (int r = 0; r < 4; ++r)
#pragma unroll
            for (int j = 0; j < 4; ++j) w[r][j] = ((const u32x2*)((const bf16_t*)WSF(WS_XB) + (size_t)(m0 + r) * DM))[64 * j + F.lane];
#pragma unroll
        for (int r = 0; r < 4; ++r) { float s = 0.f;
#pragma unroll
            for (int j = 0; j < 4; ++j) { const float a0 = bf_lo(w[r][j].x), a1 = bf_hi(w[r][j].x), a2 = bf_lo(w[r][j].y), a3 = bf_hi(w[r][j].y); s += (a0 * a0 + a1 * a1) + (a2 * a2 + a3 * a3); }
            rstd[r] = rsqrtf(wave_sum(s) * (1.0f / DM) + RMS_EPS); }
#pragma unroll
        for (int r = 0; r < 4; ++r) { f32x4* xr = (f32x4*)(a.out + (size_t)(m0 + r) * DM) + F.lane;
#pragma unroll
            for (int j = 0; j < 4; ++j) { const f32x4 v = {bf_lo(w[r][j].x), bf_hi(w[r][j].x), bf_lo(w[r][j].y), bf_hi(w[r][j].y)}; xr[64 * j] = v * rstd[r] * gv[j]; } }
    }
}
__global__ void __launch_bounds__(NWAVES * 64, 2) mk_fwd(Args args) {
    extern __shared__ __attribute__((aligned(16))) unsigned char lds[];
    const int wv_ = __builtin_amdgcn_readfirstlane((int)threadIdx.x >> 6);
    for (int u = threadIdx.x; u < (LDS_BYTES - MISC_OFF) / 4; u += NWAVES * 64) ((LAS unsigned*)((LAS unsigned char*)lds + MISC_OFF))[u] = 0u;
    __syncthreads();
#if !MK_PER_PHASE
    { XcdBarrier bar0 = xcd_barrier_post((unsigned*)(args.ws + WS_CTL) + CW_BAR, (volatile LAS unsigned*)((LAS unsigned char*)lds + MISC_OFF) + 8); (void)bar0; }
#define GRID_BAR() do { XcdBarrier bar; bar.bar = (unsigned*)WSP(WS_CTL) + CW_BAR; bar.x = xb_xcc_id(); bar.st = F.MISC + 8; bar.tid = fresh_tid(wv_); xcd_barrier(bar); } while (0)
#else
#define GRID_BAR() do {} while (0)
#endif
    const int lo = args.ph_lo, hi = args.ph_hi;
#define IN(k) (lo <= (k) && (k) < hi)
    typedef const __attribute__((address_space(4))) Args* ArgsP;
#define WSP(off) (ws + (size_t)(z_ + (unsigned)(off)))
#define PHASE_ENTRY() unsigned z_ = 0u; asm volatile("" : "+s"(z_)); ArgsP ap_; { auto p_ = __builtin_amdgcn_kernarg_segment_ptr(); asm volatile("" : "+s"(p_)); ap_ = (ArgsP)p_; } \
    Args A; _Pragma("unroll") for (int i_ = 0; i_ < 18; ++i_) A.in[i_] = ap_->in[i_]; A.out = ap_->out; A.ws = ap_->ws; A.ph_lo = 0; A.ph_hi = 0; unsigned char* ws = A.ws; Frame F; F.lds = (LAS unsigned char*)lds; F.MISC = (volatile LAS unsigned*)(F.lds + MISC_OFF); \
    { int ln_; asm volatile("v_mbcnt_lo_u32_b32 %0, -1, 0\n\tv_mbcnt_hi_u32_b32 %0, -1, %0" : "=v"(ln_)); F.tid = wv_ * 64 + ln_; } F.lane = F.tid & 63; F.wave = __builtin_amdgcn_readfirstlane(F.tid >> 6); \
    { int g_ = gridDim.x; asm volatile("" : "+s"(g_)); F.G = g_; } int bx = (int)blockIdx.x; asm volatile("" : "+s"(bx)); F.vcu = (F.G % 8 == 0) ? (bx % 8) * (F.G / 8) + bx / 8 : bx; F.z = z_; F.ws = ws; F.ctl = (unsigned*)WSP(WS_CTL); \
    LAS unsigned char* ring = F.lds; LAS unsigned char* lepi = F.lds + EPI_OFF; unsigned char* wl = WSP(WS_WL) + (size_t)l * WL_STRIDE; (void)wl; (void)ring; (void)lepi; (void)bx

    if (IN(0)) { const int l = 0; PHASE_ENTRY(); REPS(9) p0_prologue(F, A); GRID_BAR(); }

    for (int l = 0; l < DEPTH; ++l) {
        const int base = 1 + 16 * l;
        if (IN(base + 0)) { PHASE_ENTRY();
            pg8::PlainOrder S; S.init(T / 256, NIN / 256, F.G, bx);
            if ((I8_INPROJ >> l) & 1u) {
                pg8::Gemm g{WSP(WS_XB8), wl, DM, DM, DM, 1};
                pg8::EpiInProj E{(const f32x4*)WSP(WS_SSQX), (bf16_t*)WSP(WS_QA), (bf16_t*)WSP(WS_KA), (bf16_t*)WSP(WS_VA), (bf16_t*)WSP(WS_CQK), (bf16_t*)WSP(WS_KB), (bf16_t*)WSP(WS_Z),
                                 (float*)WSP(WS_SSQC), (const f32x2*)WSP(WS_ROPEA), (const f32x2*)WSP(WS_ROPEB), (const float*)WSP(WS_ROWSC2)};
                pg8::gemm_phase<3>(ring, lepi, g, S, E, F.tid);
            } else {
                pg8::Gemm g{(const bf16_t*)WSP(WS_XB), (const bf16_t*)wl, DM, DM, DM, 2};
                pg8::EpiInProj E{(const f32x4*)WSP(WS_SSQX), (bf16_t*)WSP(WS_QA), (bf16_t*)WSP(WS_KA), (bf16_t*)WSP(WS_VA), (bf16_t*)WSP(WS_CQK), (bf16_t*)WSP(WS_KB), (bf16_t*)WSP(WS_Z),
                                 (float*)WSP(WS_SSQC), (const f32x2*)WSP(WS_ROPEA), (const f32x2*)WSP(WS_ROPEB), nullptr};
                REPS(0) pg8::gemm_phase<2>(ring, lepi, g, S, E, F.tid);
            }
            GRID_BAR();
        }
        if (IN(base + 1)) { PHASE_ENTRY();
            { pg8::Gemm g{WSP(WS_CQK), wl + WL_WUP, 512, 384, 384, 2}; pg8::PlainOrder S; S.init(T / 256, 3, F.G, bx);
              pg8::EpiUp E{(const f32x4*)WSP(WS_SSQC), (bf16_t*)WSP(WS_QB), (bf16_t*)WSP(WS_KB), (bf16_t*)WSP(WS_VB), (const f32x2*)WSP(WS_ROPEB), true};
              REPS(1) pg8::gemm_phase<2>(ring, lepi, g, S, E, F.tid); }
            { pg8::Gemm g{WSP(WS_CQK) + 384 * 2, wl + WL_WUKV, 512, 128, 128, 2}; pg8::PlainOrder S; S.init(T / 256, 3, F.G, bx);
              pg8::EpiUp E{(const f32x4*)WSP(WS_SSQC), (bf16_t*)WSP(WS_QB), (bf16_t*)WSP(WS_KB), (bf16_t*)WSP(WS_VB), (const f32x2*)WSP(WS_ROPEB), false};
              pg8::gemm_phase<2>(ring, lepi, g, S, E, F.tid); }
            __syncthreads();
            REPS(2) for (int u = F.vcu; u < 512; u += F.G)
                att::fft_a_unit(u & 7, u >> 3, (const bf16_t*)WSP(WS_Z), (const bf16_t*)WSP(WS_W1F), (const f32x2*)WSP(WS_TW), (bf16_t*)WSP(WS_AP), (char*)lds, F.tid);
            GRID_BAR();
        }
        if (IN(base + 2)) { PHASE_ENTRY();
            REPS(3) for (int u = bx; u < 256; u += F.G)
                att::mla_unit(u & 7, u >> 3, (const bf16_t*)WSP(WS_QB), (const bf16_t*)WSP(WS_KB), (const bf16_t*)WSP(WS_VB), (bf16_t*)WSP(WS_MIX), (char*)lds, fresh_tid(wv_));
            __syncthreads();
            REPS(4) for (int u = bx; u < 256; u += F.G) { const int j = u >> 3;
                att::dil_unit(u & 7, j >> 1, j & 1, (const bf16_t*)WSP(WS_QA), (const bf16_t*)WSP(WS_KA), (const bf16_t*)WSP(WS_VA), (bf16_t*)WSP(WS_MIX), (char*)lds, fresh_tid(wv_)); }
            __syncthreads();
            REPS(5) att::fft_c_units(F.vcu, F.G, (const bf16_t*)WSP(WS_AP), (const bf16_t*)WSP(WS_W2F), (bf16_t*)WSP(WS_MIX), (char*)lds, fresh_tid(wv_));
            if ((((l & 1) ? I8_MOE : I8_DENSE) >> (l >> 1)) & 1u) {
                const f32x4* sq = (const f32x4*)WSP(WS_SSQX); float* rsc = (float*)WSP(WS_ROWSC);
                for (int r = bx * 512 + fresh_tid(wv_); r < T; r += F.G * 512) { const f32x4 s = sq[r]; rsc[r] = I8_XR * sqrtf(((s.x + s.y) + (s.z + s.w)) * (1.0f / DM) + 1.0f); } }
            GRID_BAR();
        }
        if (IN(base + 3)) { PHASE_ENTRY();
            pg8::Gemm g{(const bf16_t*)WSP(WS_MIX), (const bf16_t*)(wl + WL_WOUT), DM, DM, DM, 2}; pg8::PlainOrder S; S.init(T / 256, 4, F.G, bx);
            const bool i8 = (((l & 1) ? I8_MOE : I8_DENSE) >> (l >> 1)) & 1u;
            const bool f8 = i8 || ((l & 1) ? ((FP8_MOE >> (l >> 1)) & 1u) : ((FP8_DENSE >> (l >> 1)) & 1u));
            pg8::EpiResid E{(bf16_t*)WSP(WS_XB), (float*)WSP(WS_SSQX), f8 ? (unsigned char*)WSP(WS_XB8) : nullptr, i8 ? (const float*)WSP(WS_ROWSC) : nullptr, 1.0f};
            pg8::gemm_phase<2>(ring, lepi, g, S, E, F.tid);
            GRID_BAR();
        }
        if ((l & 1) == 0) {
            if (IN(base + 4)) { PHASE_ENTRY(); unsigned char* wf = WSP(WS_WFF) + (size_t)(l >> 1) * WFF_STRIDE;
                if (l + 1 < DEPTH && ((I8_INPROJ >> (l + 1)) & 1u)) {
                    const f32x4* sq = (const f32x4*)WSP(WS_SSQX); float* rsc = (float*)WSP(WS_ROWSC2);
                    for (int r = bx * 512 + F.tid; r < T; r += F.G * 512) { const f32x4 s = sq[r]; rsc[r] = I8_XR * sqrtf(((s.x + s.y) + (s.z + s.w)) * (1.0f / DM) + 1.0f); } }
                pg8::PlainOrder S; S.init(T / 256, 2 * D_FF / 256, F.G, bx);
                if ((I8_DENSE >> (l >> 1)) & 1u) {
                    pg8::Gemm g{WSP(WS_XB8), wf, DM, DM, DM, 1};
                    pg8::EpiSwiGLU E{(const f32x4*)WSP(WS_SSQX), (bf16_t*)WSP(WS_HID), D_FF, nullptr, I8_WINV, (int)((FP8_DDOWN >> (l >> 1)) & 1u), nullptr, (const float*)WSP(WS_ROWSC)};
                    pg8::gemm_phase<3>(ring, lepi, g, S, E, F.tid);
                } else if ((FP8_DENSE >> (l >> 1)) & 1u) {
                    pg8::Gemm g{WSP(WS_XB8), wf, DM, DM, DM, 1};
                    pg8::EpiSwiGLU E{(const f32x4*)WSP(WS_SSQX), (bf16_t*)WSP(WS_HID), D_FF, nullptr, W8_INV, 1, nullptr, nullptr};
                    pg8::gemm_phase<1>(ring, lepi, g, S, E, F.tid);
                } else {
                    pg8::Gemm g{WSP(WS_XB), wf, DM, DM, DM, 2};
                    pg8::EpiSwiGLU E{(const f32x4*)WSP(WS_SSQX), (bf16_t*)WSP(WS_HID), D_FF, nullptr, 1.0f, (int)((FP8_DDOWN >> (l >> 1)) & 1u), nullptr, nullptr};
                    REPS(6) pg8::gemm_phase<2>(ring, lepi, g, S, E, F.tid);
                }
                GRID_BAR();
            }
            if (IN(base + 5)) { PHASE_ENTRY(); unsigned char* wf = WSP(WS_WFF) + (size_t)(l >> 1) * WFF_STRIDE;
                const bool nx8 = l + 1 < DEPTH && ((I8_INPROJ >> (l + 1)) & 1u);
                unsigned char* x8n = nx8 ? (unsigned char*)WSP(WS_XB8) : nullptr; const float* rs2 = nx8 ? (const float*)WSP(WS_ROWSC2) : nullptr;
                pg8::PlainOrder S; S.init(T / 256, 4, F.G, bx);
                if ((FP8_DDOWN >> (l >> 1)) & 1u) {
                    pg8::Gemm g{WSP(WS_HID), wf + WFF_WD, D_FF, D_FF, D_FF, 1};
                    pg8::EpiResid E{(bf16_t*)WSP(WS_XB), (float*)WSP(WS_SSQX), x8n, rs2, W8_INV};
                    pg8::gemm_phase<1>(ring, lepi, g, S, E, F.tid);
                } else {
                    pg8::Gemm g{WSP(WS_HID), wf + WFF_WD, D_FF, D_FF, D_FF, 2};
                    pg8::EpiResid E{(bf16_t*)WSP(WS_XB), (float*)WSP(WS_SSQX), x8n, rs2, 1.0f};
                    pg8::gemm_phase<2>(ring, lepi, g, S, E, F.tid);
                }
                GRID_BAR();
            }
        } else {
            if (IN(base + 4)) { PHASE_ENTRY();
                if (l + 1 < DEPTH && ((I8_INPROJ >> (l + 1)) & 1u)) {
                    const f32x4* sq = (const f32x4*)WSP(WS_SSQX); float* rsc = (float*)WSP(WS_ROWSC2);
                    for (int r = bx * 512 + F.tid; r < T; r += F.G * 512) { const f32x4 s = sq[r]; rsc[r] = I8_XR * sqrtf(((s.x + s.y) + (s.z + s.w)) * (1.0f / DM) + 1.0f); } }
                REPS(8) moe_r1(F, A, l); GRID_BAR(); }
            if (IN(base + 5)) { PHASE_ENTRY(); moe_r2(F, ((I8_MOE >> (l >> 1)) & 1u) ? (const float*)WSP(WS_ROWSC) : nullptr); GRID_BAR(); }
            static_assert(I8_MOE == 3u && FP8_MOE == 3u, "the MoE stage program below is the int8 gate/up + fp8 down one");
            if (IN(base + 6)) { PHASE_ENTRY();
                const int* rt = (const int*)WSP(WS_ROWTOK);
                const int ntl0 = __builtin_amdgcn_readfirstlane(((const int*)WSP(WS_TILEE))[1024]), ntl1 = __builtin_amdgcn_readfirstlane(((const int*)WSP(WS_TILEE))[1025]);
                pg8::Gemm g{WSP(WS_XB8), WSP(WS_WGUE), DM, DM, DM, 1};
                pg8::MoeOrder<true> S; S.init(ntl0 + ntl1, 2 * D_FFE / 256, F.G, bx); S.tile_e = (const int*)WSP(WS_TILEE); S.row_tok = rt; S.estride = (size_t)7168 * DM; S.ntl0 = ntl0;
                pg8::EpiSwiGLU E{(const f32x4*)WSP(WS_SSQX), (bf16_t*)WSP(WS_HID), D_FFE, rt, I8_WINV, 1, (const float*)WSP(WS_ROWRS), nullptr};
                pg8::gemm_phase<3>(ring, lepi, g, S, E, F.tid);
                GRID_BAR();
            }
            for (int sl = 0; sl < 2; ++sl) {
                if (IN(base + 7 + 2 * sl)) { PHASE_ENTRY();
                    const int* tile_e = (const int*)WSP(WS_TILEE) + sl * 272; const int* rt = (const int*)WSP(WS_ROWTOK) + sl * RT_STRIDE; const float* rg = (const float*)WSP(WS_ROWGATE) + sl * RT_STRIDE;
                    const int ntl = __builtin_amdgcn_readfirstlane(((const int*)WSP(WS_TILEE))[1024 + sl]);
                    const bool nx8 = l + 1 < DEPTH && ((I8_INPROJ >> (l + 1)) & 1u);
                    unsigned char* x8n = nx8 ? (unsigned char*)WSP(WS_XB8) : nullptr; const float* rs2 = (const float*)WSP(WS_ROWSC2);
                    pg8::Gemm g{WSP(WS_HID) + (size_t)sl * RT_STRIDE * D_FFE, WSP(WS_WDE), D_FFE, D_FFE, D_FFE, 1};
                    pg8::MoeOrder<false> S; S.init(ntl, 4, F.G, bx); S.tile_e = tile_e; S.row_tok = rt; S.estride = (size_t)DM * D_FFE;
                    pg8::EpiMoeDown E{(bf16_t*)WSP(WS_XB), (float*)WSP(WS_SSQX), rt, rg, x8n, rs2, sl, W8_INV};
                    pg8::gemm_phase<1>(ring, lepi, g, S, E, F.tid);
                    GRID_BAR();
                }
            }
        }
    }
    if (IN(65)) { const int l = 0; PHASE_ENTRY(); final_norm(F, A); }
#undef IN
#undef GRID_BAR
}

extern "C" void kernel_launch(void* const* d_in, const int* in_sizes, int n_in, void* d_out, int out_size, void* d_ws, size_t ws_size, hipStream_t stream) {
    static int grid = 0;
    if (grid == 0) {
        if (n_in != 18 || in_sizes[0] != T * DM || out_size != T * DM || ws_size < WS_END) {
            fprintf(stderr, "kernel_launch: shape mismatch: n_in %d in0 %d out %d ws %zu (need >= %zu); nothing launched\n", n_in, n_in > 0 ? in_sizes[0] : -1, out_size, ws_size, (size_t)WS_END); grid = -1; return; }
        int dev = 0, cus = 0, per_cu = 0;
        if (hipGetDevice(&dev) != hipSuccess || hipDeviceGetAttribute(&cus, hipDeviceAttributeMultiprocessorCount, dev) != hipSuccess) { fprintf(stderr, "kernel_launch: device query failed\n"); grid = -1; return; }
        if (hipFuncSetAttribute((const void*)mk_fwd, hipFuncAttributeMaxDynamicSharedMemorySize, LDS_BYTES) != hipSuccess) { fprintf(stderr, "kernel_launch: hipFuncSetAttribute failed\n"); grid = -1; return; }
        if (hipOccupancyMaxActiveBlocksPerMultiprocessor(&per_cu, (const void*)mk_fwd, NWAVES * 64, LDS_BYTES) != hipSuccess || per_cu < 1)
            fprintf(stderr, "kernel_launch: note: occupancy query reports %d workgroups per CU\n", per_cu);
        (void)hipGetLastError();
        grid = cus;
        if (grid > 256) grid = 256;
    }
    if (grid < 0) return;
    if (hipMemsetAsync((char*)d_ws + WS_CTL, 0, CTL_ZERO_BYTES, stream) != hipSuccess) { fprintf(stderr, "kernel_launch: memset failed\n"); return; }
    Args a{};
    for (int i = 0; i < 18; ++i) a.in[i] = (const float*)d_in[i];
    a.out = (float*)d_out; a.ws = (unsigned char*)d_ws;
#if MK_PER_PHASE
    int ids[80]; int n = 0; ids[n++] = 0;
    for (int l = 0; l < DEPTH; ++l) { const int base = 1 + 16 * l; const int np = (l & 1) ? 10 : 6; for (int p = 0; p < np; ++p) ids[n++] = base + p; }
    ids[n++] = 65;
    for (int i = 0; i < n; ++i) { a.ph_lo = ids[i]; a.ph_hi = ids[i] + 1; hipLaunchKernelGGL(mk_fwd, dim3(grid), dim3(NWAVES * 64), LDS_BYTES, stream, a); }
#else
    a.ph_lo = 0; a.ph_hi = 1000;
    hipLaunchKernelGGL(mk_fwd, dim3(grid), dim3(NWAVES * 64), LDS_BYTES, stream, a);
#endif
    const hipError_t le = hipPeekAtLastError();
    if (le != hipSuccess) fprintf(stderr, "kernel_launch: launch failed: %s\n", hipGetErrorName(le));
}
```

```cpp
#include <hip/hip_runtime.h>
#include <cstdio>
#include <cstdint>

#ifndef MK_PER_PHASE
#define MK_PER_PHASE 0
#endif

#ifndef PROBE_DUP
#define PROBE_DUP -1
#endif
#define REPS(k) for (int rep_ = 0; rep_ < ((PROBE_DUP) == (k) ? 2 : 1); ++rep_)

#define GAS __attribute__((address_space(1)))
#define LAS __attribute__((address_space(3)))
typedef unsigned short bf16_t;
typedef short bf16x8 __attribute__((ext_vector_type(8)));
typedef short s16x4 __attribute__((ext_vector_type(4)));
typedef float f32x4 __attribute__((ext_vector_type(4)));
typedef float f32x2 __attribute__((ext_vector_type(2)));
typedef float f32x16 __attribute__((ext_vector_type(16)));
typedef unsigned u32x4 __attribute__((ext_vector_type(4)));
typedef unsigned u32x2 __attribute__((ext_vector_type(2)));
typedef int i32x2 __attribute__((ext_vector_type(2)));
typedef int i32x4 __attribute__((ext_vector_type(4)));

constexpr int T = 65536, DM = 1024, SEQ = 8192, NBATCH = 8, DEPTH = 4;
constexpr int D_IN = 1952, NIN = 2304;
constexpr int D_FF = 2816, D_FFE = 3584, NEXP = 8;
constexpr float RMS_EPS = 1e-6f;
constexpr float QSCALE_A = 0.18033688011112042f;
constexpr float QSCALE_B = 0.14724444602590306f;
constexpr float FFT_SCALE = 0.0013810679320049755f;
constexpr int RT_STRIDE = T + 8 * 256;
constexpr int MAX_TILES = RT_STRIDE / 256;

constexpr size_t MiB = 1u << 20;
constexpr size_t WS_CTL = 0, CTL_ZERO_BYTES = 1 * MiB;
constexpr size_t WS_ROPEA = 1 * MiB;
constexpr size_t WS_ROPEB = 2 * MiB;
constexpr size_t WS_W1F = 3 * MiB;
constexpr size_t WS_W2F = 3 * MiB + 128 * 1024;
constexpr size_t WS_TW = 3 * MiB + 256 * 1024;
constexpr size_t WS_SSQX = 4 * MiB;
constexpr size_t WS_SSQC = 5 * MiB;
constexpr size_t WS_TOKE = 6 * MiB;
constexpr size_t WS_TOKG = 6 * MiB + 512 * 1024;
constexpr size_t WS_CNTWG = 7 * MiB;
constexpr size_t WS_ROWTOK = 8 * MiB;
constexpr size_t WS_ROWGATE = 9 * MiB;
constexpr size_t WS_TILEE = 10 * MiB;
constexpr size_t WS_ROWSC = 11 * MiB;
constexpr size_t WS_ROWSC2 = 11 * MiB + 512 * 1024;
constexpr size_t WS_ROWRS = 12 * MiB;
constexpr size_t WS_WL = 16 * MiB, WL_STRIDE = 8 * MiB;
constexpr size_t WL_WUP = 4608 * 1024, WL_WUKV = 4608 * 1024 + 1 * MiB, WL_WOUT = 6 * MiB;
constexpr size_t WS_WFF = 48 * MiB, WFF_STRIDE = 17 * MiB;
constexpr size_t WFF_WD = 11 * MiB;
constexpr size_t WS_WGUE = 82 * MiB;
constexpr size_t WS_WDE = 194 * MiB;
constexpr size_t WS_XB = 250 * MiB;
constexpr size_t WS_AP = 970 * MiB;
constexpr size_t WS_QA = 378 * MiB, WS_KA = 426 * MiB, WS_VA = 474 * MiB;
constexpr size_t WS_CQK = 522 * MiB;
constexpr size_t WS_Z = 586 * MiB;
constexpr size_t WS_QB = 650 * MiB, WS_KB = 722 * MiB;
constexpr size_t WS_VB = 794 * MiB;
constexpr size_t WS_MIX = 842 * MiB;
constexpr size_t WS_HID = 378 * MiB;
constexpr size_t WS_XB8 = 970 * MiB;
constexpr size_t WS_END = 1034 * MiB;
static_assert(WS_HID + (size_t)RT_STRIDE * D_FFE * 2 <= WS_MIX, "hidden overlay");

constexpr int CW_TMO = 0, CW_DBG = 16, CW_BAR = 4096;

constexpr int RING_BYTES = 131072;
constexpr int EPI_OFF = RING_BYTES;
constexpr int MISC_OFF = EPI_OFF + 4096;
constexpr int TAB_OFF = MISC_OFF + 1024;
constexpr int TAB_SLOT = 5120, TAB_REL = TAB_OFF - EPI_OFF;
constexpr int LDS_BYTES = TAB_OFF + 3 * TAB_SLOT;

#define RLX_AGENT __ATOMIC_RELAXED, __HIP_MEMORY_SCOPE_AGENT
#define LDS_WAIT() asm volatile("s_waitcnt lgkmcnt(0)" ::: "memory")
#define VM_WAIT() asm volatile("s_waitcnt vmcnt(0)" ::: "memory")
#define SBAR() __builtin_amdgcn_sched_barrier(0)
#define LDS_BAR() asm volatile("s_waitcnt lgkmcnt(0)\n\ts_barrier" ::: "memory")

__device__ __forceinline__ unsigned cvt_pk_bf16(float lo, float hi) { unsigned r; asm volatile("v_cvt_pk_bf16_f32 %0, %1, %2" : "=v"(r) : "v"(lo), "v"(hi)); return r; }
__device__ __forceinline__ unsigned f2bf(float f) { unsigned u = __builtin_bit_cast(unsigned, f); return (u + 0x7fffu + ((u >> 16) & 1u)) >> 16; }
__device__ __forceinline__ unsigned pk2(float lo, float hi) { return f2bf(lo) | (f2bf(hi) << 16); }
__device__ __forceinline__ float bflo(unsigned w) { return __uint_as_float(w << 16); }
__device__ __forceinline__ float bfhi(unsigned w) { return __uint_as_float(w & 0xffff0000u); }
__device__ __forceinline__ float wave_sum(float v) {
#pragma unroll
    for (int o = 1; o < 64; o <<= 1) v += __shfl_xor(v, o);
    return v;
}
__device__ __forceinline__ float clamp448(float v) { return __builtin_amdgcn_fmed3f(v, -448.f, 448.f); }
__device__ __forceinline__ unsigned pk4_fp8(float a, float b, float c, float d) {
    int w = __builtin_amdgcn_cvt_pk_fp8_f32(clamp448(a), clamp448(b), 0, false); w = __builtin_amdgcn_cvt_pk_fp8_f32(clamp448(c), clamp448(d), w, true); return (unsigned)w; }
__device__ __forceinline__ float bf_lo(unsigned w) { return __uint_as_float(w << 16); }
__device__ __forceinline__ float bf_hi(unsigned w) { return __uint_as_float(w & 0xffff0000u); }
__device__ __forceinline__ unsigned pk4_i8(float a, float b, float c, float d) {
    const float M = 12582912.f;
    const unsigned ia = __float_as_uint(__builtin_amdgcn_fmed3f(a, -127.f, 127.f) + M), ib = __float_as_uint(__builtin_amdgcn_fmed3f(b, -127.f, 127.f) + M);
    const unsigned ic = __float_as_uint(__builtin_amdgcn_fmed3f(c, -127.f, 127.f) + M), id = __float_as_uint(__builtin_amdgcn_fmed3f(d, -127.f, 127.f) + M);
    return __builtin_amdgcn_perm(ib, ia, 0x0c0c0400u) | __builtin_amdgcn_perm(id, ic, 0x04000c0cu); }
constexpr float I8_WQ = 127.f * 32.f / 4.0f, I8_WINV = 4.0f / (127.f * 32.f);
constexpr float I8_XR = 4.0f / 127.f;
constexpr float W8_SCALE = 64.f, W8_INV = 1.0f / 64.f;
constexpr unsigned FP8_MOE = 3u;
constexpr unsigned I8_INPROJ = 15u;
constexpr unsigned I8_MOE = 3u;
constexpr unsigned I8_DENSE = 3u;
constexpr unsigned FP8_DENSE = 3u;
constexpr unsigned FP8_DDOWN = 3u;
template <int CTRL, int ROWMASK> __device__ __forceinline__ float dpp_step(float x) {
    return x + __builtin_bit_cast(float, __builtin_amdgcn_update_dpp(0, __builtin_bit_cast(int, x), CTRL, ROWMASK, 0xf, false)); }
__device__ __forceinline__ float wave_sum_dpp(float x) {
    x = dpp_step<0xB1, 0xf>(x); x = dpp_step<0x4E, 0xf>(x); x = dpp_step<0x124, 0xf>(x); x = dpp_step<0x128, 0xf>(x);
    x = dpp_step<0x142, 0xa>(x); x = dpp_step<0x143, 0xc>(x);
    return x; }
__device__ __forceinline__ u32x4 pack8(const float (&v)[8]) { u32x4 w; w.x = cvt_pk_bf16(v[0], v[1]); w.y = cvt_pk_bf16(v[2], v[3]); w.z = cvt_pk_bf16(v[4], v[5]); w.w = cvt_pk_bf16(v[6], v[7]); return w; }

#define XB_TMO      128
#define XB_XCNT(j)  (256  + 64 * (j))
#define XB_XSUB(j)  (1280 + 64 * (j))
#define XB_XGEN(j)  (2304 + 64 * (j))
#define XB_TOP      3328
#define XB_TOPGEN   3392
#define XCD_BAR_WORDS 3456
#define XB_SPIN_CAP (1u << 20)

__device__ __forceinline__ unsigned xb_ld(unsigned* p)              { return __hip_atomic_load(p, __ATOMIC_RELAXED, __HIP_MEMORY_SCOPE_AGENT); }
__device__ __forceinline__ unsigned xb_add(unsigned* p, unsigned v) { return __hip_atomic_fetch_add(p, v, __ATOMIC_RELAXED, __HIP_MEMORY_SCOPE_AGENT); }
__device__ __forceinline__ unsigned xb_xcc_id() { return (unsigned)__builtin_amdgcn_s_getreg((3 << 11) | 20) & 0xFu; }
#define XB_SPIN(cond, bar) do { unsigned _sp = 0; while (cond) { __builtin_amdgcn_s_sleep(1); \
    if ((++_sp & 255u) == 0u) { if (xb_ld(&(bar)[XB_TMO])) break; if (_sp > XB_SPIN_CAP) { atomicAdd(&(bar)[XB_TMO], 1u); break; } } } } while (0)

struct XcdBarrier { unsigned* bar; unsigned x; volatile LAS unsigned* st; int tid; };

__device__ __forceinline__ XcdBarrier xcd_barrier_post(unsigned* bar, volatile LAS unsigned* st) {
    XcdBarrier b; b.bar = bar; b.x = xb_xcc_id(); b.st = st;
    if (threadIdx.x == 0) (void)xb_add(&bar[XB_XCNT(b.x)], 1u);
    return b;
}
__device__ __forceinline__ void xcd_barrier_complete(unsigned* bar, unsigned x, unsigned& nloc, unsigned& nx) {
    const unsigned G = gridDim.x * gridDim.y * gridDim.z;
    unsigned sum, cnt, mine, sp = 0u;
    for (;;) {
        sum = 0u; cnt = 0u; mine = 0u;
#pragma unroll
        for (unsigned j = 0; j < 16; ++j) { const unsigned c = xb_ld(&bar[XB_XCNT(j)]); sum += c; cnt += (c > 0u) ? 1u : 0u; mine = (j == x) ? c : mine; }
        if (sum == G) break;
        __builtin_amdgcn_s_sleep(1);
        if ((++sp & 255u) == 0u) { if (xb_ld(&bar[XB_TMO])) break; if (sp > XB_SPIN_CAP) { atomicAdd(&bar[XB_TMO], 1u); break; } }
    }
    nloc = mine > 0u ? mine : 1u; nx = cnt > 0u ? cnt : 1u;
}
__device__ __forceinline__ void xcd_barrier(const XcdBarrier& b) {
    asm volatile("s_waitcnt vmcnt(0)" ::: "memory");
    __syncthreads();
    if (b.tid == 0) {
        unsigned* bar = b.bar;
        __builtin_amdgcn_s_waitcnt(0);
        unsigned nloc = b.st[0], nx = b.st[1];
        if (nloc == 0u) { xcd_barrier_complete(bar, b.x, nloc, nx); b.st[0] = nloc; b.st[1] = nx; }
        const unsigned old = xb_add(&bar[XB_XSUB(b.x)], 1u);
        const unsigned gen = old / nloc;
        if (old + 1u == (gen + 1u) * nloc) {
            __builtin_amdgcn_fence(__ATOMIC_RELEASE, "agent");
            asm volatile("s_waitcnt vmcnt(0)" ::: "memory");
            const unsigned og = xb_add(&bar[XB_TOP], 1u);
            const unsigned tg = og / nx;
            if (og + 1u == (tg + 1u) * nx) xb_add(&bar[XB_TOPGEN], 1u);
            else XB_SPIN(xb_ld(&bar[XB_TOPGEN]) == tg, bar);
            __builtin_amdgcn_fence(__ATOMIC_ACQUIRE, "agent");
            xb_add(&bar[XB_XGEN(b.x)], 1u);
            asm volatile("s_waitcnt vmcnt(0)" ::: "memory");
        } else {
            XB_SPIN(xb_ld(&bar[XB_XGEN(b.x)]) == gen, bar);
            __builtin_amdgcn_fence(__ATOMIC_ACQUIRE, "agent");
            asm volatile("s_waitcnt vmcnt(0)" ::: "memory");
        }
    }
    __syncthreads();
}
namespace pg8 {
constexpr int BM = 256, BK = 64, HALF = 128, HTB = HALF * BK * 2, STAGE_BYTES = 8 * HTB, NXCD = 8, WGM = 8;
__host__ __device__ __forceinline__ int lds_byte(int r, int c) { const int st = (r >> 4) * 2 + (c >> 5), rr = r & 15, cc = c & 31, ob = rr * 64 + cc * 2; return st * 1024 + (ob ^ (((ob >> 9) & 1) << 5)); }
__host__ __device__ __forceinline__ void stage_rc(int b, int& R, int& C) { const int st = b / 1024, sb = b % 1024, swz = sb ^ (((sb >> 9) & 1) << 5); R = (st >> 1) * 16 + swz / 64; C = (st & 1) * 32 + (swz % 64) / 2; }
__host__ __device__ __forceinline__ int perm32(int rho) { const int n = rho >> 4, i = rho & 15; return 8 * (i >> 2) + 4 * n + (i & 3); }

struct Unit { int pm, pn; };
typedef int i32x4 __attribute__((ext_vector_type(4)));
typedef int i32x8 __attribute__((ext_vector_type(8)));
__device__ __forceinline__ i32x8 cat16(bf16x8 lo, bf16x8 hi) { const i32x4 a = __builtin_bit_cast(i32x4, lo), b = __builtin_bit_cast(i32x4, hi); return __builtin_shufflevector(a, b, 0, 1, 2, 3, 4, 5, 6, 7); }
struct Gemm { const void* A; const void* Bt; int lda, ldb, K, esz; };

struct OrderBase {
    int nM, nN, nwg, G, c;
    __device__ __forceinline__ void init(int nM_, int nN_, int G_, int c_) { nM = nM_; nN = nN_; nwg = nM * nN; G = G_; c = c_; }
    __device__ __forceinline__ bool next(int i, Unit& u) const {
        const long L = (long)i * G + c; if (L >= nwg) return false;
        int wgid = (int)L; { const int q = nwg / NXCD, r = nwg % NXCD, xcd = wgid % NXCD, off = wgid / NXCD; wgid = (xcd < r ? xcd * (q + 1) : r * (q + 1) + (xcd - r) * q) + off; }
        const int nig = WGM * nN, gid = wgid / nig, fm = gid * WGM, gsz = (nM - fm) < WGM ? (nM - fm) : WGM;
        u.pm = fm + ((wgid % nig) % gsz); u.pn = (wgid % nig) / gsz; return true;
    }
};
struct PlainOrder : OrderBase {
    __device__ __forceinline__ const char* b_base(const Gemm& g, const Unit& u) const { return (const char*)g.Bt + (size_t)u.pn * BM * g.ldb * g.esz; }
    __device__ __forceinline__ void a_offs(const Gemm& g, const Unit& u, int R0, int C0, unsigned (&ao)[2][2]) const {
#pragma unroll
        for (int h = 0; h < 2; ++h)
#pragma unroll
            for (int i = 0; i < 2; ++i) ao[h][i] = (unsigned)((u.pm * BM + h * HALF + i * 64 + R0) * g.lda) * (unsigned)g.esz + (unsigned)C0 * 2u;
    }
};
template <bool GATHER> struct MoeOrder : OrderBase {
    const int* tile_e; const int* row_tok; size_t estride;
    int ntl0 = 1 << 30;
    __device__ __forceinline__ bool next(int i, Unit& u) const { if (!OrderBase::next(i, u)) return false; if (u.pm >= ntl0) u.pm += MAX_TILES - ntl0; return true; }
    __device__ __forceinline__ const char* b_base(const Gemm& g, const Unit& u) const {
        const int e = __builtin_amdgcn_readfirstlane(tile_e[u.pm + (u.pm >= MAX_TILES ? 8 : 0)]);
        return (const char*)g.Bt + ((size_t)e * estride + (size_t)u.pn * BM * g.ldb) * g.esz; }
    __device__ __forceinline__ void a_offs(const Gemm& g, const Unit& u, int R0, int C0, unsigned (&ao)[2][2]) const {
#pragma unroll
        for (int h = 0; h < 2; ++h)
#pragma unroll
            for (int i = 0; i < 2; ++i) {
                int r = u.pm * BM + h * HALF + i * 64 + R0;
                if (GATHER) { const int t = row_tok[r]; r = t < 0 ? 0 : t; }
                ao[h][i] = (unsigned)(r * g.lda) * (unsigned)g.esz + (unsigned)C0 * 2u; }
    }
};

template <int MODE, class Epi, class Sched>
__device__ __forceinline__ void gemm_phase(LAS unsigned char* lds, LAS unsigned char* lds_epi, const Gemm g, const Sched& S, const Epi& E, int tid) {
    asm volatile("" : "+v"(tid));
    const int wid = __builtin_amdgcn_readfirstlane(tid >> 6), lane = tid & 63, wr = wid >> 2, wc = wid & 3, fr = lane & 15, fq = lane >> 4;
    constexpr int ESZ = MODE == 2 ? 2 : 1;
    int nt = g.K * ESZ / 128;
    asm volatile("" : "+s"(nt));
    int R0, C0; stage_rc(tid * 16, R0, C0);
    unsigned voffB[2];
#pragma unroll
    for (int i = 0; i < 2; ++i) { const int R = R0 + i * 64; const int Rb = (R & ~31) + perm32(R & 31); voffB[i] = (unsigned)(Rb * g.ldb) * (unsigned)ESZ + (unsigned)C0 * 2u; }
    const size_t kstep = (size_t)(BK * 2);
    const size_t hstepB = (size_t)HALF * g.ldb * ESZ;
    const unsigned ldsw = (unsigned)wid * 1024u;
    const int aoff = lds_byte(wr * 64 + fr, fq * 8), boff = lds_byte(wc * 32 + fr, fq * 8);
    LAS unsigned char* abase = lds + aoff; LAS unsigned char* bbase = lds + 4 * HTB + boff; asm volatile("" : "+v"(abase), "+v"(bbase));
#define PG8_SA(b, h) (((b) * 2 + (h)) * HTB)
#define PG8_SB(b, h) ((4 + (b) * 2 + (h)) * HTB)
#define PG8_STAGE(bufoff, gbase, voff) do { _Pragma("unroll") for (int _i = 0; _i < 2; ++_i) \
        __builtin_amdgcn_global_load_lds((const unsigned*)((const char*)(gbase) + (voff)[_i]), (LAS unsigned*)(lds + (bufoff) + ldsw + _i * 8192), 16, 0, 0); } while (0)
#define PG8_LD16(base, off) (*(const LAS bf16x8*)((base) + (off)))
#define PG8_LDA(dst, b, h) do { if constexpr (MODE != 1) { _Pragma("unroll") for (int m = 0; m < 4; ++m) _Pragma("unroll") for (int k = 0; k < 2; ++k) dst[m][k] = PG8_LD16(abase, PG8_SA(b, h) + m * 2048 + k * 1024); } \
      else { _Pragma("unroll") for (int m = 0; m < 4; ++m) dst##8[m] = cat16(PG8_LD16(abase, PG8_SA(b, h) + m * 2048), PG8_LD16(abase, PG8_SA(b, h) + m * 2048 + 1024)); } } while (0)
#define PG8_LDB(dst, b, h) do { if constexpr (MODE != 1) { _Pragma("unroll") for (int n = 0; n < 2; ++n) _Pragma("unroll") for (int k = 0; k < 2; ++k) dst[n][k] = PG8_LD16(bbase, PG8_SA(b, h) + n * 2048 + k * 1024); } \
      else { _Pragma("unroll") for (int n = 0; n < 2; ++n) dst##8[n] = cat16(PG8_LD16(bbase, PG8_SA(b, h) + n * 2048), PG8_LD16(bbase, PG8_SA(b, h) + n * 2048 + 1024)); } } while (0)
#define PG8_MMA(ai, bj, At, Bt) do { __builtin_amdgcn_s_setprio(1); if constexpr (MODE == 2) { _Pragma("unroll") for (int m = 0; m < 4; ++m) _Pragma("unroll") for (int n = 0; n < 2; ++n) _Pragma("unroll") for (int k = 0; k < 2; ++k) \
        acc[ai][bj][m][n] = __builtin_amdgcn_mfma_f32_16x16x32_bf16(Bt[n][k], At[m][k], acc[ai][bj][m][n], 0, 0, 0); } \
      else if constexpr (MODE == 3) { _Pragma("unroll") for (int m = 0; m < 4; ++m) _Pragma("unroll") for (int n = 0; n < 2; ++n) _Pragma("unroll") for (int k = 0; k < 2; ++k) \
        acc[ai][bj][m][n] = __builtin_bit_cast(f32x4, __builtin_amdgcn_mfma_i32_16x16x64_i8(__builtin_bit_cast(i32x4, Bt[n][k]), __builtin_bit_cast(i32x4, At[m][k]), __builtin_bit_cast(i32x4, acc[ai][bj][m][n]), 0, 0, 0)); } \
      else { _Pragma("unroll") for (int m = 0; m < 4; ++m) _Pragma("unroll") for (int n = 0; n < 2; ++n) \
        asm volatile("s_nop 1\n\tv_mfma_scale_f32_16x16x128_f8f6f4 %0, %1, %2, %0, %3, %3 op_sel_hi:[0,0,0]" : "+v"(acc[ai][bj][m][n]) : "v"(Bt##8[n]), "v"(At##8[m]), "v"(0x7f7f7f7f)); } \
      __builtin_amdgcn_s_setprio(0); } while (0)
#define PG8_WAIT_V(n) asm volatile("s_waitcnt vmcnt(" #n ")" ::: "memory")
#define PG8_WAIT_L(n) asm volatile("s_waitcnt lgkmcnt(" #n ")" ::: "memory")
#define PG8_BAR __builtin_amdgcn_s_barrier()
#define PG8_SCHED __builtin_amdgcn_sched_barrier(0)
    Unit cur, nxt; int ui = 0;
    if (!S.next(0, cur)) return;
    f32x4 acc[2][2][4][2];
#pragma unroll
    for (int a = 0; a < 2; ++a)
#pragma unroll
        for (int b = 0; b < 2; ++b)
#pragma unroll
            for (int m = 0; m < 4; ++m)
#pragma unroll
                for (int n = 0; n < 2; ++n) acc[a][b][m][n] = (f32x4){0.f, 0.f, 0.f, 0.f};
    bf16x8 At[4][2], B0[2][2], B1[2][2]; i32x8 At8[4], B08[2], B18[2];
    unsigned ao[2][2], nao[2][2];
    S.a_offs(g, cur, R0, C0, ao);
    const char* const A0 = (const char*)g.A;
    const char* cB = S.b_base(g, cur);
    int eslot = 0; E.prefetch(cur, lds_epi, 0, wid, fq * 16 + fr);
    PG8_STAGE(PG8_SB(0, 0), cB, voffB); PG8_STAGE(PG8_SB(0, 1), cB + hstepB, voffB); PG8_STAGE(PG8_SA(0, 0), A0, ao[0]); PG8_STAGE(PG8_SA(0, 1), A0, ao[1]);
    if (wr == 1) PG8_BAR;
    PG8_WAIT_V(2); PG8_BAR;
    PG8_STAGE(PG8_SB(1, 0), cB + kstep, voffB); PG8_STAGE(PG8_SA(1, 0), A0 + kstep, ao[0]); PG8_STAGE(PG8_SB(1, 1), cB + hstepB + kstep, voffB);
    PG8_WAIT_V(6); PG8_BAR;
    for (;;) {
        const bool has_next = S.next(ui + 1, nxt);
        const char* nB = cB;
        if (has_next) { S.a_offs(g, nxt, R0, C0, nao); nB = S.b_base(g, nxt); E.prefetch(nxt, lds_epi, eslot == 2 ? 0 : eslot + 1, wid, fq * 16 + fr); }
        else {
#pragma unroll
            for (int h = 0; h < 2; ++h)
#pragma unroll
                for (int i = 0; i < 2; ++i) nao[h][i] = ao[h][i]; }
        for (int t = 0; t < nt; t += 2) {
            const bool last = (t == nt - 2);
            const char* a1 = A0 + (size_t)(t + 1) * kstep;
            const char* a2 = last ? A0 : A0 + (size_t)(t + 2) * kstep; const char* b2 = last ? nB : cB + (size_t)(t + 2) * kstep;
            const char* a3 = a2 + kstep; const char* b3 = b2 + kstep;
            unsigned a2o[2][2];
#pragma unroll
            for (int h = 0; h < 2; ++h)
#pragma unroll
                for (int i = 0; i < 2; ++i) a2o[h][i] = last ? nao[h][i] : ao[h][i];
            PG8_LDB(B0, 0, 0); PG8_LDB(B1, 0, 1); PG8_SCHED; PG8_LDA(At, 0, 0); PG8_STAGE(PG8_SA(1, 1), a1, ao[1]);
            PG8_WAIT_V(8); PG8_WAIT_L(0); PG8_BAR; PG8_MMA(0, 0, At, B0); PG8_MMA(0, 1, At, B1); PG8_BAR; PG8_SCHED;
            PG8_LDA(At, 0, 1); PG8_STAGE(PG8_SB(0, 0), b2, voffB); PG8_STAGE(PG8_SB(0, 1), b2 + hstepB, voffB); PG8_STAGE(PG8_SA(0, 0), a2, a2o[0]);
            PG8_WAIT_V(8); PG8_WAIT_L(0); PG8_BAR; PG8_MMA(1, 0, At, B0); PG8_MMA(1, 1, At, B1); PG8_BAR; PG8_SCHED;
            PG8_LDB(B0, 1, 0); PG8_LDB(B1, 1, 1); PG8_SCHED; PG8_LDA(At, 1, 0); PG8_STAGE(PG8_SA(0, 1), a2, a2o[1]);
            PG8_WAIT_V(8); PG8_WAIT_L(0); PG8_BAR; PG8_MMA(0, 0, At, B0); PG8_MMA(0, 1, At, B1); PG8_BAR; PG8_SCHED;
            PG8_LDA(At, 1, 1); PG8_STAGE(PG8_SB(1, 0), b3, voffB); PG8_STAGE(PG8_SB(1, 1), b3 + hstepB, voffB); PG8_STAGE(PG8_SA(1, 0), a3, a2o[0]);
            PG8_WAIT_V(8); PG8_WAIT_L(0); PG8_BAR; PG8_MMA(1, 0, At, B0); PG8_MMA(1, 1, At, B1); PG8_BAR; PG8_SCHED;
        }
        if constexpr (MODE == 3) {
#pragma unroll
            for (int a = 0; a < 2; ++a)
#pragma unroll
                for (int b = 0; b < 2; ++b)
#pragma unroll
                    for (int m = 0; m < 4; ++m)
#pragma unroll
                        for (int n = 0; n < 2; ++n) acc[a][b][m][n] = __builtin_convertvector(__builtin_bit_cast(i32x4, acc[a][b][m][n]), f32x4);
        }
        if constexpr (MODE == 1) asm volatile("s_nop 15\n\ts_nop 15" ::: "memory");
        if (wr == 0) PG8_BAR;
        E.eslot = eslot; E(acc, cur, wr, wc, fr, fq, lds_epi, tid); eslot = eslot == 2 ? 0 : eslot + 1;
        if (!has_next) break;
#pragma unroll
        for (int a = 0; a < 2; ++a)
#pragma unroll
            for (int b = 0; b < 2; ++b)
#pragma unroll
                for (int m = 0; m < 4; ++m)
#pragma unroll
                    for (int n = 0; n < 2; ++n) acc[a][b][m][n] = (f32x4){0.f, 0.f, 0.f, 0.f};
        cur = nxt; cB = nB; ++ui;
#pragma unroll
        for (int h = 0; h < 2; ++h)
#pragma unroll
            for (int i = 0; i < 2; ++i) ao[h][i] = nao[h][i];
        if (wr == 1) PG8_BAR;
    }
    PG8_WAIT_V(0);
    PG8_BAR;
#undef PG8_SA
#undef PG8_SB
#undef PG8_STAGE
#undef PG8_LD16
#undef PG8_LDA
#undef PG8_LDB
#undef PG8_MMA
#undef PG8_WAIT_V
#undef PG8_WAIT_L
#undef PG8_BAR
#undef PG8_SCHED
}

__device__ __forceinline__ void row_reduce_store(const float (&part)[2][4], LAS unsigned char* lds_epi, int pm, int wr, int wc, int fr, int fq, int tid, float* dst, int slot, const int* rowmap) {
    LAS float* P = (LAS float*)lds_epi;
#pragma unroll
    for (int ai = 0; ai < 2; ++ai)
#pragma unroll
        for (int m = 0; m < 4; ++m) { float s = part[ai][m]; s += __shfl_xor(s, 16); s += __shfl_xor(s, 32);
            if (fq == 0) P[(ai * HALF + wr * 64 + m * 16 + fr) * 4 + wc] = s; }
    asm volatile("s_waitcnt lgkmcnt(0)" ::: "memory"); __builtin_amdgcn_s_barrier(); asm volatile("" ::: "memory");
    if (tid < 256) { const f32x4 p = *(const LAS f32x4*)(P + tid * 4); int r = pm * BM + tid; if (rowmap) r = rowmap[r];
        if (r >= 0) dst[(size_t)r * 4 + slot] = (p.x + p.y) + (p.z + p.w); }
}
__device__ __forceinline__ void st16(bf16_t* p, const float (&v)[8]) { *(u32x4*)p = pack8(v); }
__device__ __forceinline__ void rot_pairs(float (&v)[8], const f32x4 c01, const f32x4 c23) {
    const float c[4] = {c01.x, c01.z, c23.x, c23.z}, s[4] = {c01.y, c01.w, c23.y, c23.w};
#pragma unroll
    for (int i = 0; i < 4; ++i) { const float a = v[2 * i], b = v[2 * i + 1]; v[2 * i] = a * c[i] - b * s[i]; v[2 * i + 1] = b * c[i] + a * s[i]; }
}
__device__ __forceinline__ LAS unsigned char* epi_tab(LAS unsigned char* lds_epi, int slot) { return lds_epi + TAB_REL + slot * TAB_SLOT; }
__device__ __forceinline__ void epi_tab_fetch(const f32x4* sq, const float* sc, int pm, LAS unsigned char* tab, int wid, int lane) {
    asm volatile("" : "+v"(lane));
    pm = __builtin_amdgcn_readfirstlane(pm);
    if (wid < 4) __builtin_amdgcn_global_load_lds((const unsigned*)((const char*)sq + (size_t)(pm * BM + wid * 64) * 16 + (size_t)(unsigned)(lane * 16)), (LAS unsigned*)(tab + wid * 1024), 16, 0, 0);
    else if (sc) __builtin_amdgcn_global_load_lds((const unsigned*)((const char*)sc + (size_t)(pm * BM + (wid - 4) * 64) * 4 + (size_t)(unsigned)(lane * 4)), (LAS unsigned*)(tab + 4096 + (wid - 4) * 256), 4, 0, 0);
}

struct EpiInProj {
    const f32x4* ssqx; bf16_t *QA, *KA, *VA, *CQK, *KB, *Z; float* ssqc; const f32x2* ropeA; const f32x2* ropeB; const float* rowsc;
    mutable int eslot = 0;
    __device__ __forceinline__ void prefetch(const Unit& u, LAS unsigned char* lds_epi, int slot, int wid, int lane) const { epi_tab_fetch(ssqx, rowsc, u.pm, epi_tab(lds_epi, slot), wid, lane); }
    __device__ __forceinline__ void operator()(const f32x4 (&acc)[2][2][4][2], const Unit& u, int wr, int wc, int fr, int fq, LAS unsigned char* lds_epi, int tid) const {
        int cw = wc * 32 + fq * 8; asm volatile("" : "+v"(cw));
        const int row0 = u.pm * BM + wr * 64 + fr;
        float rs[2][4], part[2][4];
        { f32x4 sq[2][4]; const LAS unsigned char* tab = epi_tab(lds_epi, eslot);
#pragma unroll
          for (int ai = 0; ai < 2; ++ai)
#pragma unroll
              for (int m = 0; m < 4; ++m) sq[ai][m] = ((const LAS f32x4*)tab)[ai * HALF + wr * 64 + m * 16 + fr];
#pragma unroll
          for (int ai = 0; ai < 2; ++ai)
#pragma unroll
              for (int m = 0; m < 4; ++m) { const f32x4 s = sq[ai][m]; rs[ai][m] = rsqrtf(((s.x + s.y) + (s.z + s.w)) * (1.0f / DM) + RMS_EPS); part[ai][m] = 0.f; }
          if (rowsc) { float sc[2][4];
#pragma unroll
              for (int ai = 0; ai < 2; ++ai)
#pragma unroll
                  for (int m = 0; m < 4; ++m) sc[ai][m] = ((const LAS float*)(tab + 4096))[ai * HALF + wr * 64 + m * 16 + fr];
#pragma unroll
              for (int ai = 0; ai < 2; ++ai)
#pragma unroll
                  for (int m = 0; m < 4; ++m) rs[ai][m] *= sc[ai][m] * I8_WINV; } }
#pragma unroll
        for (int bj = 0; bj < 2; ++bj) {
            const int ht = u.pn * 2 + bj;
            const float segf = rowsc ? (ht < 3 ? QSCALE_A : ht >= 14 ? 8.0f : 1.0f) : 1.0f;
            bf16_t* dst = nullptr; int pitch = 0; int kind = 0;
            if (ht < 3) { dst = QA + ht * 128 + cw; pitch = 384; kind = 1; }
            else if (ht < 6) { dst = KA + (ht - 3) * 128 + cw; pitch = 384; kind = 1; }
            else if (ht < 9) { dst = VA + (ht - 6) * 128 + cw; pitch = 384; }
            else if (ht < 12) { dst = CQK + (ht - 9) * 128 + cw; pitch = 512; kind = 3; }
            else if (ht == 12) { dst = CQK + 384 + cw; pitch = 512; kind = 3; }
            else if (ht == 13) { kind = 2; }
            else { dst = Z + (ht - 14) * 128 + cw; pitch = 512; }
            const bool rotA = (wc & 1) == 0 && fq < 2;
            const f32x2* tb = kind == 1 ? ropeA + (fq & 1) * 4 : ropeB + fq * 4; const int tp = kind == 1 ? 8 : 16;
#pragma unroll
            for (int ai = 0; ai < 2; ++ai) {
                f32x4 cs[4][2];
                if (kind == 1 || kind == 2) {
#pragma unroll
                    for (int m = 0; m < 4; ++m) { const f32x2* q = tb + (size_t)((row0 + ai * HALF + m * 16) & (SEQ - 1)) * tp; cs[m][0] = *(const f32x4*)q; cs[m][1] = *(const f32x4*)(q + 2); }
                }
#pragma unroll
                for (int m = 0; m < 4; ++m) {
                    const int row = row0 + ai * HALF + m * 16; const float r = rs[ai][m] * segf;
                    float v[8];
#pragma unroll
                    for (int n = 0; n < 2; ++n)
#pragma unroll
                        for (int j = 0; j < 4; ++j) v[4 * n + j] = acc[ai][bj][m][n][j] * r;
                    if (kind == 1) { if (rotA) rot_pairs(v, cs[m][0], cs[m][1]); st16(dst + (size_t)row * pitch, v); }
                    else if (kind == 2) { if (wc == 0) { rot_pairs(v, cs[m][0], cs[m][1]); const u32x4 w = pack8(v);
#pragma unroll
                            for (int h = 0; h < 6; ++h) *(u32x4*)(KB + (size_t)row * 576 + h * 96 + 64 + fq * 8) = w; } }
                    else { if (kind == 3) { float s = 0.f;
#pragma unroll
                            for (int j = 0; j < 8; ++j) s += v[j] * v[j];
                            part[ai][m] += s; }
                        st16(dst + (size_t)row * pitch, v); }
                }
                asm volatile("" ::: "memory");
            }
        }
        if (u.pn >= 4 && u.pn <= 6) row_reduce_store(part, lds_epi, u.pm, wr, wc, fr, fq, tid, ssqc, u.pn - 4, nullptr);
    }
};

struct EpiUp {
    const f32x4* ssqc; bf16_t *QB, *KB, *VB; const f32x2* ropeB; bool isq;
    mutable int eslot = 0;
    __device__ __forceinline__ void prefetch(const Unit& u, LAS unsigned char* lds_epi, int slot, int wid, int lane) const { epi_tab_fetch(ssqc, nullptr, u.pm, epi_tab(lds_epi, slot), wid, lane); }
    __device__ __forceinline__ void operator()(const f32x4 (&acc)[2][2][4][2], const Unit& u, int wr, int wc, int fr, int fq, LAS unsigned char* lds_epi, int tid) const {
        int cw = wc * 32 + fq * 8; asm volatile("" : "+v"(cw));
        const int row0 = u.pm * BM + wr * 64 + fr;
        float rs[2][4];
        { f32x4 sq[2][4];
#pragma unroll
          for (int ai = 0; ai < 2; ++ai)
#pragma unroll
              for (int m = 0; m < 4; ++m) sq[ai][m] = ((const LAS f32x4*)epi_tab(lds_epi, eslot))[ai * HALF + wr * 64 + m * 16 + fr];
#pragma unroll
          for (int ai = 0; ai < 2; ++ai)
#pragma unroll
              for (int m = 0; m < 4; ++m) { const f32x4 s = sq[ai][m]; rs[ai][m] = isq ? rsqrtf((s.x + s.y) * (1.0f / 384.0f) + RMS_EPS) : rsqrtf(s.z * (1.0f / 128.0f) + RMS_EPS); } }
#pragma unroll
        for (int bj = 0; bj < 2; ++bj) {
            const int n0 = u.pn * BM + bj * HALF + cw;
            bf16_t* dst; int pitch; int ropeoff = -1; bool valid = true;
            if (isq) { const int head = n0 / 96, ip = n0 - head * 96; valid = n0 < 576; dst = QB + n0; pitch = 576; if (ip >= 64) ropeoff = (ip - 64) >> 1; }
            else if (n0 < 384) { const int head = n0 >> 6; dst = KB + head * 96 + (n0 & 63); pitch = 576; }
            else { dst = VB + (n0 - 384); pitch = 384; }
            const f32x2* tb = ropeB + (ropeoff < 0 ? 0 : ropeoff);
#pragma unroll
            for (int ai = 0; ai < 2; ++ai) {
                f32x4 cs[4][2];
                if (isq) {
#pragma unroll
                    for (int m = 0; m < 4; ++m) { const f32x2* q = tb + (size_t)((row0 + ai * HALF + m * 16) & (SEQ - 1)) * 16; cs[m][0] = *(const f32x4*)q; cs[m][1] = *(const f32x4*)(q + 2); } }
#pragma unroll
                for (int m = 0; m < 4; ++m) {
                    const int row = row0 + ai * HALF + m * 16; const float r = rs[ai][m];
                    float v[8];
#pragma unroll
                    for (int n = 0; n < 2; ++n)
#pragma unroll
                        for (int j = 0; j < 4; ++j) v[4 * n + j] = acc[ai][bj][m][n][j] * r;
                    if (ropeoff >= 0) rot_pairs(v, cs[m][0], cs[m][1]);
                    if (valid) st16(dst + (size_t)row * pitch, v);
                }
                asm volatile("" ::: "memory");
            }
        }
    }
};

struct EpiResid {
    bf16_t* XM; float* ssqx; unsigned char* XB8; const float* rowsc; float ascale;
    mutable int eslot = 0;
    __device__ __forceinline__ void prefetch(const Unit&, LAS unsigned char*, int, int, int) const {}
    __device__ __forceinline__ void operator()(const f32x4 (&acc)[2][2][4][2], const Unit& u, int wr, int wc, int fr, int fq, LAS unsigned char* lds_epi, int tid) const {
        int cw = wc * 32 + fq * 8; asm volatile("" : "+v"(cw));
        const int row0 = u.pm * BM + wr * 64 + fr, col0 = u.pn * BM + cw;
        float part[2][4];
#pragma unroll
        for (int ai = 0; ai < 2; ++ai)
          {
            u32x4 xr[4][2]; float qs[4] = {1.f, 1.f, 1.f, 1.f};
            if (rowsc) {
#pragma unroll
                for (int mm = 0; mm < 4; ++mm) qs[mm] = rowsc[row0 + ai * HALF + mm * 16]; }
#pragma unroll
            for (int mm = 0; mm < 4; ++mm) { const size_t off = (size_t)(row0 + ai * HALF + mm * 16) * DM + col0;
#pragma unroll
                for (int bj = 0; bj < 2; ++bj) xr[mm][bj] = *(const u32x4*)(XM + off + bj * HALF); }
#pragma unroll
            for (int mm = 0; mm < 4; ++mm) { const int m = mm; const size_t off = (size_t)(row0 + ai * HALF + m * 16) * DM + col0; float s = 0.f; const float iq = __builtin_amdgcn_rcpf(qs[mm]);
#pragma unroll
                for (int bj = 0; bj < 2; ++bj) { const u32x4 xw = xr[mm][bj];
                    const f32x4 x0 = {bf_lo(xw.x), bf_hi(xw.x), bf_lo(xw.y), bf_hi(xw.y)}, x1 = {bf_lo(xw.z), bf_hi(xw.z), bf_lo(xw.w), bf_hi(xw.w)};
                    const f32x4 y0 = x0 + acc[ai][bj][m][0] * ascale, y1 = x1 + acc[ai][bj][m][1] * ascale;
                    u32x4 w; w.x = cvt_pk_bf16(y0.x, y0.y); w.y = cvt_pk_bf16(y0.z, y0.w); w.z = cvt_pk_bf16(y1.x, y1.y); w.w = cvt_pk_bf16(y1.z, y1.w);
                    *(u32x4*)(XM + off + bj * HALF) = w;
                    if (XB8) { u32x2 w8;
                        if (rowsc) { w8.x = pk4_i8(y0.x * iq, y0.y * iq, y0.z * iq, y0.w * iq); w8.y = pk4_i8(y1.x * iq, y1.y * iq, y1.z * iq, y1.w * iq); }
                        else { w8.x = pk4_fp8(y0.x, y0.y, y0.z, y0.w); w8.y = pk4_fp8(y1.x, y1.y, y1.z, y1.w); }
                        *(u32x2*)(XB8 + off + bj * HALF) = w8; }
                    s += (y0.x * y0.x + y0.y * y0.y) + (y0.z * y0.z + y0.w * y0.w) + (y1.x * y1.x + y1.y * y1.y) + (y1.z * y1.z + y1.w * y1.w);
                }
                part[ai][m] = s; }
            asm volatile("" ::: "memory");
          }
        row_reduce_store(part, lds_epi, u.pm, wr, wc, fr, fq, tid, ssqx, u.pn, nullptr);
    }
};

__device__ __forceinline__ float silu_mul(float g, float u) { return g * u * __builtin_amdgcn_rcpf(1.0f + __builtin_amdgcn_exp2f(-1.4426950408889634f * g)); }
struct EpiSwiGLU {
    const f32x4* ssqx; bf16_t* HID; int ldh; const int* rowmap; float ascale; int out8; const float* rowrs; const float* rowsc; mutable int eslot = 0;
    __device__ __forceinline__ void prefetch(const Unit& u, LAS unsigned char* lds_epi, int slot, int wid, int lane) const {
        LAS unsigned char* tab = epi_tab(lds_epi, slot);
        if (rowrs) { if (wid < 4) { asm volatile("" : "+v"(lane)); const int pm = __builtin_amdgcn_readfirstlane(u.pm);
                __builtin_amdgcn_global_load_lds((const unsigned*)((const char*)rowrs + (size_t)(pm * BM + wid * 64) * 4 + (size_t)(unsigned)(lane * 4)), (LAS unsigned*)(tab + wid * 256), 4, 0, 0); } }
        else if (!rowmap) epi_tab_fetch(ssqx, rowsc, u.pm, tab, wid, lane); }
    __device__ __forceinline__ void operator()(const f32x4 (&acc)[2][2][4][2], const Unit& u, int wr, int wc, int fr, int fq, LAS unsigned char* lds_epi, int tid) const {
        int cw = wc * 32 + fq * 8; asm volatile("" : "+v"(cw));
        const int row0 = u.pm * BM + wr * 64 + fr, col0 = u.pn * HALF + cw;
        float rs[2][4];
        if (rowrs) {
            const LAS float* T = (const LAS float*)epi_tab(lds_epi, eslot);
#pragma unroll
            for (int ai = 0; ai < 2; ++ai)
#pragma unroll
                for (int m = 0; m < 4; ++m) rs[ai][m] = T[ai * HALF + wr * 64 + m * 16 + fr] * ascale;
        } else {
            int tok[2][4];
#pragma unroll
            for (int ai = 0; ai < 2; ++ai)
#pragma unroll
                for (int m = 0; m < 4; ++m) { const int row = row0 + ai * HALF + m * 16; tok[ai][m] = rowmap ? rowmap[row] : row; }
            f32x4 sq[2][4]; float sc[2][4];
            if (!rowmap) {
                const LAS unsigned char* tab = epi_tab(lds_epi, eslot);
#pragma unroll
                for (int ai = 0; ai < 2; ++ai)
#pragma unroll
                    for (int m = 0; m < 4; ++m) { const int rr = ai * HALF + wr * 64 + m * 16 + fr; sq[ai][m] = ((const LAS f32x4*)tab)[rr]; sc[ai][m] = rowsc ? ((const LAS float*)(tab + 4096))[rr] : 1.0f; }
            } else {
#pragma unroll
            for (int ai = 0; ai < 2; ++ai)
#pragma unroll
                for (int m = 0; m < 4; ++m) { sq[ai][m] = ssqx[tok[ai][m] < 0 ? 0 : tok[ai][m]]; sc[ai][m] = rowsc ? rowsc[tok[ai][m] < 0 ? 0 : tok[ai][m]] : 1.0f; }
            }
#pragma unroll
            for (int ai = 0; ai < 2; ++ai)
#pragma unroll
                for (int m = 0; m < 4; ++m) { const f32x4 s = sq[ai][m]; const float r = rsqrtf(((s.x + s.y) + (s.z + s.w)) * (1.0f / DM) + RMS_EPS) * (ascale * sc[ai][m]); rs[ai][m] = tok[ai][m] < 0 ? 0.f : r; }
        }
#pragma unroll
        for (int ai = 0; ai < 2; ++ai)
#pragma unroll
            for (int m = 0; m < 4; ++m) {
                const int row = row0 + ai * HALF + m * 16; const float r = rs[ai][m]; const float c1 = -1.4426950408889634f * r, ir2 = __builtin_amdgcn_rcpf(r * r);
                float v[8];
#pragma unroll
                for (int n = 0; n < 2; ++n)
#pragma unroll
                    for (int j = 0; j < 4; ++j) { const float ag = acc[ai][0][m][n][j], au = acc[ai][1][m][n][j];
                        const float e = __builtin_amdgcn_exp2f(ag * c1); v[4 * n + j] = (ag * au) * __builtin_amdgcn_rcpf(__builtin_fmaf(e, ir2, ir2)); }
                if (out8) { u32x2 w8; w8.x = pk4_fp8(v[0], v[1], v[2], v[3]); w8.y = pk4_fp8(v[4], v[5], v[6], v[7]); *(u32x2*)((unsigned char*)HID + (size_t)row * ldh + col0) = w8; }
                else st16(HID + (size_t)row * ldh + col0, v);
            }
    }
};

struct EpiMoeDown {
    bf16_t* XM; float* ssqx; const int* rowmap; const float* rowgate; unsigned char* XB8; const float* rowsc; int last; float ascale;
    mutable int eslot = 0;
    __device__ __forceinline__ void prefetch(const Unit& u, LAS unsigned char* lds_epi, int slot, int wid, int lane) const {
        asm volatile("" : "+v"(lane)); const int pm = __builtin_amdgcn_readfirstlane(u.pm); LAS unsigned char* tab = epi_tab(lds_epi, slot);
        if (wid < 4) __builtin_amdgcn_global_load_lds((const unsigned*)((const char*)rowmap + (size_t)(pm * BM + wid * 64) * 4 + (size_t)(unsigned)(lane * 4)), (LAS unsigned*)(tab + wid * 256), 4, 0, 0);
        else __builtin_amdgcn_global_load_lds((const unsigned*)((const char*)rowgate + (size_t)(pm * BM + (wid - 4) * 64) * 4 + (size_t)(unsigned)(lane * 4)), (LAS unsigned*)(tab + 4096 + (wid - 4) * 256), 4, 0, 0); }
    __device__ __forceinline__ void operator()(const f32x4 (&acc)[2][2][4][2], const Unit& u, int wr, int wc, int fr, int fq, LAS unsigned char* lds_epi, int tid) const {
        int cw = wc * 32 + fq * 8; asm volatile("" : "+v"(cw));
        const int row0 = u.pm * BM + wr * 64 + fr, col0 = u.pn * BM + cw;
        float part[2][4]; int tok[2][4];
#pragma unroll
        for (int ai = 0; ai < 2; ++ai)
#pragma unroll
            for (int m = 0; m < 4; ++m) tok[ai][m] = ((const LAS int*)epi_tab(lds_epi, eslot))[ai * HALF + wr * 64 + m * 16 + fr];
#pragma unroll
        for (int ai = 0; ai < 2; ++ai)
          {
            u32x4 xr[4][2]; float gt[4], qs[4] = {1.f, 1.f, 1.f, 1.f};
#pragma unroll
            for (int mm = 0; mm < 4; ++mm) gt[mm] = ((const LAS float*)(epi_tab(lds_epi, eslot) + 4096))[ai * HALF + wr * 64 + mm * 16 + fr] * ascale;
            if (XB8) {
#pragma unroll
                for (int mm = 0; mm < 4; ++mm) { const int tk = tok[ai][mm]; qs[mm] = rowsc[tk < 0 ? 0 : tk]; } }
#pragma unroll
            for (int mm = 0; mm < 4; ++mm) { const int m = mm; const size_t off = (size_t)(tok[ai][m] < 0 ? 0 : tok[ai][m]) * DM + col0;
#pragma unroll
                for (int bj = 0; bj < 2; ++bj) xr[mm][bj] = *(const u32x4*)(XM + off + bj * HALF); }
#pragma unroll
            for (int mm = 0; mm < 4; ++mm) { const int m = mm; const int tk = tok[ai][m]; const float g1 = gt[mm]; float s = 0.f; const float iq = __builtin_amdgcn_rcpf(qs[mm]);
                if (tk >= 0) { const size_t off = (size_t)tk * DM + col0;
#pragma unroll
                    for (int bj = 0; bj < 2; ++bj) { const u32x4 xw = xr[mm][bj];
                        const f32x4 x0 = {bf_lo(xw.x), bf_hi(xw.x), bf_lo(xw.y), bf_hi(xw.y)}, x1 = {bf_lo(xw.z), bf_hi(xw.z), bf_lo(xw.w), bf_hi(xw.w)};
                        const f32x4 y0 = x0 + acc[ai][bj][m][0] * g1, y1 = x1 + acc[ai][bj][m][1] * g1;
                        u32x4 w; w.x = cvt_pk_bf16(y0.x, y0.y); w.y = cvt_pk_bf16(y0.z, y0.w); w.z = cvt_pk_bf16(y1.x, y1.y); w.w = cvt_pk_bf16(y1.z, y1.w);
                        *(u32x4*)(XM + off + bj * HALF) = w;
                        if (last) {
                            if (XB8) { u32x2 w8; w8.x = pk4_i8(y0.x * iq, y0.y * iq, y0.z * iq, y0.w * iq); w8.y = pk4_i8(y1.x * iq, y1.y * iq, y1.z * iq, y1.w * iq); *(u32x2*)(XB8 + off + bj * HALF) = w8; }
                            s += (y0.x * y0.x + y0.y * y0.y) + (y0.z * y0.z + y0.w * y0.w) + (y1.x * y1.x + y1.y * y1.y) + (y1.z * y1.z + y1.w * y1.w); }
                    } }
                part[ai][m] = s; }
            asm volatile("" ::: "memory");
          }
        if (last) row_reduce_store(part, lds_epi, u.pm, wr, wc, fr, fq, tid, ssqx, u.pn, rowmap);
    }
};
struct EpiNull { float* sink; mutable int eslot = 0;
    __device__ __forceinline__ void prefetch(const Unit&, LAS unsigned char*, int, int, int) const {}
    __device__ __forceinline__ void operator()(const f32x4 (&acc)[2][2][4][2], const Unit& u, int wr, int wc, int fr, int fq, LAS unsigned char* lds_epi, int tid) const {
        f32x4 s = {0.f, 0.f, 0.f, 0.f};
#pragma unroll
        for (int ai = 0; ai < 2; ++ai)
#pragma unroll
            for (int bj = 0; bj < 2; ++bj)
#pragma unroll
                for (int m = 0; m < 4; ++m) { s += acc[ai][bj][m][0]; s += acc[ai][bj][m][1]; }
        if ((s.x + s.y) + (s.z + s.w) == 12345.678f) sink[tid] = s.x;
    }
};
}
namespace att {
__device__ __forceinline__ int crow(int r, int hi) { return (r & 3) + 8 * (r >> 2) + 4 * hi; }
__device__ __forceinline__ bf16x8 ld8(const bf16_t* p) { return *reinterpret_cast<const bf16x8*>(p); }
constexpr float THR = 8.f;
__device__ __forceinline__ void partialSM(f32x16& p0, f32x16& p1, float& m_reg, float& alpha) {
    float pmax = p0[0];
#pragma unroll
    for (int r = 1; r < 16; ++r) pmax = fmaxf(pmax, p0[r]);
#pragma unroll
    for (int r = 0; r < 16; ++r) pmax = fmaxf(pmax, p1[r]);
    { auto rr = __builtin_amdgcn_permlane32_swap(__float_as_uint(pmax), __float_as_uint(pmax), false, false);
      pmax = fmaxf(__uint_as_float(rr[0]), __uint_as_float(rr[1])); }
    float mn;
    if (__builtin_expect(__all(pmax - m_reg <= THR), 1)) { mn = m_reg; alpha = 1.f; }
    else { mn = fmaxf(m_reg, pmax); alpha = __builtin_amdgcn_exp2f(m_reg - mn); m_reg = mn; }
#pragma unroll
    for (int r = 0; r < 16; ++r) p0[r] = p0[r] - mn;
#pragma unroll
    for (int r = 0; r < 16; ++r) p1[r] = p1[r] - mn;
#pragma unroll
    for (int r = 0; r < 16; ++r) p0[r] = __builtin_amdgcn_exp2f(p0[r]);
}
template <bool FIRST>
__device__ __forceinline__ void partialSM_neg(f32x16& p0, f32x16& p1, float& m_reg, f32x16& negm, float& alpha) {
    float pmax = p0[0];
#pragma unroll
    for (int r = 1; r < 16; ++r) pmax = fmaxf(pmax, p0[r]);
#pragma unroll
    for (int r = 0; r < 16; ++r) pmax = fmaxf(pmax, p1[r]);
    { auto rr = __builtin_amdgcn_permlane32_swap(__float_as_uint(pmax), __float_as_uint(pmax), false, false);
      pmax = fmaxf(__uint_as_float(rr[0]), __uint_as_float(rr[1])); }
    if (!FIRST && __builtin_expect(__all(pmax <= THR), 1)) { alpha = 1.f; }
    else { const float dl = FIRST ? pmax : fmaxf(pmax, 0.f); m_reg += dl;
#pragma unroll
        for (int r = 0; r < 16; ++r) { p0[r] -= dl; p1[r] -= dl; }
        const float nm = -m_reg;
#pragma unroll
        for (int r = 0; r < 16; ++r) negm[r] = nm;
        alpha = FIRST ? 1.f : __builtin_amdgcn_exp2f(-dl); }
#pragma unroll
    for (int r = 0; r < 16; ++r) p0[r] = __builtin_amdgcn_exp2f(p0[r]);
}
__device__ __forceinline__ void finishSM(f32x16& p0, f32x16& p1, float alpha, float& l_reg, bf16x8& pa0, bf16x8& pa1, bf16x8& pa2, bf16x8& pa3) {
#pragma unroll
    for (int r = 0; r < 16; ++r) p1[r] = __builtin_amdgcn_exp2f(p1[r]);
    float ps = 0;
#pragma unroll
    for (int r = 0; r < 16; ++r) ps += p0[r];
#pragma unroll
    for (int r = 0; r < 16; ++r) ps += p1[r];
    { auto rr = __builtin_amdgcn_permlane32_swap(__float_as_uint(ps), __float_as_uint(ps), false, false);
      ps = __uint_as_float(rr[0]) + __uint_as_float(rr[1]); }
    l_reg = l_reg * alpha + ps;
#define PK4(P, BASE, OUT) do { unsigned a0 = cvt_pk_bf16(P[BASE + 0], P[BASE + 1]), a1 = cvt_pk_bf16(P[BASE + 2], P[BASE + 3]);   \
    unsigned b0 = cvt_pk_bf16(P[BASE + 4], P[BASE + 5]), b1 = cvt_pk_bf16(P[BASE + 6], P[BASE + 7]);                              \
    auto r0 = __builtin_amdgcn_permlane32_swap(a0, b0, false, false); auto r1 = __builtin_amdgcn_permlane32_swap(a1, b1, false, false); \
    u32x4 w = {r0[0], r1[0], r0[1], r1[1]}; OUT = *reinterpret_cast<bf16x8*>(&w); } while (0)
    PK4(p0, 0, pa0); PK4(p0, 8, pa1); PK4(p1, 0, pa2); PK4(p1, 8, pa3);
#undef PK4
}
__device__ __forceinline__ void finishSM_ns(f32x16& p0, f32x16& p1, float alpha, float& l_reg, bf16x8& pa0, bf16x8& pa1, bf16x8& pa2, bf16x8& pa3) {
#pragma unroll
    for (int r = 0; r < 16; ++r) p1[r] = __builtin_amdgcn_exp2f(p1[r]);
    float ps = 0;
#pragma unroll
    for (int r = 0; r < 16; ++r) ps += p0[r];
#pragma unroll
    for (int r = 0; r < 16; ++r) ps += p1[r];
    { auto rr = __builtin_amdgcn_permlane32_swap(__float_as_uint(ps), __float_as_uint(ps), false, false);
      ps = __uint_as_float(rr[0]) + __uint_as_float(rr[1]); }
    l_reg = l_reg * alpha + ps;
#define PK4N(P, BASE, OUT) do { u32x4 w = {cvt_pk_bf16(P[BASE + 0], P[BASE + 1]), cvt_pk_bf16(P[BASE + 2], P[BASE + 3]), cvt_pk_bf16(P[BASE + 4], P[BASE + 5]), cvt_pk_bf16(P[BASE + 6], P[BASE + 7])}; \
    OUT = *reinterpret_cast<bf16x8*>(&w); } while (0)
    PK4N(p0, 0, pa0); PK4N(p0, 8, pa1); PK4N(p1, 0, pa2); PK4N(p1, 8, pa3);
#undef PK4N
}
template <int NCG> __device__ __forceinline__ int v_st_ns(int k, int c) { return ((k >> 3) * NCG + (c >> 5)) * 512 + ((k & 7) * 32 + (c & 31)) * 2; }
template <int NCG> __device__ __forceinline__ int v_st(int k, int c) { const int kk = (k & ~0xC) | ((k & 4) << 1) | ((k & 8) >> 1); return ((kk >> 3) * NCG + (c >> 5)) * 512 + ((kk & 7) * 32 + (c & 31)) * 2; }
__device__ __forceinline__ int v_rd_base(int lane) { return ((lane & 3) << 3) | (((lane >> 2) & 3) << 6) | (((lane >> 4) & 1) << 5) | (((lane >> 5) & 1) << 8); }
template <int OFF> __device__ __forceinline__ s16x4 tr_read(int vb) { s16x4 r; asm volatile("ds_read_b64_tr_b16 %0, %1 offset:%2" : "=&v"(r) : "v"(vb), "i"(OFF) : "memory"); return r; }
template <int NCG, int D0> __device__ __forceinline__ void pv_one(f32x16& od, int vb, bf16x8 pa0, bf16x8 pa1, bf16x8 pa2, bf16x8 pa3) {
    constexpr int HS = NCG * 512, KS = 2 * HS, O = D0 * 512;
    const s16x4 l0 = tr_read<O>(vb), h0 = tr_read<O + HS>(vb), l1 = tr_read<O + KS>(vb), h1 = tr_read<O + KS + HS>(vb);
    const s16x4 l2 = tr_read<O + 2 * KS>(vb), h2 = tr_read<O + 2 * KS + HS>(vb), l3 = tr_read<O + 3 * KS>(vb), h3 = tr_read<O + 3 * KS + HS>(vb);
    asm volatile("s_waitcnt lgkmcnt(0)" ::: "memory"); SBAR();
#define PK(L, H) (bf16x8){L[0], L[1], L[2], L[3], H[0], H[1], H[2], H[3]}
    od = __builtin_amdgcn_mfma_f32_32x32x16_bf16(pa0, PK(l0, h0), od, 0, 0, 0);
    od = __builtin_amdgcn_mfma_f32_32x32x16_bf16(pa1, PK(l1, h1), od, 0, 0, 0);
    od = __builtin_amdgcn_mfma_f32_32x32x16_bf16(pa2, PK(l2, h2), od, 0, 0, 0);
    od = __builtin_amdgcn_mfma_f32_32x32x16_bf16(pa3, PK(l3, h3), od, 0, 0, 0);
#undef PK
}
__device__ __forceinline__ u32x4 ld16_sys(const void* p) { u32x4 v; asm volatile("global_load_dwordx4 %0, %1, off sc0 sc1\n\ts_waitcnt vmcnt(0)" : "=v"(v) : "v"(p) : "memory"); return v; }

template <class RowPtr>
__device__ __forceinline__ void head_tail(const f32x16 (&o)[2], float l_reg, float* wsf, bf16_t* stg, int lane, int r32, int hi, float (&ss)[4], const RowPtr& rowptr) {
    if (hi == 0) wsf[r32] = l_reg; asm volatile("s_waitcnt lgkmcnt(0)" ::: "memory");
    float rli[16];
#pragma unroll
    for (int r = 0; r < 16; ++r) rli[r] = __builtin_amdgcn_rcpf(wsf[crow(r, hi)]);
#pragma unroll
    for (int r = 0; r < 16; ++r) { const int orow = crow(r, hi);
#pragma unroll
        for (int d0 = 0; d0 < 2; ++d0) stg[orow * 64 + d0 * 32 + r32] = (bf16_t)f2bf(o[d0][r] * rli[r]); }
    asm volatile("s_waitcnt lgkmcnt(0)" ::: "memory");
#pragma unroll
    for (int i = 0; i < 4; ++i) { const int row = i * 8 + (lane >> 3), ch = lane & 7; const u32x4 v = *(const u32x4*)(stg + row * 64 + ch * 8);
        *(u32x4*)(rowptr(i) + ch * 8) = v;
        float s = 0.f;
#pragma unroll
        for (int j = 0; j < 4; ++j) { const float a = bflo(v[j]), b = bfhi(v[j]); s += a * a + b * b; }
        ss[i] += s; }
    asm volatile("s_waitcnt lgkmcnt(0)" ::: "memory");
}
__device__ __forceinline__ u32x4 ld16_dev(const void* p) {
    const unsigned long long a = __hip_atomic_load((const unsigned long long*)p, __ATOMIC_RELAXED, __HIP_MEMORY_SCOPE_AGENT), b = __hip_atomic_load((const unsigned long long*)p + 1, __ATOMIC_RELAXED, __HIP_MEMORY_SCOPE_AGENT);
    u32x4 v; v.x = (unsigned)a; v.y = (unsigned)(a >> 32); v.z = (unsigned)b; v.w = (unsigned)(b >> 32); return v; }
template <class RowPtr>
__device__ __forceinline__ void group_norm_rows(float (&ss)[4], int lane, const RowPtr& rowptr  ) {
    float rstd[4];
#pragma unroll
    for (int i = 0; i < 4; ++i) { float s = ss[i]; s += __shfl_xor(s, 1); s += __shfl_xor(s, 2); s += __shfl_xor(s, 4); rstd[i] = rsqrtf(s * (1.0f / 384.0f) + RMS_EPS); }
    asm volatile("s_waitcnt vmcnt(0)" ::: "memory");
#pragma unroll
    for (int hb = 0; hb < 6; hb += 2) {
        u32x4 v[2][4];
#pragma unroll
        for (int h = 0; h < 2; ++h)
#pragma unroll
            for (int i = 0; i < 4; ++i) v[h][i] = ld16_dev(rowptr(i, hb + h) + (lane & 7) * 8);
#pragma unroll
        for (int h = 0; h < 2; ++h)
#pragma unroll
            for (int i = 0; i < 4; ++i) { bf16_t* p = rowptr(i, hb + h) + (lane & 7) * 8; u32x4 w;
#pragma unroll
                for (int j = 0; j < 4; ++j) w[j] = cvt_pk_bf16(bflo(v[h][i][j]) * rstd[i], bfhi(v[h][i][j]) * rstd[i]);
                *(u32x4*)p = w; }
    }
}

constexpr int KP = 208;
constexpr int SHM_K = 64 * KP, SHM_V = 8192;
constexpr int SLOT = 2 * SHM_K + 2 * SHM_V, L_WS = 3 * SLOT, MLA_LDS = L_WS + 8 * 384;
__device__ __forceinline__ void qkt96(f32x16& p0, f32x16& p1, const char* Ks, const bf16x8* qr, const f32x16& negm, int r32, int hi) {
#pragma unroll
    for (int d0 = 0; d0 < 6; ++d0) { const int cb = (d0 * 16 + hi * 8) * 2;
        const bf16x8 b0 = *reinterpret_cast<const bf16x8*>(Ks + r32 * KP + cb);
        const bf16x8 b1 = *reinterpret_cast<const bf16x8*>(Ks + (32 + r32) * KP + cb);
        if (d0 == 0) { p0 = __builtin_amdgcn_mfma_f32_32x32x16_bf16(b0, qr[0], negm, 0, 0, 0); p1 = __builtin_amdgcn_mfma_f32_32x32x16_bf16(b1, qr[0], negm, 0, 0, 0); }
        else { p0 = __builtin_amdgcn_mfma_f32_32x32x16_bf16(b0, qr[d0], p0, 0, 0, 0); p1 = __builtin_amdgcn_mfma_f32_32x32x16_bf16(b1, qr[d0], p1, 0, 0, 0); } }
}
__device__ __forceinline__ void mla_unit(int b, int qt, const bf16_t* __restrict__ QB, const bf16_t* __restrict__ KB, const bf16_t* __restrict__ VB, bf16_t* MIX, char* lds, int tid) {
    asm volatile("" : "+v"(tid));
    const int wid = __builtin_amdgcn_readfirstlane(tid >> 6), lane = tid & 63, r32 = lane & 31, hi = lane >> 5;
    float* wsf = (float*)(lds + L_WS) + wid * 96; float* al_l = wsf + 32; float* ssrow = wsf + 64;
    bf16_t* stg = (bf16_t*)lds + wid * 2048;
    const long rowbase = (long)b * SEQ; const int q0 = qt * 256 + wid * 32;
    int kgo[3], klo[3], vgo[2], vlo[2];
#pragma unroll
    for (int i = 0; i < 3; ++i) { const int p = tid + 512 * i, row = p / 12, c = p - row * 12; kgo[i] = row * 576 + c * 8; klo[i] = (row >> 6) * SHM_K + (row & 63) * KP + c * 16; }
#pragma unroll
    for (int i = 0; i < 2; ++i) { const int p = tid + 512 * i, row = p >> 3, c = p & 7; vgo[i] = row * 384 + c * 8; vlo[i] = 2 * SHM_K + (row >> 6) * SHM_V + v_st_ns<2>(row & 63, c * 8); }
    const int vrd = (int)(uintptr_t)lds + v_rd_base(lane);
    if (lane < 32) ssrow[lane] = 0.f;
    constexpr int NP = SEQ / 128;
    if (wid >= 4) __builtin_amdgcn_s_setprio(1);
    bf16x8 ks[3], vs[2];
    for (int h = 0; h < 6; ++h) {
        const bf16_t* Qw = QB + (rowbase + q0 + r32) * 576 + h * 96 + hi * 8;
        const bf16_t* Kh = KB + rowbase * 576 + h * 96; const bf16_t* Vh = VB + rowbase * 384 + h * 64;
        bf16x8 qr[6];
#pragma unroll
        for (int d0 = 0; d0 < 6; ++d0) qr[d0] = ld8(Qw + d0 * 16);
        float m_reg = 0.f, l_reg = 0; f32x16 o[2] = {}; f32x16 negm = {};

#define SLOAD(P) do { _Pragma("unroll") for (int i = 0; i < 3; ++i) ks[i] = ld8(Kh + (long)(P) * (128 * 576) + kgo[i]); _Pragma("unroll") for (int i = 0; i < 2; ++i) vs[i] = ld8(Vh + (long)(P) * (128 * 384) + vgo[i]); } while (0)
#define LBAR() asm volatile("s_waitcnt lgkmcnt(0)\n\ts_barrier" ::: "memory")
#define SWRITE(sl) do { char* sb_ = lds + (sl) * SLOT; _Pragma("unroll") for (int i = 0; i < 3; ++i) *(bf16x8*)(sb_ + klo[i]) = ks[i]; _Pragma("unroll") for (int i = 0; i < 2; ++i) *(bf16x8*)(sb_ + vlo[i]) = vs[i]; } while (0)
#define KT(sl, sub) (lds + (sl) * SLOT + (sub) * SHM_K)
#define VT(sl, sub) (vrd + (sl) * SLOT + 2 * SHM_K + (sub) * SHM_V)
#define RESC(a) do { if (__any((a) < 1.f)) { if (hi == 0) al_l[r32] = (a); asm volatile("s_waitcnt lgkmcnt(0)" ::: "memory"); \
        _Pragma("unroll") for (int d = 0; d < 2; ++d) _Pragma("unroll") for (int r = 0; r < 16; ++r) o[d][r] *= al_l[crow(r, hi)]; } } while (0)
#define PV2(vb) do { pv_one<2, 0>(o[0], (vb), pa0, pa1, pa2, pa3); pv_one<2, 1>(o[1], (vb), pa0, pa1, pa2, pa3); } while (0)
        f32x16 pA0, pA1, pB0, pB1; float alA, alB; bf16x8 pa0, pa1, pa2, pa3;
        int s0 = 0, s1 = 1, s2 = 2;
        if (h == 0) SLOAD(0);
        SWRITE(0); SLOAD(1); LBAR();
        qkt96(pA0, pA1, KT(0, 0), qr, negm, r32, hi); partialSM_neg<true>(pA0, pA1, m_reg, negm, alA);
        SWRITE(1); SLOAD(2); LBAR();
        for (int J = 0; J < NP - 1; ++J) {
            if (J + 2 < NP) SWRITE(s2); if (J + 3 < NP) SLOAD(J + 3);
            SBAR(); qkt96(pB0, pB1, KT(s0, 1), qr, negm, r32, hi);
            finishSM_ns(pA0, pA1, alA, l_reg, pa0, pa1, pa2, pa3); SBAR();
            PV2(VT(s0, 0)); partialSM_neg<false>(pB0, pB1, m_reg, negm, alB);
            RESC(alB);
            SBAR(); qkt96(pA0, pA1, KT(s1, 0), qr, negm, r32, hi);
            finishSM_ns(pB0, pB1, alB, l_reg, pa0, pa1, pa2, pa3); SBAR();
            PV2(VT(s0, 1)); partialSM_neg<false>(pA0, pA1, m_reg, negm, alA);
            RESC(alA); LBAR();
            { const int t_ = s0; s0 = s1; s1 = s2; s2 = t_; }
        }
        if (h + 1 < 6) {
#pragma unroll
            for (int i = 0; i < 3; ++i) ks[i] = ld8(Kh + 96 + kgo[i]);
#pragma unroll
            for (int i = 0; i < 2; ++i) vs[i] = ld8(Vh + 64 + vgo[i]); }
        SBAR(); qkt96(pB0, pB1, KT(s0, 1), qr, negm, r32, hi);
        finishSM_ns(pA0, pA1, alA, l_reg, pa0, pa1, pa2, pa3); SBAR();
        PV2(VT(s0, 0)); partialSM_neg<false>(pB0, pB1, m_reg, negm, alB);
        RESC(alB);
        finishSM_ns(pB0, pB1, alB, l_reg, pa0, pa1, pa2, pa3); SBAR();
        PV2(VT(s0, 1));
#undef KT
#undef VT
#undef RESC
#undef PV2
#undef SLOAD
#undef SWRITE
        LDS_BAR();
        bf16_t* obase = MIX + (rowbase + q0) * 1024 + 384 + h * 64;
        { float ssh[4] = {0.f, 0.f, 0.f, 0.f};
          head_tail(o, l_reg, wsf, stg, lane, r32, hi, ssh, [&](int i) { return obase + (long)(i * 8 + (lane >> 3)) * 1024; });
#pragma unroll
          for (int i = 0; i < 4; ++i) { float t = ssh[i]; t += __shfl_xor(t, 1); t += __shfl_xor(t, 2); t += __shfl_xor(t, 4); if ((lane & 7) == 0) ssrow[i * 8 + (lane >> 3)] += t; } }
        LDS_BAR();
    }
    __builtin_amdgcn_s_setprio(0);
    { int ln = lane; asm volatile("" : "+v"(ln));
      int q0l = q0; asm volatile("" : "+v"(q0l));
      bf16_t* obase = MIX + (rowbase + q0l) * 1024 + 384; float ss[4];
      asm volatile("s_waitcnt lgkmcnt(0)" ::: "memory");
#pragma unroll
      for (int i = 0; i < 4; ++i) ss[i] = ssrow[i * 8 + (ln >> 3)] * 0.125f;
      group_norm_rows(ss, ln, [&](int i, int h) { return obase + (long)(i * 8 + (ln >> 3)) * 1024 + h * 64; }); }
}

constexpr int DL_X = 0, DL_ML = 65536, DL_V = 67584, DL_WS = 133120, DIL_LDS = 135168;
template <int SH>
__device__ __forceinline__ void dil_loadk(bf16x8 (&kf)[2][4], int kb, const bf16_t* __restrict__ Kb, int r32, int hi) {
    kb = __builtin_amdgcn_readfirstlane(kb);
    const char* kbase = (const char*)Kb + ((long)kb << SH) * 768; const unsigned koff = (unsigned)((r32 << SH) * 768 + hi * 16);
#pragma unroll
    for (int hf = 0; hf < 2; ++hf)
#pragma unroll
        for (int d0 = 0; d0 < 4; ++d0) kf[hf][d0] = *(const bf16x8*)(kbase + (size_t)(hf * ((32 << SH) * 768) + d0 * 32) + (size_t)koff);
}
template <int SH>
__device__ __forceinline__ void dil_tile(int kb, int qidx, bf16x8 (&kf)[2][4], bool nv, const bf16_t* __restrict__ Kb, const bf16_t* __restrict__ Vb, const bf16x8 (&qr)[4], float& m_reg, float& l_reg, f32x16 (&o)[2],
                                         char* V_lds, int vb0, float* al_l, int lane, int r32, int hi) {
    constexpr int L = SEQ >> SH;
    { const int kbu = __builtin_amdgcn_readfirstlane(kb);
      const char* vbase = (const char*)Vb + ((long)kbu << SH) * 768; const unsigned voff = (unsigned)((((lane & 31) >> 2) << SH) * 768 + ((lane >> 5) * 32 + (lane & 3) * 8) * 2);
      LAS unsigned char* vdst = (LAS unsigned char*)(unsigned)(uintptr_t)V_lds;
#pragma unroll
      for (int j = 0; j < 8; ++j) __builtin_amdgcn_global_load_lds((const unsigned*)(vbase + (size_t)(j * ((8 << SH) * 768)) + (size_t)voff), (LAS unsigned*)(vdst + j * 1024), 16, 0, 0); }
    f32x16 p0 = {}, p1 = {};
#pragma unroll
    for (int d0 = 0; d0 < 4; ++d0) { p0 = __builtin_amdgcn_mfma_f32_32x32x16_bf16(kf[0][d0], qr[d0], p0, 0, 0, 0); p1 = __builtin_amdgcn_mfma_f32_32x32x16_bf16(kf[1][d0], qr[d0], p1, 0, 0, 0); }
    if (nv) dil_loadk<SH>(kf, kb + 64, Kb, r32, hi);
    const int rel = kb - qidx + 64 + 4 * hi;
    if (kb < 0 || kb + 63 >= L) {
#pragma unroll
        for (int r = 0; r < 16; ++r) { const int cr = (r & 3) + 8 * (r >> 2); const int k0 = kb + 4 * hi + cr, k1 = k0 + 32;
            const bool v0 = (unsigned)(rel + cr) <= 128u && (unsigned)k0 < (unsigned)L, v1 = (unsigned)(rel + cr + 32) <= 128u && (unsigned)k1 < (unsigned)L;
            p0[r] = v0 ? p0[r] : -INFINITY; p1[r] = v1 ? p1[r] : -INFINITY; }
    } else {
#pragma unroll
        for (int r = 0; r < 16; ++r) { const int cr = (r & 3) + 8 * (r >> 2);
            p0[r] = (unsigned)(rel + cr) <= 128u ? p0[r] : -INFINITY; p1[r] = (unsigned)(rel + cr + 32) <= 128u ? p1[r] : -INFINITY; }
    }
    float alpha; bf16x8 pa0, pa1, pa2, pa3;
    partialSM(p0, p1, m_reg, alpha);
    finishSM_ns(p0, p1, alpha, l_reg, pa0, pa1, pa2, pa3);
    if (__any(alpha < 1.f)) { if (hi == 0) al_l[r32] = alpha; asm volatile("s_waitcnt lgkmcnt(0)" ::: "memory");
#pragma unroll
        for (int d = 0; d < 2; ++d)
#pragma unroll
            for (int r = 0; r < 16; ++r) o[d][r] *= al_l[crow(r, hi)]; }
    if (nv) asm volatile("s_waitcnt vmcnt(8) lgkmcnt(0)" ::: "memory"); else asm volatile("s_waitcnt vmcnt(0) lgkmcnt(0)" ::: "memory");
    pv_one<2, 0>(o[0], vb0, pa0, pa1, pa2, pa3); pv_one<2, 1>(o[1], vb0, pa0, pa1, pa2, pa3);
}
__device__ __forceinline__ void dil_unit(int b, int iblk, int h8, const bf16_t* __restrict__ QA, const bf16_t* __restrict__ KA, const bf16_t* __restrict__ VA, bf16_t* MIX, char* lds, int tid_) {
    asm volatile("" : "+v"(tid_));
    const int lane = tid_ & 63, r32 = lane & 31, hi = lane >> 5, w = __builtin_amdgcn_readfirstlane(tid_ >> 6);
    float* X = (float*)(lds + DL_X); float* ML = (float*)(lds + DL_ML);
    char* V_lds = lds + DL_V + w * 8192; bf16_t* stg = (bf16_t*)V_lds; float* wsf = (float*)(lds + DL_WS) + w * 64; float* al_l = wsf + 32;
    const long rowbase = (long)b * SEQ;
    const int vb0 = (int)(uintptr_t)V_lds + v_rd_base(lane);
    const int rho = 8 * h8 + w;
    float ss[4] = {0.f, 0.f, 0.f, 0.f};
    const int lane_o = lane;
    for (int h = 0; h < 6; ++h) {
        float m_reg = -1e30f, l_reg = 0; f32x16 o[2] = {};
        bf16x8 qr[4];
        const bf16_t* Kh = KA + rowbase * 384 + h * 64; const bf16_t* Vh = VA + rowbase * 384 + h * 64;
        int ln1 = lane_o; asm volatile("" : "+v"(ln1));
        {   const int lane = ln1, r32 = ln1 & 31, hi = ln1 >> 5;
            const int a = r32 >> 3, c = r32 & 7, pos = 16 * (32 * iblk + 4 * w + a) + 8 * h8 + c;
            const bf16_t* Qw = QA + (rowbase + pos) * 384 + h * 64 + hi * 8;
#pragma unroll
            for (int d0 = 0; d0 < 4; ++d0) qr[d0] = ld8(Qw + d0 * 16);
            const int kb0 = 16 * (32 * iblk + 4 * w) + 8 * h8 - 64;
            { bf16x8 kf[2][4]; int t = kb0 + 63 >= 0 ? 0 : (-kb0) >> 6;
              if (t < 3 && kb0 + 64 * t < SEQ) dil_loadk<0>(kf, kb0 + 64 * t, Kh, r32, hi);
#pragma unroll 1
              for (; t < 3 && kb0 + 64 * t < SEQ; ++t) { const int kb = kb0 + 64 * t; const bool nv = t + 1 < 3 && kb + 64 < SEQ;
                  dil_tile<0>(kb, pos, kf, nv, Kh, Vh, qr, m_reg, l_reg, o, V_lds, vb0, al_l, lane, r32, hi); } }
#pragma unroll
            for (int r = 0; r < 16; ++r) { const int q = crow(r, hi); float* xp = X + ((q & 7) * 32 + 4 * w + (q >> 3)) * 64 + r32; xp[0] = o[0][r]; xp[32] = o[1][r]; }
            if (hi == 0) { ML[c * 32 + 4 * w + a] = m_reg; ML[256 + c * 32 + 4 * w + a] = l_reg; }
        }
        asm volatile("s_waitcnt lgkmcnt(0)" ::: "memory"); __syncthreads();
        int ln2 = lane_o; asm volatile("" : "+v"(ln2));
        {   const int lane = ln2, r32 = ln2 & 31, hi = ln2 >> 5;
            const int pos = 16 * (32 * iblk + r32) + rho;
            const bf16_t* Qw = QA + (rowbase + pos) * 384 + h * 64 + hi * 8;
#pragma unroll
            for (int d0 = 0; d0 < 4; ++d0) qr[d0] = ld8(Qw + d0 * 16);
#pragma unroll
            for (int r = 0; r < 16; ++r) { const float* xp = X + (w * 32 + crow(r, hi)) * 64 + r32; o[0][r] = xp[0]; o[1][r] = xp[32]; }
            m_reg = ML[w * 32 + r32]; l_reg = ML[256 + w * 32 + r32];
            asm volatile("s_waitcnt lgkmcnt(0)" ::: "memory"); __syncthreads();
            { bf16x8 kf[2][4]; const int kb16 = 32 * iblk - 64, kb4 = 128 * iblk - 64;
              int t = kb16 + 63 >= 0 ? 0 : (-kb16) >> 6;
              if (t < 3 && kb16 + 64 * t < (SEQ >> 4)) dil_loadk<4>(kf, kb16 + 64 * t, Kh + rho * 384, r32, hi);
#pragma unroll 1
              for (; t < 3 && kb16 + 64 * t < (SEQ >> 4); ++t) { const int kb = kb16 + 64 * t; const bool nv = t + 1 < 3 && kb + 64 < (SEQ >> 4);
                  dil_tile<4>(kb, 32 * iblk + r32, kf, nv, Kh + rho * 384, Vh + rho * 384, qr, m_reg, l_reg, o, V_lds, vb0, al_l, lane, r32, hi); }
              t = kb4 + 63 >= 0 ? 0 : (-kb4) >> 6;
              if (t < 4 && kb4 + 64 * t < (SEQ >> 2)) dil_loadk<2>(kf, kb4 + 64 * t, Kh + (rho & 3) * 384, r32, hi);
#pragma unroll 1
              for (; t < 4 && kb4 + 64 * t < (SEQ >> 2); ++t) { const int kb = kb4 + 64 * t; const bool nv = t + 1 < 4 && kb + 64 < (SEQ >> 2);
                  dil_tile<2>(kb, 4 * (32 * iblk + r32) + (rho >> 2), kf, nv, Kh + (rho & 3) * 384, Vh + (rho & 3) * 384, qr, m_reg, l_reg, o, V_lds, vb0, al_l, lane, r32, hi); } }
        }
        bf16_t* obase = MIX + (rowbase + rho) * 1024 + h * 64;
        head_tail(o, l_reg, wsf, stg, lane, r32, hi, ss, [&](int i) { return obase + (long)(16 * (32 * iblk + i * 8 + (lane >> 3))) * 1024; });
    }
    { int ln = lane; asm volatile("" : "+v"(ln));
      bf16_t* obase = MIX + (rowbase + rho) * 1024;
      group_norm_rows(ss, ln, [&](int i, int h) { return obase + (long)(16 * (32 * iblk + i * 8 + (ln >> 3))) * 1024 + h * 64; }); }
    __syncthreads();
}

__device__ __forceinline__ void fft_a_unit(int b, int n2, const bf16_t* __restrict__ Z, const bf16_t* __restrict__ W1, const f32x2* __restrict__ TW, bf16_t* AP, char* lds, int tid) {
    asm volatile("" : "+v"(tid));
    const int wid = tid >> 6, lane = tid & 63, r32 = lane & 31, hi = lane >> 5;
#pragma unroll
    for (int bt = 0; bt < 2; ++bt) { bf16x8 pc[8];
#pragma unroll
        for (int j = 0; j < 8; ++j) { const int p = tid + 512 * (bt * 8 + j), row = p >> 5, c8 = p & 31, cs = row >> 7, n1 = row & 127;
            pc[j] = ld8(Z + ((long)b * SEQ + 64 * n1 + n2) * 512 + cs * 256 + c8 * 8); }
#pragma unroll
        for (int j = 0; j < 8; ++j) { const int p = tid + 512 * (bt * 8 + j), row = p >> 5, c8 = p & 31;
            *(bf16x8*)(lds + ((row >> 6) * 2 + (c8 >> 4)) * 16384 + v_st<4>(row & 63, (c8 & 15) * 8)) = pc[j]; } }
    __syncthreads();
    const int kb = wid & 3, ch = wid >> 2;
    f32x16 acc[2][4] = {};
    const int vb = (int)(uintptr_t)lds + v_rd_base(lane);
    for (int kblk = 0; kblk < 4; ++kblk) {
        bf16x8 af[2][4];
#pragma unroll
        for (int ri = 0; ri < 2; ++ri)
#pragma unroll
            for (int s = 0; s < 4; ++s) af[ri][s] = ld8(W1 + (ri * 128 + 32 * kb + r32) * 256 + kblk * 64 + s * 16 + hi * 8);
        const int vt = vb + (kblk * 2 + ch) * 16384;
#pragma unroll
        for (int ri = 0; ri < 2; ++ri) {
            pv_one<4, 0>(acc[ri][0], vt, af[ri][0], af[ri][1], af[ri][2], af[ri][3]); pv_one<4, 1>(acc[ri][1], vt, af[ri][0], af[ri][1], af[ri][2], af[ri][3]);
            pv_one<4, 2>(acc[ri][2], vt, af[ri][0], af[ri][1], af[ri][2], af[ri][3]); pv_one<4, 3>(acc[ri][3], vt, af[ri][0], af[ri][1], af[ri][2], af[ri][3]); }
    }
    f32x2 tw[16];
#pragma unroll
    for (int r = 0; r < 16; ++r) tw[r] = TW[n2 * 128 + 32 * kb + crow(r, hi)];
    __syncthreads();
    bf16_t* ot = (bf16_t*)lds;
#pragma unroll
    for (int r = 0; r < 16; ++r) { const int k1 = 32 * kb + crow(r, hi); bf16_t* orow = ot + k1 * 512 + 128 * ch + r32;
#pragma unroll
        for (int d0 = 0; d0 < 4; ++d0) { const float re = acc[0][d0][r], im = acc[1][d0][r];
            orow[d0 * 32] = (bf16_t)f2bf(re * tw[r].x + im * tw[r].y); orow[256 + d0 * 32] = (bf16_t)f2bf(im * tw[r].x - re * tw[r].y); } }
    __syncthreads();
#pragma unroll
    for (int j = 0; j < 16; ++j) { const int p = tid + 512 * j, k1 = p >> 6, c = p & 63;
        *(u32x4*)(AP + (((long)b * 128 + k1) * 64 + n2) * 512 + c * 8) = *(const u32x4*)(ot + k1 * 512 + c * 8); }
    __syncthreads();
}
__device__ __forceinline__ void fft_c_units(int u0, int ustep, const bf16_t* __restrict__ AP, const bf16_t* __restrict__ W2, bf16_t* MIX, char* lds, int tid) {
    asm volatile("" : "+v"(tid));
    if (u0 >= 1024) return;
    const int wid = tid >> 6, lane = tid & 63, r32 = lane & 31, hi = lane >> 5;
    const int rb = wid & 1, cq4 = wid >> 1, ch = cq4 >> 1, dsel = cq4 & 1;
    bf16x8 af[2][4];
#pragma unroll
    for (int kblk = 0; kblk < 2; ++kblk)
#pragma unroll
        for (int s = 0; s < 4; ++s) af[kblk][s] = ld8(W2 + (32 * rb + r32) * 128 + kblk * 64 + s * 16 + hi * 8);
    bf16x8 pc[8];
    { const bf16_t* src = AP + ((long)(u0 & 7) * 128 + (u0 >> 3)) * 64 * 512;
#pragma unroll
      for (int j = 0; j < 8; ++j) pc[j] = ld8(src + (long)(tid + 512 * j) * 8); }
    const int vb = (int)(uintptr_t)lds + v_rd_base(lane) + dsel * 1024;
    for (int u = u0; u < 1024; u += ustep) {
        const int b = u & 7, k1 = u >> 3;
#pragma unroll
        for (int j = 0; j < 8; ++j) { const int p = tid + 512 * j, row = p >> 5, c8 = p & 31;
            *(bf16x8*)(lds + ((row >> 6) * 2 + (c8 >> 4)) * 16384 + v_st<4>(row & 63, (c8 & 15) * 8)) = pc[j]; }
        LDS_BAR();
        if (u + ustep < 1024) { const int un = u + ustep; const bf16_t* src = AP + ((long)(un & 7) * 128 + (un >> 3)) * 64 * 512;
#pragma unroll
            for (int j = 0; j < 8; ++j) pc[j] = ld8(src + (long)(tid + 512 * j) * 8); }
        f32x16 acc[2] = {};
#pragma unroll
        for (int kblk = 0; kblk < 2; ++kblk) { const int vt = vb + (kblk * 2 + ch) * 16384;
            pv_one<4, 0>(acc[0], vt, af[kblk][0], af[kblk][1], af[kblk][2], af[kblk][3]); pv_one<4, 1>(acc[1], vt, af[kblk][0], af[kblk][1], af[kblk][2], af[kblk][3]); }
        float* ot = (float*)(lds + 65536);
#pragma unroll
        for (int r = 0; r < 16; ++r) { const int k2 = 32 * rb + crow(r, hi);
#pragma unroll
            for (int j = 0; j < 2; ++j) ot[k2 * 260 + 64 * cq4 + 32 * j + r32] = acc[j][r]; }
        LDS_BAR();
        { const int k2 = tid >> 3, seg = tid & 7; const float* rp = ot + k2 * 260 + seg * 32; f32x4 x[8]; float s = 0.f;
#pragma unroll
          for (int j = 0; j < 8; ++j) { x[j] = *(const f32x4*)(rp + 4 * j); s += (x[j].x * x[j].x + x[j].y * x[j].y) + (x[j].z * x[j].z + x[j].w * x[j].w); }
          s += __shfl_xor(s, 1); s += __shfl_xor(s, 2); s += __shfl_xor(s, 4);
          const float rstd = rsqrtf(s * (1.0f / 256.0f) + RMS_EPS);
          bf16_t* dst = MIX + ((long)b * SEQ + k1 + 128 * k2) * 1024 + 768 + seg * 32;
#pragma unroll
          for (int j = 0; j < 4; ++j) { u32x4 w; w.x = cvt_pk_bf16(x[2 * j].x * rstd, x[2 * j].y * rstd); w.y = cvt_pk_bf16(x[2 * j].z * rstd, x[2 * j].w * rstd);
              w.z = cvt_pk_bf16(x[2 * j + 1].x * rstd, x[2 * j + 1].y * rstd); w.w = cvt_pk_bf16(x[2 * j + 1].z * rstd, x[2 * j + 1].w * rstd);
              *(u32x4*)(dst + 8 * j) = w; } }
        LDS_BAR();
    }
}
}
constexpr int NWAVES = 8;
struct Frame {
    LAS unsigned char* lds; volatile LAS unsigned* MISC; unsigned* ctl; unsigned char* ws;
    int tid, lane, wave, vcu, G; unsigned z;
};
__device__ __forceinline__ int fresh_tid(int wv) { int ln_; asm volatile("v_mbcnt_lo_u32_b32 %0, -1, 0\n\tv_mbcnt_hi_u32_b32 %0, -1, %0" : "=v"(ln_)); return wv * 64 + ln_; }
#define WSF(off) (ws + (size_t)(F.z + (unsigned)(off)))
struct Args { const float* in[18]; float* out; unsigned char* ws; int ph_lo, ph_hi; };

__constant__ double INVF_A[8] = {1.0, 0.19392274474868576, 0.03760603093086393, 0.007292664737217109, 0.001414213562373095, 0.0002742481756762073, 5.318295896944988e-05, 1.031338537721246e-05};
__constant__ double INVF_B[16] = {1.0, 0.44036660267178046, 0.19392274474868576, 0.08539710028576561, 0.03760603093086393, 0.016560440080994446, 0.007292664737217109, 0.003211445994752591,
                                  0.001414213562373095, 0.000622772421914596, 0.0002742481756762073, 0.00012076973741146504, 5.318295896944988e-05, 2.341999896140934e-05, 1.031338537721246e-05, 4.5416704806078695e-06};
__device__ __forceinline__ f32x2 cs_rev(float rev) { return (f32x2){__builtin_amdgcn_cosf(rev), __builtin_amdgcn_sinf(rev)}; }
__device__ __forceinline__ f32x2 cs_angle(double ang) { const double rv = ang * 0.15915494309189535; const double fr = rv - __builtin_floor(rv); return cs_rev((float)fr); }

template <class ColF>
__device__ __forceinline__ void tr_item(LAS float* scr, int lane, bf16_t* dst, int ldd, int k0, int n0, const ColF& colf) {
    const auto col = colf(n0 + (lane & 31));
    float tv[32];
#pragma unroll
    for (int i = 0; i < 32; ++i) tv[i] = col.val(k0 + 2 * i + (lane >> 5));
#pragma unroll
    for (int i = 0; i < 32; ++i) scr[(2 * i + (lane >> 5)) * 33 + (lane & 31)] = tv[i];
    LDS_WAIT(); asm volatile("" ::: "memory");
    const int c = lane & 7;
#pragma unroll
    for (int j = 0; j < 4; ++j) { const int n = (lane >> 3) + 8 * j; const LAS float* s = scr + (8 * c) * 33 + n;
        u32x4 o; o.x = pk2(s[0 * 33], s[1 * 33]); o.y = pk2(s[2 * 33], s[3 * 33]); o.z = pk2(s[4 * 33], s[5 * 33]); o.w = pk2(s[6 * 33], s[7 * 33]);
        *(u32x4*)(dst + (size_t)(n0 + n) * ldd + k0 + 8 * c) = o; }
    LDS_WAIT(); asm volatile("" ::: "memory");
}
template <bool I8 = false, class ColF>
__device__ __forceinline__ void tr_item8(LAS float* scr, int lane, unsigned char* dst, int ldd, int k0, int n0, const ColF& colf, float scale) {
    const auto col = colf(n0 + (lane & 31));
    float tv[32];
#pragma unroll
    for (int i = 0; i < 32; ++i) tv[i] = col.val(k0 + 2 * i + (lane >> 5));
#pragma unroll
    for (int i = 0; i < 32; ++i) scr[(2 * i + (lane >> 5)) * 33 + (lane & 31)] = tv[i] * scale;
    LDS_WAIT(); asm volatile("" ::: "memory");
#pragma unroll
    for (int j = 0; j < 2; ++j) { const int p = lane + 64 * j, n = p >> 2, c = p & 3; const LAS float* s = scr + (16 * c) * 33 + n;
        u32x4 o;
#pragma unroll
        for (int q = 0; q < 4; ++q) o[q] = I8 ? pk4_i8(s[(4 * q) * 33], s[(4 * q + 1) * 33], s[(4 * q + 2) * 33], s[(4 * q + 3) * 33]) : pk4_fp8(s[(4 * q) * 33], s[(4 * q + 1) * 33], s[(4 * q + 2) * 33], s[(4 * q + 3) * 33]);
        *(u32x4*)(dst + (size_t)(n0 + n) * ldd + k0 + 16 * c) = o; }
    LDS_WAIT(); asm volatile("" ::: "memory");
}
struct ColPlain { const float* src; int ld; const float* gain; float scale; int gsel;
    __device__ __forceinline__ float val(int k) const { const float w = src[(size_t)k * ld]; const float gv = gain[k]; return w * scale * (gsel ? gv : 1.0f); } };
struct ColDft { const float* src; int ld; const float* gain; const LAS float* trig;
    __device__ __forceinline__ float val(int k) const { const float* p = src + (size_t)k * ld; float a = 0.f;
#pragma unroll 16
        for (int c = 0; c < 64; ++c) a += p[c] * trig[c * 32];
        return a * gain[k]; } };

__device__ __forceinline__ int rope_src(int ip, int half) { return ip < 2 * half ? ((ip & 1) ? (ip >> 1) + half : (ip >> 1)) : ip; }

struct ColInProj { const float* w; const float* gain;
    __device__ __forceinline__ ColPlain operator()(int n) const {
        ColPlain c; c.src = w; c.ld = D_IN; c.gain = gain; c.scale = 1.f; c.gsel = 1;
        if (n < 768) { const int seg = n / 384, r = n - seg * 384, head = r >> 6, ip = r & 63; c.src = w + seg * 384 + head * 64 + rope_src(ip, 8); if (seg == 0) c.scale = QSCALE_A; }
        else if (n < 1664) c.src = w + n;
        else if (n < 1696) c.src = w + 1664 + rope_src(n - 1664, 16);
        else c.scale = 0.f;
        return c; } };
struct ColInProjDft { const float* w; const float* gain; LAS float* tl; int lane;
    __device__ __forceinline__ ColDft operator()(int n) const { const int c2 = n - 1792, sn = c2 >> 8, cp = c2 & 255, cc = cp & 63; ColDft d; d.src = w + 1696 + (cp >> 6) * 64; d.ld = D_IN; d.gain = gain;
        LAS float* t = tl + (lane & 31);
        if (lane < 32) {
#pragma unroll 8
            for (int c = 0; c < 64; ++c) { const float rev = (float)((c * cc) & 63) * (1.0f / 64.0f); t[c * 32] = sn ? __builtin_amdgcn_sinf(rev) : __builtin_amdgcn_cosf(rev); } }
        LDS_WAIT(); asm volatile("" ::: "memory");
        d.trig = t; return d; } };
struct ColUq { const float* wuq; const float* qn;
    __device__ __forceinline__ ColPlain operator()(int n) const { ColPlain c; c.src = wuq; c.ld = 576; c.gain = qn; c.scale = 0.f; c.gsel = 1;
        if (n < 576) { const int head = n / 96, ip = n - head * 96; c.src = wuq + head * 96 + (ip < 64 ? ip : 64 + rope_src(ip - 64, 16)); c.scale = QSCALE_B; }
        return c; } };
struct ColUkv { const float* wukv; const float* kvn;
    __device__ __forceinline__ ColPlain operator()(int n) const { ColPlain c; c.ld = 768; c.gain = kvn; c.scale = 1.f; c.gsel = 1;
        c.src = wukv + (n < 384 ? (n >> 6) * 128 + (n & 63) : ((n - 384) >> 6) * 128 + 64 + ((n - 384) & 63)); return c; } };
struct ColSimple { const float* w; int ld; const float* gain;
    __device__ __forceinline__ ColPlain operator()(int n) const { ColPlain c; c.src = w + n; c.ld = ld; c.gain = gain ? gain : w; c.scale = 1.f; c.gsel = gain ? 1 : 0; return c; } };
struct ColGU { const float* wg; const float* wu; int ld; const float* gain;
    __device__ __forceinline__ ColPlain operator()(int n) const { const int j = n >> 8, r = n & 255; const uintptr_t msk = r < 128 ? ~(uintptr_t)0 : (uintptr_t)0; ColPlain c; c.src = (const float*)(((uintptr_t)wg & msk) | ((uintptr_t)wu & ~msk)) + 128 * j + (r & 127); c.ld = ld; c.gain = gain; c.scale = 1.f; c.gsel = 1; return c; } };

__device__ __forceinline__ void p0_prologue(Frame& F, const Args& a) {
    LAS float* scr = (LAS float*)(F.lds + F.wave * 16896);
    const int gw = F.vcu * NWAVES + F.wave, NGW = F.G * NWAVES, gt = gw * 64 + F.lane, NGT = NGW * 64;
    unsigned char* ws = F.ws;
    { f32x2* ra = (f32x2*)WSF(WS_ROPEA); for (int i = gt; i < SEQ * 8; i += NGT) ra[i] = cs_angle((double)(i >> 3) * INVF_A[i & 7]);
      f32x2* rb = (f32x2*)WSF(WS_ROPEB); for (int i = gt; i < SEQ * 16; i += NGT) rb[i] = cs_angle((double)(i >> 4) * INVF_B[i & 15]);
      bf16_t* w1 = (bf16_t*)WSF(WS_W1F);
      for (int i = gt; i < 256 * 256; i += NGT) { const int row = i >> 8, k = i & 255, ri = row >> 7, k1 = row & 127, cs = k >> 7, n1 = k & 127;
          const f32x2 t = cs_rev((float)((n1 * k1) & 127) * (1.0f / 128.0f));
          const float v = ri == 0 ? (cs == 0 ? t.x : -t.y) : (cs == 0 ? -t.y : -t.x); w1[i] = (bf16_t)f2bf(v); }
      bf16_t* w2 = (bf16_t*)WSF(WS_W2F);
      for (int i = gt; i < 64 * 128; i += NGT) { const int k2 = i >> 7, k = i & 127, n2 = k >> 1, ri = k & 1; const f32x2 t = cs_rev((float)((n2 * k2) & 63) * (1.0f / 64.0f));
          w2[i] = (bf16_t)f2bf((ri ? t.y : t.x) * FFT_SCALE); }
      f32x2* tw = (f32x2*)WSF(WS_TW);
      for (int i = gt; i < 64 * 128; i += NGT) { const int n2 = i >> 7, k1 = i & 127; tw[i] = cs_rev((float)(n2 * k1) * (1.0f / 8192.0f)); } }
    constexpr int I_IN = 16 * 56, I_UP = 6 * 24 + 2 * 24, I_OUT = 16 * 32, I_L = I_IN + I_UP + I_OUT, I_GU = 16 * 176, I_D = 44 * 32, I_F = I_GU + I_D;
    constexpr int NITEMS = DEPTH * I_L + 2 * I_F;
    for (int it = gw; it < DEPTH * 256; it += NGW) { const int l = it >> 8, r = it & 255, kb = r >> 4, nb = 56 + (r & 15); unsigned char* wl = WSF(WS_WL) + (size_t)l * WL_STRIDE;
        const float* wsrc = a.in[2] + (size_t)l * DM * D_IN; const float* gsrc = a.in[1] + l * DM; ColInProjDft cf{wsrc, gsrc, scr + 64 * 33, F.lane};
        if ((I8_INPROJ >> l) & 1u) tr_item8<true>(scr, F.lane, wl, DM, 64 * kb, 32 * nb, cf, I8_WQ / 8.0f);
        else tr_item(scr, F.lane, (bf16_t*)wl, DM, 64 * kb, 32 * nb, cf); }
    for (int it = gw; it < NITEMS; it += NGW) {
        if (it < DEPTH * I_L) { const int l = it / I_L; int r = it - l * I_L; unsigned char* wl = WSF(WS_WL) + (size_t)l * WL_STRIDE;
            if (r < I_IN) { const int kb = r / 56, nb = r - kb * 56; const float* wsrc = a.in[2] + (size_t)l * DM * D_IN; const float* gsrc = a.in[1] + l * DM; ColInProj cf{wsrc, gsrc};
                if ((I8_INPROJ >> l) & 1u) tr_item8<true>(scr, F.lane, wl, DM, 64 * kb, 32 * nb, cf, nb < 12 ? I8_WQ / QSCALE_A : I8_WQ);
                else tr_item(scr, F.lane, (bf16_t*)wl, DM, 64 * kb, 32 * nb, cf);
                continue; } r -= I_IN;
            if (r < I_UP) { if (r < 144) { const int kb = r / 24, nb = r - kb * 24; ColUq cf{a.in[4] + (size_t)l * 384 * 576, a.in[3] + l * 384}; tr_item(scr, F.lane, (bf16_t*)(wl + WL_WUP), 384, 64 * kb, 32 * nb, cf); }
                else { r -= 144; const int kb = r / 24, nb = r - kb * 24; ColUkv cf{a.in[6] + (size_t)l * 128 * 768, a.in[5] + l * 128}; tr_item(scr, F.lane, (bf16_t*)(wl + WL_WUKV), 128, 64 * kb, 32 * nb, cf); } continue; } r -= I_UP;
            { const int kb = r / 32, nb = r - kb * 32; ColSimple cf{a.in[8] + (size_t)l * DM * DM, DM, a.in[7] + l * DM}; tr_item(scr, F.lane, (bf16_t*)(wl + WL_WOUT), DM, 64 * kb, 32 * nb, cf); }
        } else { int r = it - DEPTH * I_L; const int i = r / I_F; r -= i * I_F; unsigned char* wf = WSF(WS_WFF) + (size_t)i * WFF_STRIDE;
            const bool f8 = (FP8_DENSE >> i) & 1u;
            if (r < I_GU) { const int kb = r / 176, nb = r - kb * 176; ColGU cf{a.in[10] + (size_t)i * DM * D_FF, a.in[11] + (size_t)i * DM * D_FF, D_FF, a.in[9] + (2 * i) * DM};
                if ((I8_DENSE >> i) & 1u) tr_item8<true>(scr, F.lane, wf, DM, 64 * kb, 32 * nb, cf, I8_WQ); else if (f8) tr_item8(scr, F.lane, wf, DM, 64 * kb, 32 * nb, cf, W8_SCALE); else tr_item(scr, F.lane, (bf16_t*)wf, DM, 64 * kb, 32 * nb, cf); continue; } r -= I_GU;
            { const int kb = r / 32, nb = r - kb * 32; ColSimple cf{a.in[12] + (size_t)i * D_FF * DM, DM, nullptr};
              if ((FP8_DDOWN >> i) & 1u) tr_item8(scr, F.lane, wf + WFF_WD, D_FF, 64 * kb, 32 * nb, cf, W8_SCALE); else tr_item(scr, F.lane, (bf16_t*)(wf + WFF_WD), D_FF, 64 * kb, 32 * nb, cf); }
        }
    }
    { const float* x = a.in[0]; bf16_t* XB = (bf16_t*)WSF(WS_XB); f32x4* sq = (f32x4*)WSF(WS_SSQX);
      for (int m0 = gw * 4; m0 < T; m0 += NGW * 4) {
          f32x4 v[4][4]; float s[4];
#pragma unroll
          for (int r = 0; r < 4; ++r)
#pragma unroll
              for (int j = 0; j < 4; ++j) v[r][j] = ((const f32x4*)(x + (size_t)(m0 + r) * DM))[64 * j + F.lane];
#pragma unroll
          for (int r = 0; r < 4; ++r) { float t = 0.f;
#pragma unroll
              for (int j = 0; j < 4; ++j) t += (v[r][j].x * v[r][j].x + v[r][j].y * v[r][j].y) + (v[r][j].z * v[r][j].z + v[r][j].w * v[r][j].w);
              s[r] = wave_sum_dpp(t); }
#pragma unroll
          for (int r = 0; r < 4; ++r) {
              if (I8_INPROJ & 1u) {
                  const float tot = __int_as_float(__builtin_amdgcn_readlane(__float_as_int(s[r]), 63)); const float step = I8_XR * sqrtf(tot * (1.0f / DM) + 1e-12f), iq = 1.0f / step;
                  unsigned* o4 = (unsigned*)(WSF(WS_XB8) + (size_t)(m0 + r) * DM) + F.lane;
#pragma unroll
                  for (int j = 0; j < 4; ++j) o4[64 * j] = pk4_i8(v[r][j].x * iq, v[r][j].y * iq, v[r][j].z * iq, v[r][j].w * iq);
                  if (F.lane == 63) ((float*)WSF(WS_ROWSC2))[m0 + r] = step;
              }
              { u32x2* o8 = (u32x2*)(XB + (size_t)(m0 + r) * DM) + F.lane;
#pragma unroll
                  for (int j = 0; j < 4; ++j) { u32x2 w; w.x = cvt_pk_bf16(v[r][j].x, v[r][j].y); w.y = cvt_pk_bf16(v[r][j].z, v[r][j].w); o8[64 * j] = w; } }
              if (F.lane == 63) sq[m0 + r] = (f32x4){s[r], 0.f, 0.f, 0.f}; } } }
}

struct ConvBlk { const float* src; int ld; const float* gain; unsigned char* dst; int ldd, k0, n0, drow0, rstep, i8; };
__device__ __forceinline__ void conv_load(const Frame& F, const ConvBlk& cb, float scale, f32x4 (&v)[8], float (&g)[8]) {
#pragma unroll
    for (int i = 0; i < 8; ++i) { const int k = cb.k0 + 8 * F.wave + i; v[i] = *(const f32x4*)(cb.src + (size_t)k * cb.ld + cb.n0 + 4 * F.lane); const float sc = cb.i8 ? I8_WQ : scale; g[i] = cb.gain ? cb.gain[k] * sc : sc; }
}
template <bool F8>
__device__ __forceinline__ void conv_put(const Frame& F, const f32x4 (&v)[8], const float (&g)[8], LAS unsigned char* T, int i8) {
    constexpr int PITCH = F8 ? 260 : 516;
#pragma unroll
    for (int i = 0; i < 8; ++i) { const int kr = 8 * F.wave + i; const f32x4 x = v[i] * g[i];
        if (F8) *(LAS unsigned*)(T + kr * PITCH + 4 * F.lane) = i8 ? pk4_i8(x.x, x.y, x.z, x.w) : pk4_fp8(x.x, x.y, x.z, x.w);
        else { *(LAS unsigned*)(T + kr * PITCH + 8 * F.lane) = cvt_pk_bf16(x.x, x.y); *(LAS unsigned*)(T + kr * PITCH + 8 * F.lane + 4) = cvt_pk_bf16(x.z, x.w); } }
}
template <bool F8>
__device__ __forceinline__ void conv_out(const Frame& F, const ConvBlk& cb, const LAS unsigned char* T) {
    constexpr int PITCH = F8 ? 260 : 516;
    if (F8) {
#pragma unroll
        for (int j = 0; j < 2; ++j) { const int p = F.tid + 512 * j, n = p >> 2, c = p & 3; u32x4 o;
#pragma unroll
            for (int q = 0; q < 4; ++q) { unsigned w = 0;
#pragma unroll
                for (int b = 0; b < 4; ++b) w |= (unsigned)T[(16 * c + 4 * q + b) * PITCH + n] << (8 * b);
                o[q] = w; }
            *(u32x4*)(cb.dst + (size_t)(cb.drow0 + (n < 128 ? n : n + cb.rstep)) * cb.ldd + cb.k0 + 16 * c) = o; }
    } else {
#pragma unroll
        for (int j = 0; j < 4; ++j) { const int p = F.tid + 512 * j, n = p >> 3, c = p & 7; u32x4 o;
#pragma unroll
            for (int q = 0; q < 4; ++q) { const unsigned lo = *(const LAS unsigned short*)(T + (8 * c + 2 * q) * PITCH + 2 * n), hi = *(const LAS unsigned short*)(T + (8 * c + 2 * q + 1) * PITCH + 2 * n); o[q] = lo | (hi << 16); }
            *(u32x4*)(cb.dst + ((size_t)(cb.drow0 + (n < 128 ? n : n + cb.rstep)) * cb.ldd + cb.k0 + 8 * c) * 2) = o; }
    }
}
__device__ __forceinline__ ConvBlk moe_blk(const Args& a, unsigned char* dgu0, unsigned char* dd0, const float* fng, int mi, int it, int esz) {
    const int e = it / 672; int r = it - e * 672; const size_t eo = ((size_t)mi * NEXP + e) * DM * D_FFE; ConvBlk cb;
    if (r < 448) { const int up = r >= 224; if (up) r -= 224; const int kb = r / 14, nb = r - kb * 14;
        cb.src = (up ? a.in[15] : a.in[14]) + eo; cb.ld = D_FFE; cb.gain = fng; cb.dst = dgu0 + (size_t)e * 7168 * DM * esz; cb.ldd = DM; cb.k0 = 64 * kb; cb.n0 = 256 * nb; cb.drow0 = 512 * nb + (up ? 128 : 0); cb.rstep = 128; cb.i8 = (int)((I8_MOE >> mi) & 1u); }
    else { r -= 448; const int kb = r >> 2, nb = r & 3;
        cb.src = a.in[16] + eo; cb.ld = DM; cb.gain = nullptr; cb.dst = dd0 + (size_t)e * DM * D_FFE * esz; cb.ldd = D_FFE; cb.k0 = 64 * kb; cb.n0 = 256 * nb; cb.drow0 = 256 * nb; cb.rstep = 0; cb.i8 = 0; }
    return cb;
}
template <bool F8>
__device__ __forceinline__ void moe_convert(Frame& F, const Args& a, const float* fng, int mi) {
    unsigned char* ws = F.ws; unsigned char* dgu0 = (unsigned char*)WSF(WS_WGUE); unsigned char* dd0 = (unsigned char*)WSF(WS_WDE); LAS unsigned char* T0 = F.lds; LAS unsigned char* T1 = F.lds + 40960;
    const float scale = F8 ? W8_SCALE : 1.0f; constexpr int esz = F8 ? 1 : 2; constexpr int NB = NEXP * 672;
    int itA = F.vcu; if (itA >= NB) return;
    int itB = itA + F.G; bool hasB = itB < NB;
    ConvBlk cA = moe_blk(a, dgu0, dd0, fng, mi, itA, esz), cB = cA; f32x4 vA[8], vB[8]; float gA[8], gB[8];
    conv_load(F, cA, scale, vA, gA);
    if (hasB) { cB = moe_blk(a, dgu0, dd0, fng, mi, itB, esz); conv_load(F, cB, scale, vB, gB); }
    for (;;) {
        conv_put<F8>(F, vA, gA, T0, cA.i8);
        const ConvBlk oA = cA; const int nA = itA + 2 * F.G; const bool moreA = nA < NB;
        if (moreA) { cA = moe_blk(a, dgu0, dd0, fng, mi, nA, esz); conv_load(F, cA, scale, vA, gA); }
        LDS_BAR();
        conv_out<F8>(F, oA, T0);
        if (!hasB) break;
        conv_put<F8>(F, vB, gB, T1, cB.i8);
        const ConvBlk oB = cB; const int nB = itB + 2 * F.G; const bool moreB = nB < NB;
        if (moreB) { cB = moe_blk(a, dgu0, dd0, fng, mi, nB, esz); conv_load(F, cB, scale, vB, gB); }
        LDS_BAR();
        conv_out<F8>(F, oB, T1);
        if (!moreA) break;
        itA = nA; itB = nB; hasB = moreB;
    }
    __syncthreads();
}
__device__ __forceinline__ void moe_r1(Frame& F, const Args& a, int l) {
    const int mi = l >> 1; unsigned char* ws = F.ws;
    const int gw = F.vcu * NWAVES + F.wave, NGW = F.G * NWAVES, gt = gw * 64 + F.lane, NGT = NGW * 64;
    const float* fng = a.in[9] + l * DM;
    REPS(18) { if ((FP8_MOE >> mi) & 1u) moe_convert<true>(F, a, fng, mi); else moe_convert<false>(F, a, fng, mi); }
    { int* rt = (int*)WSF(WS_ROWTOK); float* rs_ = (float*)WSF(WS_ROWRS); for (int i = gt; i < 2 * RT_STRIDE; i += NGT) { rt[i] = -1; rs_[i] = 0.f; } }
    __syncthreads();
    LAS float* Wl = (LAS float*)F.lds; LAS int* cnt = (LAS int*)(F.lds + 32768);
    const float* wr_ = a.in[13] + (size_t)mi * DM * NEXP;
    for (int i = F.tid; i < DM * NEXP; i += NWAVES * 64) { const int k = i >> 3, e = i & 7; Wl[(((k >> 8) * 4 + (k & 3)) * 64 + ((k >> 2) & 63)) * 8 + e] = wr_[i] * fng[k]; }
    const bf16_t* x = (const bf16_t*)WSF(WS_XB); i32x2* toke = (i32x2*)WSF(WS_TOKE); f32x2* tokg = (f32x2*)WSF(WS_TOKG); int* cntwg = (int*)WSF(WS_CNTWG);
    REPS(19) for (int c = F.vcu; c < T / 256; c += F.G) {
        if (F.tid < 16) cnt[F.tid] = 0;
        __syncthreads();
        for (int it = 0; it < 8; ++it) { const int tok0 = c * 256 + F.wave * 32 + it * 4;
            f32x4 xv[4][4]; float lg[4][8]; float sq[4];
#pragma unroll
            for (int t = 0; t < 4; ++t)
#pragma unroll
                for (int j = 0; j < 4; ++j) { const u32x2 w = ((const u32x2*)(x + (size_t)(tok0 + t) * DM))[64 * j + F.lane]; xv[t][j] = (f32x4){bf_lo(w.x), bf_hi(w.x), bf_lo(w.y), bf_hi(w.y)}; }
#pragma unroll
            for (int t = 0; t < 4; ++t) { sq[t] = 0.f;
#pragma unroll
                for (int e = 0; e < 8; ++e) lg[t][e] = 0.f; }
#pragma unroll
            for (int j = 0; j < 4; ++j)
#pragma unroll
                for (int q = 0; q < 4; ++q) { const LAS float* wp = Wl + ((j * 4 + q) * 64 + F.lane) * 8; const f32x4 w0 = *(const LAS f32x4*)wp, w1 = *(const LAS f32x4*)(wp + 4);
#pragma unroll
                    for (int t = 0; t < 4; ++t) { const float xq = xv[t][j][q]; sq[t] += xq * xq;
                        lg[t][0] += xq * w0.x; lg[t][1] += xq * w0.y; lg[t][2] += xq * w0.z; lg[t][3] += xq * w0.w; lg[t][4] += xq * w1.x; lg[t][5] += xq * w1.y; lg[t][6] += xq * w1.z; lg[t][7] += xq * w1.w; } }
#pragma unroll
            for (int t = 0; t < 4; ++t) { const int tok = tok0 + t;
                const float rstd = rsqrtf(wave_sum_dpp(sq[t]) * (1.0f / DM) + RMS_EPS); float l8[8];
#pragma unroll
                for (int e = 0; e < 8; ++e) l8[e] = wave_sum_dpp(lg[t][e]) * rstd;
                int e0 = 0; float v0 = l8[0];
#pragma unroll
                for (int e = 1; e < 8; ++e) if (l8[e] > v0) { v0 = l8[e]; e0 = e; }
                int e1 = -1; float v1 = -INFINITY;
#pragma unroll
                for (int e = 0; e < 8; ++e) if (e != e0 && l8[e] > v1) { v1 = l8[e]; e1 = e; }
                const float g1 = 1.0f / (1.0f + __expf(v0 - v1)), g0 = 1.0f - g1;
                if (F.lane == 63) { toke[tok] = (i32x2){e0, e1}; tokg[tok] = (f32x2){g0, g1}; atomicAdd((int*)&cnt[e0], 1); atomicAdd((int*)&cnt[8 + e1], 1); } } }
        __syncthreads();
        if (F.tid < 16) cntwg[c * 16 + F.tid] = cnt[F.tid];
        __syncthreads();
    }
}
__device__ __forceinline__ void moe_r2(Frame& F, const float* rowsc) {
    unsigned char* ws = F.ws;
    LAS int* cw = (LAS int*)F.lds;
    LAS int* tot = cw + 4096;
    LAS int* wpre = tot + 16;
    LAS int* base = wpre + 64;
    const int* cntwg = (const int*)WSF(WS_CNTWG); const i32x2* toke = (const i32x2*)WSF(WS_TOKE); const f32x2* tokg = (const f32x2*)WSF(WS_TOKG);
    int* rt = (int*)WSF(WS_ROWTOK); float* rg = (float*)WSF(WS_ROWGATE); float* rs_ = (float*)WSF(WS_ROWRS); int* tile_e = (int*)WSF(WS_TILEE);
    for (int i = F.tid; i < 4096; i += NWAVES * 64) cw[i] = cntwg[i];
    __syncthreads();
    if (F.tid < 16) { int s = 0; for (int w = 0; w < 256; ++w) s += cw[w * 16 + F.tid]; tot[F.tid] = s; }
    __syncthreads();
    if (blockIdx.x == 0) { for (int i = F.tid; i < 2 * 272; i += NWAVES * 64) { const int sl = i / 272, t = i - sl * 272; int cum = 0, ex = 7;
        for (int e = 7; e >= 0; --e) { int c2 = 0; for (int q = 0; q <= e; ++q) c2 += (tot[sl * 8 + q] + 255) >> 8; if (t < c2) ex = e; if (e == 7) cum = c2; }
        tile_e[sl * 272 + t] = ex; if (t == 0) tile_e[1024 + sl] = cum; } }
    for (int c = F.vcu; c < T / 256; c += F.G) {
        __syncthreads();
        if (F.tid < 16) { const int sl = F.tid >> 3, e = F.tid & 7; int st = 0; for (int q = 0; q < e; ++q) st += ((tot[sl * 8 + q] + 255) >> 8) << 8;
            int pre = 0; for (int w = 0; w < c; ++w) pre += cw[w * 16 + F.tid]; base[F.tid] = st + pre; }
        i32x2 ee = {0, 0}; f32x2 gg = {0.f, 0.f}; int rk0 = 0, rk1 = 0;
        if (F.tid < 256) { const int tok = c * 256 + F.tid; ee = toke[tok]; gg = tokg[tok];
#pragma unroll
            for (int e = 0; e < 8; ++e) { const unsigned long long m0 = __ballot(ee.x == e), m1 = __ballot(ee.y == e); const unsigned long long lt = (1ull << F.lane) - 1ull;
                if (ee.x == e) rk0 = __popcll(m0 & lt); if (ee.y == e) rk1 = __popcll(m1 & lt);
                if (F.lane == 0) { wpre[F.wave * 16 + e] = __popcll(m0); wpre[F.wave * 16 + 8 + e] = __popcll(m1); } } }
        __syncthreads();
        if (F.tid < 256) { const int tok = c * 256 + F.tid; int p0 = base[ee.x] + rk0, p1 = base[8 + ee.y] + rk1;
            for (int w = 0; w < F.wave; ++w) { p0 += wpre[w * 16 + ee.x]; p1 += wpre[w * 16 + 8 + ee.y]; }
            const f32x4 sq = ((const f32x4*)WSF(WS_SSQX))[tok]; const float rstd = rsqrtf(((sq.x + sq.y) + (sq.z + sq.w)) * (1.0f / DM) + RMS_EPS) * (rowsc ? rowsc[tok] : 1.0f);
            rt[p0] = tok; rg[p0] = gg.x; rs_[p0] = rstd; rt[RT_STRIDE + p1] = tok; rg[RT_STRIDE + p1] = gg.y; rs_[RT_STRIDE + p1] = rstd; }
    }
    __syncthreads();
}
__device__ __forceinline__ void final_norm(Frame& F, const Args& a) {
    const int gw = F.vcu * NWAVES + F.wave, NGW = F.G * NWAVES; const float* g = a.in[17];
    f32x4 gv[4];
#pragma unroll
    for (int j = 0; j < 4; ++j) gv[j] = ((const f32x4*)g)[64 * j + F.lane];
    unsigned char* ws = F.ws;
    for (int m0 = gw * 4; m0 < T; m0 += NGW * 4) {
        u32x2 w[4][4]; float rstd[4];
#pragma unroll
        for (int r = 0; r < 4; ++r)
#pragma unroll
            for (int j = 0; j < 4; ++j) w[r][j] = ((const u32x2*)((const bf16_t*)WSF(WS_XB) + (size_t)(m0 + r) * DM))[64 * j + F.lane];
#pragma unroll
        for (int r = 0; r < 4; ++r) { float s = 0.f;
#pragma unroll
            for (int j = 0; j < 4; ++j) { const float a0 = bf_lo(w[r][j].x), a1 = bf_hi(w[r][j].x), a2 = bf_lo(w[r][j].y), a3 = bf_hi(w[r][j].y); s += (a0 * a0 + a1 * a1) + (a2 * a2 + a3 * a3); }
            rstd[r] = rsqrtf(wave_sum(s) * (1.0f / DM) + RMS_EPS); }
#pragma unroll
        for (int r = 0; r < 4; ++r) { f32x4* xr = (f32x4*)(a.out + (size_t)(m0 + r) * DM) + F.lane;
#pragma unroll
            for (int j = 0; j < 4; ++j) { const f32x4 v = {bf_lo(w[r][j].x), bf_hi(w[r][j].x), bf_lo(w[r][j].y), bf_hi(w[r][j].y)}; xr[64 * j] = v * rstd[r] * gv[j]; } }
    }
}
__global__ void __launch_bounds__(NWAVES * 64, 2) mk_fwd(Args args) {
    extern __shared__ __attribute__((aligned(16))) unsigned char lds[];
    const int wv_ = __builtin_amdgcn_readfirstlane((int)threadIdx.x >> 6);
    for (int u = threadIdx.x; u < (LDS_BYTES - MISC_OFF) / 4; u += NWAVES * 64) ((LAS unsigned*)((LAS unsigned char*)lds + MISC_OFF))[u] = 0u;
    __syncthreads();
#if !MK_PER_PHASE
    { XcdBarrier bar0 = xcd_barrier_post((unsigned*)(args.ws + WS_CTL) + CW_BAR, (volatile LAS unsigned*)((LAS unsigned char*)lds + MISC_OFF) + 8); (void)bar0; }
#define GRID_BAR() do { XcdBarrier bar; bar.bar = (unsigned*)WSP(WS_CTL) + CW_BAR; bar.x = xb_xcc_id(); bar.st = F.MISC + 8; bar.tid = fresh_tid(wv_); xcd_barrier(bar); } while (0)
#else
#define GRID_BAR() do {} while (0)
#endif
    const int lo = args.ph_lo, hi = args.ph_hi;
#define IN(k) (lo <= (k) && (k) < hi)
    typedef const __attribute__((address_space(4))) Args* ArgsP;
#define WSP(off) (ws + (size_t)(z_ + (unsigned)(off)))
#define PHASE_ENTRY() unsigned z_ = 0u; asm volatile("" : "+s"(z_)); ArgsP ap_; { auto p_ = __builtin_amdgcn_kernarg_segment_ptr(); asm volatile("" : "+s"(p_)); ap_ = (ArgsP)p_; } \
    Args A; _Pragma("unroll") for (int i_ = 0; i_ < 18; ++i_) A.in[i_] = ap_->in[i_]; A.out = ap_->out; A.ws = ap_->ws; A.ph_lo = 0; A.ph_hi = 0; unsigned char* ws = A.ws; Frame F; F.lds = (LAS unsigned char*)lds; F.MISC = (volatile LAS unsigned*)(F.lds + MISC_OFF); \
    { int ln_; asm volatile("v_mbcnt_lo_u32_b32 %0, -1, 0\n\tv_mbcnt_hi_u32_b32 %0, -1, %0" : "=v"(ln_)); F.tid = wv_ * 64 + ln_; } F.lane = F.tid & 63; F.wave = __builtin_amdgcn_readfirstlane(F.tid >> 6); \
    { int g_ = gridDim.x; asm volatile("" : "+s"(g_)); F.G = g_; } int bx = (int)blockIdx.x; asm volatile("" : "+s"(bx)); F.vcu = (F.G % 8 == 0) ? (bx % 8) * (F.G / 8) + bx / 8 : bx; F.z = z_; F.ws = ws; F.ctl = (unsigned*)WSP(WS_CTL); \
    LAS unsigned char* ring = F.lds; LAS unsigned char* lepi = F.lds + EPI_OFF; unsigned char* wl = WSP(WS_WL) + (size_t)l * WL_STRIDE; (void)wl; (void)ring; (void)lepi; (void)bx

    if (IN(0)) { const int l = 0; PHASE_ENTRY(); REPS(9) p0_prologue(F, A); GRID_BAR(); }

    for (int l = 0; l < DEPTH; ++l) {
        const int base = 1 + 16 * l;
        if (IN(base + 0)) { PHASE_ENTRY();
            pg8::PlainOrder S; S.init(T / 256, NIN / 256, F.G, bx);
            if ((I8_INPROJ >> l) & 1u) {
                pg8::Gemm g{WSP(WS_XB8), wl, DM, DM, DM, 1};
                pg8::EpiInProj E{(const f32x4*)WSP(WS_SSQX), (bf16_t*)WSP(WS_QA), (bf16_t*)WSP(WS_KA), (bf16_t*)WSP(WS_VA), (bf16_t*)WSP(WS_CQK), (bf16_t*)WSP(WS_KB), (bf16_t*)WSP(WS_Z),
                                 (float*)WSP(WS_SSQC), (const f32x2*)WSP(WS_ROPEA), (const f32x2*)WSP(WS_ROPEB), (const float*)WSP(WS_ROWSC2)};
                pg8::gemm_phase<3>(ring, lepi, g, S, E, F.tid);
            } else {
                pg8::Gemm g{(const bf16_t*)WSP(WS_XB), (const bf16_t*)wl, DM, DM, DM, 2};
                pg8::EpiInProj E{(const f32x4*)WSP(WS_SSQX), (bf16_t*)WSP(WS_QA), (bf16_t*)WSP(WS_KA), (bf16_t*)WSP(WS_VA), (bf16_t*)WSP(WS_CQK), (bf16_t*)WSP(WS_KB), (bf16_t*)WSP(WS_Z),
                                 (float*)WSP(WS_SSQC), (const f32x2*)WSP(WS_ROPEA), (const f32x2*)WSP(WS_ROPEB), nullptr};
                REPS(0) pg8::gemm_phase<2>(ring, lepi, g, S, E, F.tid);
            }
            GRID_BAR();
        }
        if (IN(base + 1)) { PHASE_ENTRY();
            { pg8::Gemm g{WSP(WS_CQK), wl + WL_WUP, 512, 384, 384, 2}; pg8::PlainOrder S; S.init(T / 256, 3, F.G, bx);
              pg8::EpiUp E{(const f32x4*)WSP(WS_SSQC), (bf16_t*)WSP(WS_QB), (bf16_t*)WSP(WS_KB), (bf16_t*)WSP(WS_VB), (const f32x2*)WSP(WS_ROPEB), true};
              REPS(1) pg8::gemm_phase<2>(ring, lepi, g, S, E, F.tid); }
            { pg8::Gemm g{WSP(WS_CQK) + 384 * 2, wl + WL_WUKV, 512, 128, 128, 2}; pg8::PlainOrder S; S.init(T / 256, 3, F.G, bx);
              pg8::EpiUp E{(const f32x4*)WSP(WS_SSQC), (bf16_t*)WSP(WS_QB), (bf16_t*)WSP(WS_KB), (bf16_t*)WSP(WS_VB), (const f32x2*)WSP(WS_ROPEB), false};
              pg8::gemm_phase<2>(ring, lepi, g, S, E, F.tid); }
            __syncthreads();
            REPS(2) for (int u = F.vcu; u < 512; u += F.G)
                att::fft_a_unit(u & 7, u >> 3, (const bf16_t*)WSP(WS_Z), (const bf16_t*)WSP(WS_W1F), (const f32x2*)WSP(WS_TW), (bf16_t*)WSP(WS_AP), (char*)lds, F.tid);
            GRID_BAR();
        }
        if (IN(base + 2)) { PHASE_ENTRY();
            REPS(3) for (int u = bx; u < 256; u += F.G)
                att::mla_unit(u & 7, u >> 3, (const bf16_t*)WSP(WS_QB), (const bf16_t*)WSP(WS_KB), (const bf16_t*)WSP(WS_VB), (bf16_t*)WSP(WS_MIX), (char*)lds, fresh_tid(wv_));
            __syncthreads();
            REPS(4) for (int u = bx; u < 256; u += F.G) { const int j = u >> 3;
                att::dil_unit(u & 7, j >> 1, j & 1, (const bf16_t*)WSP(WS_QA), (const bf16_t*)WSP(WS_KA), (const bf16_t*)WSP(WS_VA), (bf16_t*)WSP(WS_MIX), (char*)lds, fresh_tid(wv_)); }
            __syncthreads();
            REPS(5) att::fft_c_units(F.vcu, F.G, (const bf16_t*)WSP(WS_AP), (const bf16_t*)WSP(WS_W2F), (bf16_t*)WSP(WS_MIX), (char*)lds, fresh_tid(wv_));
            if ((((l & 1) ? I8_MOE : I8_DENSE) >> (l >> 1)) & 1u) {
                const f32x4* sq = (const f32x4*)WSP(WS_SSQX); float* rsc = (float*)WSP(WS_ROWSC);
                for (int r = bx * 512 + fresh_tid(wv_); r < T; r += F.G * 512) { const f32x4 s = sq[r]; rsc[r] = I8_XR * sqrtf(((s.x + s.y) + (s.z + s.w)) * (1.0f / DM) + 1.0f); } }
            GRID_BAR();
        }
        if (IN(base + 3)) { PHASE_ENTRY();
            pg8::Gemm g{(const bf16_t*)WSP(WS_MIX), (const bf16_t*)(wl + WL_WOUT), DM, DM, DM, 2}; pg8::PlainOrder S; S.init(T / 256, 4, F.G, bx);
            const bool i8 = (((l & 1) ? I8_MOE : I8_DENSE) >> (l >> 1)) & 1u;
            const bool f8 = i8 || ((l & 1) ? ((FP8_MOE >> (l >> 1)) & 1u) : ((FP8_DENSE >> (l >> 1)) & 1u));
            pg8::EpiResid E{(bf16_t*)WSP(WS_XB), (float*)WSP(WS_SSQX), f8 ? (unsigned char*)WSP(WS_XB8) : nullptr, i8 ? (const float*)WSP(WS_ROWSC) : nullptr, 1.0f};
            pg8::gemm_phase<2>(ring, lepi, g, S, E, F.tid);
            GRID_BAR();
        }
        if ((l & 1) == 0) {
            if (IN(base + 4)) { PHASE_ENTRY(); unsigned char* wf = WSP(WS_WFF) + (size_t)(l >> 1) * WFF_STRIDE;
                if (l + 1 < DEPTH && ((I8_INPROJ >> (l + 1)) & 1u)) {
                    const f32x4* sq = (const f32x4*)WSP(WS_SSQX); float* rsc = (float*)WSP(WS_ROWSC2);
                    for (int r = bx * 512 + F.tid; r < T; r += F.G * 512) { const f32x4 s = sq[r]; rsc[r] = I8_XR * sqrtf(((s.x + s.y) + (s.z + s.w)) * (1.0f / DM) + 1.0f); } }
                pg8::PlainOrder S; S.init(T / 256, 2 * D_FF / 256, F.G, bx);
                if ((I8_DENSE >> (l >> 1)) & 1u) {
                    pg8::Gemm g{WSP(WS_XB8), wf, DM, DM, DM, 1};
                    pg8::EpiSwiGLU E{(const f32x4*)WSP(WS_SSQX), (bf16_t*)WSP(WS_HID), D_FF, nullptr, I8_WINV, (int)((FP8_DDOWN >> (l >> 1)) & 1u), nullptr, (const float*)WSP(WS_ROWSC)};
                    pg8::gemm_phase<3>(ring, lepi, g, S, E, F.tid);
                } else if ((FP8_DENSE >> (l >> 1)) & 1u) {
                    pg8::Gemm g{WSP(WS_XB8), wf, DM, DM, DM, 1};
                    pg8::EpiSwiGLU E{(const f32x4*)WSP(WS_SSQX), (bf16_t*)WSP(WS_HID), D_FF, nullptr, W8_INV, 1, nullptr, nullptr};
                    pg8::gemm_phase<1>(ring, lepi, g, S, E, F.tid);
                } else {
                    pg8::Gemm g{WSP(WS_XB), wf, DM, DM, DM, 2};
                    pg8::EpiSwiGLU E{(const f32x4*)WSP(WS_SSQX), (bf16_t*)WSP(WS_HID), D_FF, nullptr, 1.0f, (int)((FP8_DDOWN >> (l >> 1)) & 1u), nullptr, nullptr};
                    REPS(6) pg8::gemm_phase<2>(ring, lepi, g, S, E, F.tid);
                }
                GRID_BAR();
            }
            if (IN(base + 5)) { PHASE_ENTRY(); unsigned char* wf = WSP(WS_WFF) + (size_t)(l >> 1) * WFF_STRIDE;
                const bool nx8 = l + 1 < DEPTH && ((I8_INPROJ >> (l + 1)) & 1u);
                unsigned char* x8n = nx8 ? (unsigned char*)WSP(WS_XB8) : nullptr; const float* rs2 = nx8 ? (const float*)WSP(WS_ROWSC2) : nullptr;
                pg8::PlainOrder S; S.init(T / 256, 4, F.G, bx);
                if ((FP8_DDOWN >> (l >> 1)) & 1u) {
                    pg8::Gemm g{WSP(WS_HID), wf + WFF_WD, D_FF, D_FF, D_FF, 1};
                    pg8::EpiResid E{(bf16_t*)WSP(WS_XB), (float*)WSP(WS_SSQX), x8n, rs2, W8_INV};
                    pg8::gemm_phase<1>(ring, lepi, g, S, E, F.tid);
                } else {
                    pg8::Gemm g{WSP(WS_HID), wf + WFF_WD, D_FF, D_FF, D_FF, 2};
                    pg8::EpiResid E{(bf16_t*)WSP(WS_XB), (float*)WSP(WS_SSQX), x8n, rs2, 1.0f};
                    pg8::gemm_phase<2>(ring, lepi, g, S, E, F.tid);
                }
                GRID_BAR();
            }
        } else {
            if (IN(base + 4)) { PHASE_ENTRY();
                if (l + 1 < DEPTH && ((I8_INPROJ >> (l + 1)) & 1u)) {
                    const f32x4* sq = (const f32x4*)WSP(WS_SSQX); float* rsc = (float*)WSP(WS_ROWSC2);
                    for (int r = bx * 512 + F.tid; r < T; r += F.G * 512) { const f32x4 s = sq[r]; rsc[r] = I8_XR * sqrtf(((s.x + s.y) + (s.z + s.w)) * (1.0f / DM) + 1.0f); } }
                REPS(8) moe_r1(F, A, l); GRID_BAR(); }
            if (IN(base + 5)) { PHASE_ENTRY(); moe_r2(F, ((I8_MOE >> (l >> 1)) & 1u) ? (const float*)WSP(WS_ROWSC) : nullptr); GRID_BAR(); }
            static_assert(I8_MOE == 3u && FP8_MOE == 3u, "the MoE stage program below is the int8 gate/up + fp8 down one");
            if (IN(base + 6)) { PHASE_ENTRY();
                const int* rt = (const int*)WSP(WS_ROWTOK);
                const int ntl0 = __builtin_amdgcn_readfirstlane(((const int*)WSP(WS_TILEE))[1024]), ntl1 = __builtin_amdgcn_readfirstlane(((const int*)WSP(WS_TILEE))[1025]);
                pg8::Gemm g{WSP(WS_XB8), WSP(WS_WGUE), DM, DM, DM, 1};
                pg8::MoeOrder<true> S; S.init(ntl0 + ntl1, 2 * D_FFE / 256, F.G, bx); S.tile_e = (const int*)WSP(WS_TILEE); S.row_tok = rt; S.estride = (size_t)7168 * DM; S.ntl0 = ntl0;
                pg8::EpiSwiGLU E{(const f32x4*)WSP(WS_SSQX), (bf16_t*)WSP(WS_HID), D_FFE, rt, I8_WINV, 1, (const float*)WSP(WS_ROWRS), nullptr};
                pg8::gemm_phase<3>(ring, lepi, g, S, E, F.tid);
                GRID_BAR();
            }
            for (int sl = 0; sl < 2; ++sl) {
                if (IN(base + 7 + 2 * sl)) { PHASE_ENTRY();
                    const int* tile_e = (const int*)WSP(WS_TILEE) + sl * 272; const int* rt = (const int*)WSP(WS_ROWTOK) + sl * RT_STRIDE; const float* rg = (const float*)WSP(WS_ROWGATE) + sl * RT_STRIDE;
                    const int ntl = __builtin_amdgcn_readfirstlane(((const int*)WSP(WS_TILEE))[1024 + sl]);
                    const bool nx8 = l + 1 < DEPTH && ((I8_INPROJ >> (l + 1)) & 1u);
                    unsigned char* x8n = nx8 ? (unsigned char*)WSP(WS_XB8) : nullptr; const float* rs2 = (const float*)WSP(WS_ROWSC2);
                    pg8::Gemm g{WSP(WS_HID) + (size_t)sl * RT_STRIDE * D_FFE, WSP(WS_WDE), D_FFE, D_FFE, D_FFE, 1};
                    pg8::MoeOrder<false> S; S.init(ntl, 4, F.G, bx); S.tile_e = tile_e; S.row_tok = rt; S.estride = (size_t)DM * D_FFE;
                    pg8::EpiMoeDown E{(bf16_t*)WSP(WS_XB), (float*)WSP(WS_SSQX), rt, rg, x8n, rs2, sl, W8_INV};
                    pg8::gemm_phase<1>(ring, lepi, g, S, E, F.tid);
                    GRID_BAR();
                }
            }
        }
    }
    if (IN(65)) { const int l = 0; PHASE_ENTRY(); final_norm(F, A); }
#undef IN
#undef GRID_BAR
}

extern "C" void kernel_launch(void* const* d_in, const int* in_sizes, int n_in, void* d_out, int out_size, void* d_ws, size_t ws_size, hipStream_t stream) {
    static int grid = 0;
    if (grid == 0) {
        if (n_in != 18 || in_sizes[0] != T * DM || out_size != T * DM || ws_size < WS_END) {
            fprintf(stderr, "kernel_launch: shape mismatch: n_in %d in0 %d out %d ws %zu (need >= %zu); nothing launched\n", n_in, n_in > 0 ? in_sizes[0] : -1, out_size, ws_size, (size_t)WS_END); grid = -1; return; }
        int dev = 0, cus = 0, per_cu = 0;
        if (hipGetDevice(&dev) != hipSuccess || hipDeviceGetAttribute(&cus, hipDeviceAttributeMultiprocessorCount, dev) != hipSuccess) { fprintf(stderr, "kernel_launch: device query failed\n"); grid = -1; return; }
        if (hipFuncSetAttribute((const void*)mk_fwd, hipFuncAttributeMaxDynamicSharedMemorySize, LDS_BYTES) != hipSuccess) { fprintf(stderr, "kernel_launch: hipFuncSetAttribute failed\n"); grid = -1; return; }
        if (hipOccupancyMaxActiveBlocksPerMultiprocessor(&per_cu, (const void*)mk_fwd, NWAVES * 64, LDS_BYTES) != hipSuccess || per_cu < 1)
            fprintf(stderr, "kernel_launch: note: occupancy query reports %d workgroups per CU\n", per_cu);
        (void)hipGetLastError();
        grid = cus;
        if (grid > 256) grid = 256;
    }
    if (grid < 0) return;
    if (hipMemsetAsync((char*)d_ws + WS_CTL, 0, CTL_ZERO_BYTES, stream) != hipSuccess) { fprintf(stderr, "kernel_launch: memset failed\n"); return; }
    Args a{};
    for (int i = 0; i < 18; ++i) a.in[i] = (const float*)d_in[i];
    a.out = (float*)d_out; a.ws = (unsigned char*)d_ws;
#if MK_PER_PHASE
    int ids[80]; int n = 0; ids[n++] = 0;
    for (int l = 0; l < DEPTH; ++l) { const int base = 1 + 16 * l; const int np = (l & 1) ? 10 : 6; for (int p = 0; p < np; ++p) ids[n++] = base + p; }
    ids[n++] = 65;
    for (int i = 0; i < n; ++i) { a.ph_lo = ids[i]; a.ph_hi = ids[i] + 1; hipLaunchKernelGGL(mk_fwd, dim3(grid), dim3(NWAVES * 64), LDS_BYTES, stream, a); }
#else
    a.ph_lo = 0; a.ph_hi = 1000;
    hipLaunchKernelGGL(mk_fwd, dim3(grid), dim3(NWAVES * 64), LDS_BYTES, stream, a);
#endif
    const hipError_t le = hipPeekAtLastError();
    if (le != hipSuccess) fprintf(stderr, "kernel_launch: launch failed: %s\n", hipGetErrorName(le));
}
```
